# Optimizing an MI355X kernel written in HIP

```python
import jax, jax.numpy as jnp
from jax import lax
import numpy as np

D_MODEL = 1024
BATCH = 2
SEQ = 16384
DEPTH = 2

D_FF = 2816
EPS = 1e-6
NSA_HEADS = 8
NSA_KV_GROUPS = 2
HEAD_DIM = 64
NSA_WIDTH = NSA_HEADS * HEAD_DIM
KV_WIDTH = NSA_KV_GROUPS * HEAD_DIM
CMP_BLOCK = 32
CMP_STRIDE = 16
CMP_HIDDEN = 128
SLC_BLOCK = 64
RATIO = SLC_BLOCK // CMP_STRIDE
SLC_TOP_N = 16
WINDOW = 512
Q_BLOCK = 128
FORCE_BONUS = 1e4
CONV_WIDTH = 512
CONV_K = 3
IN_SIZES = (NSA_WIDTH, 3 * NSA_HEADS, KV_WIDTH, KV_WIDTH, KV_WIDTH, KV_WIDTH,
            KV_WIDTH, KV_WIDTH, CONV_WIDTH, CONV_WIDTH, CONV_WIDTH)
IN_COLS = sum(IN_SIZES)
IN_SPLITS = tuple(int(s) for s in np.cumsum(IN_SIZES)[:-1])
MIX_OUT = NSA_WIDTH + CONV_WIDTH
RWKV_HEAD = 64
RWKV_HEADS = D_MODEL // RWKV_HEAD
DECAY_LORA = 64
AAA_LORA = 64
GATE_LORA = 128
LNX_EPS = 64e-5

kernel_name = "hybrid_nsa_shortconv_rwkv7_macaron"


def rmsnorm(x, g):
    xf = x.astype(jnp.float32)
    y = xf * lax.rsqrt(jnp.mean(xf * xf, -1, keepdims=True) + EPS)
    return (y * g.astype(jnp.float32)).astype(x.dtype)


def macaron_half_ffn(x, pre_g, post_g, w_gate, w_up, w_down):
    h = rmsnorm(x, pre_g)
    h = (jax.nn.silu(h @ w_gate) * (h @ w_up)) @ w_down
    return x + 0.5 * rmsnorm(h, post_g)


def alibi_slopes(n):
    return 2.0 ** (-8.0 * jnp.arange(1, n + 1, dtype=jnp.float32) / n)


def masked_softmax(s, mask):
    s = jnp.where(mask, s.astype(jnp.float32), -jnp.inf)
    m = jnp.max(s, -1, keepdims=True)
    m = jnp.where(jnp.isfinite(m), m, 0.0)
    p = jnp.exp(s - m)
    return p / jnp.maximum(jnp.sum(p, -1, keepdims=True), 1e-30)


def compress_blocks(kv, pe, w1, w2):
    B, S, G, Dh = kv.shape
    halves = kv.reshape(B, S // CMP_STRIDE, CMP_STRIDE, G, Dh)
    blocks = jnp.concatenate([halves[:, :-1], halves[:, 1:]], axis=2)
    blocks = blocks + pe[None, None, :, None, :]
    nc = blocks.shape[1]
    flat = blocks.transpose(0, 1, 3, 2, 4).reshape(B, nc, G, CMP_BLOCK * Dh)
    return jax.nn.gelu(flat @ w1) @ w2


def nsa_attention(q, gates, kc, vc, k_slc, v_slc, k_win, v_win):
    B, S, H, Dh = q.shape
    G = kc.shape[2]
    R = H // G
    n_cmp = kc.shape[1]
    n_slc = S // SLC_BLOCK
    top_n = min(SLC_TOP_N, n_slc)
    slopes = alibi_slopes(H).reshape(G, R)
    cmp_end = jnp.arange(n_cmp) * CMP_STRIDE + (CMP_BLOCK - 1)
    qg = q.reshape(B, S, G, R, Dh) * (Dh ** -0.5)
    gg = gates.reshape(B, S, G, R, 3)
    kb = k_slc.reshape(B, n_slc, SLC_BLOCK, G, Dh).transpose(0, 3, 1, 2, 4)
    vb = v_slc.reshape(B, n_slc, SLC_BLOCK, G, Dh).transpose(0, 3, 1, 2, 4)
    gather = jax.vmap(jax.vmap(lambda blocks, ix: blocks[ix]))
    kw = jnp.pad(k_win, ((0, 0), (WINDOW, 0), (0, 0), (0, 0)))
    vw = jnp.pad(v_win, ((0, 0), (WINDOW, 0), (0, 0), (0, 0)))
    j = jnp.arange(n_slc)
    offs = jnp.arange(SLC_BLOCK)
    woffs = jnp.arange(Q_BLOCK + WINDOW) - WINDOW

    def query_block(qi):
        q0 = qi * Q_BLOCK
        t = q0 + jnp.arange(Q_BLOCK)
        qb = lax.dynamic_slice_in_dim(qg, q0, Q_BLOCK, axis=1)
        gb = lax.dynamic_slice_in_dim(gg, q0, Q_BLOCK, axis=1)
        d_cmp = t[:, None] - cmp_end[None, :]
        s = jnp.einsum("btgrd,bngd->bgrtn", qb, kc) - slopes[:, :, None, None] * d_cmp
        p_cmp = masked_softmax(s, d_cmp >= 0)
        o_cmp = jnp.einsum("bgrtn,bngd->btgrd", p_cmp.astype(vc.dtype), vc)
        imp = jnp.pad(p_cmp.sum(2), ((0, 0), (0, 0), (0, 0), (0, 1)))
        imp = imp.reshape(B, G, Q_BLOCK, n_slc, RATIO)
        last = imp[..., RATIO - 1]
        prev = jnp.pad(last, ((0, 0), (0, 0), (0, 0), (1, 0)))[..., :-1]
        imp = imp.sum(-1) - 0.5 * last + 0.5 * prev
        blk_t = (t // SLC_BLOCK)[:, None]
        forced = (j == 0) | (j == blk_t) | (j == blk_t - 1)
        imp = jnp.where(forced, imp + FORCE_BONUS, imp)
        imp = jnp.where(j <= blk_t, imp, -jnp.inf)
        _, idx = lax.top_k(imp, top_n)
        ks = gather(kb, idx)
        vs = gather(vb, idx)
        d_slc = t[:, None, None] - (idx[..., None] * SLC_BLOCK + offs)
        s = jnp.einsum("btgrd,bgtnld->bgrtnl", qb, ks) - slopes[:, :, None, None, None] * d_slc[:, :, None]
        mask = jnp.broadcast_to((d_slc >= 0)[:, :, None], s.shape)
        p = masked_softmax(s.reshape(B, G, R, Q_BLOCK, -1), mask.reshape(B, G, R, Q_BLOCK, -1))
        o_slc = jnp.einsum("bgrtm,bgtmd->btgrd", p.astype(vs.dtype),
                           vs.reshape(B, G, Q_BLOCK, top_n * SLC_BLOCK, Dh))
        kwb = lax.dynamic_slice_in_dim(kw, q0, Q_BLOCK + WINDOW, axis=1)
        vwb = lax.dynamic_slice_in_dim(vw, q0, Q_BLOCK + WINDOW, axis=1)
        kpos = q0 + woffs
        d_win = t[:, None] - kpos[None, :]
        mask = (d_win >= 0) & (d_win < WINDOW) & (kpos[None, :] >= 0)
        s = jnp.einsum("btgrd,bsgd->bgrts", qb, kwb) - slopes[:, :, None, None] * d_win
        p = masked_softmax(s, mask)
        o_win = jnp.einsum("bgrts,bsgd->btgrd", p.astype(vwb.dtype), vwb)
        return gb[..., 0:1] * o_cmp + gb[..., 1:2] * o_slc + gb[..., 2:3] * o_win

    out = lax.map(query_block, jnp.arange(S // Q_BLOCK))
    return out.transpose(1, 0, 2, 3, 4, 5).reshape(B, S, H * Dh)


def short_conv(b_gate, c_gate, u, conv_w, conv_b):
    z = c_gate * u
    y = lax.conv_general_dilated(z, conv_w[:, None, :].astype(z.dtype), window_strides=(1,),
                                 padding=[(CONV_K - 1, 0)],
                                 dimension_numbers=("NWC", "WIO", "NWC"),
                                 feature_group_count=z.shape[-1])
    return b_gate * (y + conv_b)


def nsa_shortconv_mixer(h, w_in, cmp_pe_k, cmp_w1_k, cmp_w2_k, cmp_pe_v, cmp_w1_v, cmp_w2_v,
                        conv_w, conv_b, w_out):
    B, S, _ = h.shape
    q, g, kc, vc, ks, vs, kw, vw, cb, cc, cu = jnp.split(h @ w_in, IN_SPLITS, axis=-1)
    kv = lambda t: t.reshape(B, S, NSA_KV_GROUPS, HEAD_DIM)
    kc = compress_blocks(kv(kc), cmp_pe_k, cmp_w1_k, cmp_w2_k)
    vc = compress_blocks(kv(vc), cmp_pe_v, cmp_w1_v, cmp_w2_v)
    o_nsa = nsa_attention(q.reshape(B, S, NSA_HEADS, HEAD_DIM),
                          jax.nn.sigmoid(g).reshape(B, S, NSA_HEADS, 3),
                          kc, vc, kv(ks), kv(vs), kv(kw), kv(vw))
    o_conv = short_conv(cb, cc, cu, conv_w, conv_b)
    return jnp.concatenate([o_nsa.astype(h.dtype), o_conv], axis=-1) @ w_out


def rwkv7_mixer(h, mu, w_r, w_k, w_v, w_o, w0, w_dec1, w_dec2, a0, w_a1, w_a2,
                w_g1, w_g2, k_k, k_a, r_k, lnx_g, lnx_b):
    B, S, D = h.shape
    H, N = RWKV_HEADS, RWKV_HEAD
    xx = jnp.pad(h, ((0, 0), (1, 0), (0, 0)))[:, :-1] - h
    xr, xw, xk, xv, xa, xg = [h + xx * mu[i] for i in range(6)]
    r = xr @ w_r
    k = xk @ w_k
    v = xv @ w_v
    w_log = -jax.nn.softplus(-(w0 + jnp.tanh(xw @ w_dec1) @ w_dec2)) - 0.5
    a = jax.nn.sigmoid(a0 + (xa @ w_a1) @ w_a2)
    g = jax.nn.sigmoid(xg @ w_g1) @ w_g2
    kk = (k * k_k).reshape(B, S, H, N).astype(jnp.float32)
    kk = kk * lax.rsqrt(jnp.maximum(jnp.sum(kk * kk, -1, keepdims=True), 1e-12))
    k = k * (1.0 + (a - 1.0) * k_a)
    decay = jnp.exp(-jnp.exp(w_log.astype(jnp.float32)))
    heads = lambda t: t.reshape(B, S, H, N).astype(jnp.float32).transpose(1, 0, 2, 3)
    xs = (heads(r), heads(decay), heads(k), heads(v), kk.transpose(1, 0, 2, 3), heads(a))

    def step(state, inp):
        r_t, w_t, k_t, v_t, kk_t, a_t = inp
        sa = jnp.einsum("bhij,bhj->bhi", state, -kk_t)
        state = (state * w_t[:, :, None, :] + sa[..., None] * (kk_t * a_t)[:, :, None, :]
                 + v_t[..., None] * k_t[:, :, None, :])
        return state, jnp.einsum("bhij,bhj->bhi", state, r_t)

    state0 = jnp.zeros((B, H, N, N), jnp.float32)
    _, y = lax.scan(step, state0, xs)
    y = y.transpose(1, 0, 2, 3)
    mean = jnp.mean(y, -1, keepdims=True)
    var = jnp.mean(jnp.square(y - mean), -1, keepdims=True)
    y = ((y - mean) * lax.rsqrt(var + LNX_EPS)).reshape(B, S, D) * lnx_g + lnx_b
    rh, kh, vh = (t.reshape(B, S, H, N).astype(jnp.float32) for t in (r, k, v))
    bonus = (jnp.sum(rh * kh * r_k, -1, keepdims=True) * vh).reshape(B, S, D)
    return ((y + bonus).astype(h.dtype) * g) @ w_o


def setup_inputs(seed: int = 0) -> dict:
    key = jax.random.key(seed)
    keys = iter(jax.random.split(key, 80))

    def nrm(shape, scale):
        return jax.random.normal(next(keys), shape, jnp.float32) * scale

    def unif(shape, lo, hi):
        return jax.random.uniform(next(keys), shape, jnp.float32, lo, hi)

    def gain(n=D_MODEL):
        return 1.0 + nrm((n,), 0.05)

    inp = {"x": nrm((BATCH, SEQ, D_MODEL), 1.0)}

    def add_ffn(p):
        inp[p + "_pre_g"] = gain()
        inp[p + "_post_g"] = gain()
        inp[p + "_w_gate"] = nrm((D_MODEL, D_FF), D_MODEL ** -0.5)
        inp[p + "_w_up"] = nrm((D_MODEL, D_FF), D_MODEL ** -0.5)
        inp[p + "_w_down"] = nrm((D_FF, D_MODEL), D_FF ** -0.5)

    add_ffn("l0_ffn1")
    inp["l0_mix_pre_g"] = gain()
    inp["l0_mix_post_g"] = gain()
    inp["l0_w_in"] = nrm((D_MODEL, IN_COLS), D_MODEL ** -0.5)
    for kvn in ("k", "v"):
        inp["l0_cmp_pe_" + kvn] = nrm((CMP_BLOCK, HEAD_DIM), 0.1)
        inp["l0_cmp_w1_" + kvn] = nrm((CMP_BLOCK * HEAD_DIM, CMP_HIDDEN), (CMP_BLOCK * HEAD_DIM) ** -0.5)
        inp["l0_cmp_w2_" + kvn] = nrm((CMP_HIDDEN, HEAD_DIM), CMP_HIDDEN ** -0.5)
    inp["l0_conv_w"] = nrm((CONV_K, CONV_WIDTH), 0.5)
    inp["l0_conv_b"] = nrm((CONV_WIDTH,), 0.02)
    inp["l0_w_out"] = nrm((MIX_OUT, D_MODEL), MIX_OUT ** -0.5)
    add_ffn("l0_ffn2")
    add_ffn("l1_ffn1")
    inp["l1_mix_pre_g"] = gain()
    inp["l1_mix_post_g"] = gain()
    inp["l1_mu"] = unif((6, D_MODEL), 0.0, 1.0)
    inp["l1_w_r"] = nrm((D_MODEL, D_MODEL), D_MODEL ** -0.5)
    inp["l1_w_k"] = nrm((D_MODEL, D_MODEL), D_MODEL ** -0.5)
    inp["l1_w_v"] = nrm((D_MODEL, D_MODEL), D_MODEL ** -0.5)
    inp["l1_w_o"] = nrm((D_MODEL, D_MODEL), D_MODEL ** -0.5)
    inp["l1_w0"] = unif((D_MODEL,), -6.0, 1.0)
    inp["l1_w_dec1"] = nrm((D_MODEL, DECAY_LORA), D_MODEL ** -0.5)
    inp["l1_w_dec2"] = nrm((DECAY_LORA, D_MODEL), 0.1 * DECAY_LORA ** -0.5)
    inp["l1_a0"] = nrm((D_MODEL,), 0.5)
    inp["l1_w_a1"] = nrm((D_MODEL, AAA_LORA), D_MODEL ** -0.5)
    inp["l1_w_a2"] = nrm((AAA_LORA, D_MODEL), 0.5 * AAA_LORA ** -0.5)
    inp["l1_w_g1"] = nrm((D_MODEL, GATE_LORA), D_MODEL ** -0.5)
    inp["l1_w_g2"] = nrm((GATE_LORA, D_MODEL), GATE_LORA ** -0.5)
    inp["l1_k_k"] = 0.85 + nrm((D_MODEL,), 0.05)
    inp["l1_k_a"] = 1.0 + nrm((D_MODEL,), 0.05)
    inp["l1_r_k"] = nrm((RWKV_HEADS, RWKV_HEAD), 0.1)
    inp["l1_lnx_g"] = gain()
    inp["l1_lnx_b"] = nrm((D_MODEL,), 0.02)
    add_ffn("l1_ffn2")
    return inp


def reference(x,
              l0_ffn1_pre_g, l0_ffn1_post_g, l0_ffn1_w_gate, l0_ffn1_w_up, l0_ffn1_w_down,
              l0_mix_pre_g, l0_mix_post_g, l0_w_in,
              l0_cmp_pe_k, l0_cmp_w1_k, l0_cmp_w2_k, l0_cmp_pe_v, l0_cmp_w1_v, l0_cmp_w2_v,
              l0_conv_w, l0_conv_b, l0_w_out,
              l0_ffn2_pre_g, l0_ffn2_post_g, l0_ffn2_w_gate, l0_ffn2_w_up, l0_ffn2_w_down,
              l1_ffn1_pre_g, l1_ffn1_post_g, l1_ffn1_w_gate, l1_ffn1_w_up, l1_ffn1_w_down,
              l1_mix_pre_g, l1_mix_post_g, l1_mu, l1_w_r, l1_w_k, l1_w_v, l1_w_o,
              l1_w0, l1_w_dec1, l1_w_dec2, l1_a0, l1_w_a1, l1_w_a2, l1_w_g1, l1_w_g2,
              l1_k_k, l1_k_a, l1_r_k, l1_lnx_g, l1_lnx_b,
              l1_ffn2_pre_g, l1_ffn2_post_g, l1_ffn2_w_gate, l1_ffn2_w_up, l1_ffn2_w_down):
    layers = [
        dict(ffn1=(l0_ffn1_pre_g, l0_ffn1_post_g, l0_ffn1_w_gate, l0_ffn1_w_up, l0_ffn1_w_down),
             norms=(l0_mix_pre_g, l0_mix_post_g),
             mixer=nsa_shortconv_mixer,
             mix=(l0_w_in, l0_cmp_pe_k, l0_cmp_w1_k, l0_cmp_w2_k, l0_cmp_pe_v, l0_cmp_w1_v,
                  l0_cmp_w2_v, l0_conv_w, l0_conv_b, l0_w_out),
             ffn2=(l0_ffn2_pre_g, l0_ffn2_post_g, l0_ffn2_w_gate, l0_ffn2_w_up, l0_ffn2_w_down)),
        dict(ffn1=(l1_ffn1_pre_g, l1_ffn1_post_g, l1_ffn1_w_gate, l1_ffn1_w_up, l1_ffn1_w_down),
             norms=(l1_mix_pre_g, l1_mix_post_g),
             mixer=rwkv7_mixer,
             mix=(l1_mu, l1_w_r, l1_w_k, l1_w_v, l1_w_o, l1_w0, l1_w_dec1, l1_w_dec2, l1_a0,
                  l1_w_a1, l1_w_a2, l1_w_g1, l1_w_g2, l1_k_k, l1_k_a, l1_r_k, l1_lnx_g, l1_lnx_b),
             ffn2=(l1_ffn2_pre_g, l1_ffn2_post_g, l1_ffn2_w_gate, l1_ffn2_w_up, l1_ffn2_w_down)),
    ]
    for i in range(DEPTH):
        p = layers[i]
        x = macaron_half_ffn(x, *p["ffn1"])
        pre_g, post_g = p["norms"]
        x = x + rmsnorm(p["mixer"](rmsnorm(x, pre_g), *p["mix"]), post_g)
        x = macaron_half_ffn(x, *p["ffn2"])
    return x
```

```cpp
#include <hip/hip_runtime.h>
#include <cstdio>
#include <cstdint>

#ifndef MK_ONE_LAUNCH
#define MK_ONE_LAUNCH 0
#endif

#define LAS __attribute__((address_space(3)))
typedef unsigned short bf16;
typedef short bf16x8 __attribute__((ext_vector_type(8)));
typedef float f32x4 __attribute__((ext_vector_type(4)));
typedef float f32x2 __attribute__((ext_vector_type(2)));
typedef unsigned u32x4 __attribute__((ext_vector_type(4)));
typedef unsigned u32x2 __attribute__((ext_vector_type(2)));

constexpr int NB = 2, SEQ = 16384, M = NB * SEQ, D = 1024, FF = 2816;
constexpr int NCMP = 1023, NSLC = 256;
constexpr int PROJ_LD = 3072;
constexpr int PC_Q = 0, PC_KC = 512, PC_VC = 640, PC_KS = 768, PC_VS = 896, PC_KW = 1024, PC_VW = 1152, PC_CB = 1280, PC_CC = 1792, PC_CU = 2304, PC_G = 2816;
constexpr int RKV_LD = 3328;
constexpr int EAG_LD = 3072;
constexpr float EPS = 1e-6f;

constexpr size_t MiB = 1u << 20;
constexpr size_t WS_CTL = 0, CTL_ZERO_BYTES = 1 * MiB;
constexpr size_t WS_KC = 1 * MiB, WS_VC = 2 * MiB;
constexpr size_t WS_W = 8 * MiB;
constexpr size_t WS_BIG = 28 * MiB;
constexpr size_t WS_EAG = 236 * MiB;
constexpr size_t WS_XN = 236 * MiB;
constexpr size_t WS_DD = 302 * MiB;
constexpr size_t WS_Y = 428 * MiB;
constexpr size_t WS_END = 492 * MiB;
constexpr size_t W_GU = 0, W_DN = 11 * MiB;
constexpr size_t W_IN = 0, W_OUT = 6 * MiB;
constexpr size_t W_RKV = 0, W_L2 = 13 * MiB, W_O = 15 * MiB;

constexpr int CW_BAR = 4096;

constexpr int LDS_CTL_OFF = 147456;
constexpr int LDS_BYTES = 147456 + 256;

__device__ __forceinline__ float bf2f(bf16 b) { return __uint_as_float(((unsigned)b) << 16); }
__device__ __forceinline__ float bflo(unsigned u) { return __uint_as_float(u << 16); }
__device__ __forceinline__ float bfhi(unsigned u) { return __uint_as_float(u & 0xffff0000u); }
__device__ __forceinline__ unsigned cvt_pk_bf16(float lo, float hi) { unsigned r; asm volatile("v_cvt_pk_bf16_f32 %0, %1, %2" : "=v"(r) : "v"(lo), "v"(hi)); return r; }
__device__ __forceinline__ bf16 f2bf(float f) { return (bf16)(cvt_pk_bf16(f, 0.f) & 0xffffu); }
__device__ __forceinline__ float wave_sum(float v) {
#pragma unroll
    for (int o = 1; o < 64; o <<= 1) v += __shfl_xor(v, o);
    return v;
}
__device__ __forceinline__ float wave_max(float v) {
#pragma unroll
    for (int o = 1; o < 64; o <<= 1) v = fmaxf(v, __shfl_xor(v, o));
    return v;
}
__device__ __forceinline__ float sigmoidf_(float x) { return 1.0f / (1.0f + __expf(-x)); }

namespace pg8 {
#define PG8_LAS __attribute__((address_space(3)))
typedef unsigned short bf16_t;
constexpr int BM = 256, BK = 64, HALF = 128, HTB = HALF * BK * 2, STAGE_BYTES = 8 * HTB, NXCD = 8, WGM = 8;

__host__ __device__ __forceinline__ int lds_byte(int r, int c) { const int st = (r >> 4) * 2 + (c >> 5), rr = r & 15, cc = c & 31, ob = rr * 64 + cc * 2; return st * 1024 + (ob ^ (((ob >> 9) & 1) << 5)); }
__host__ __device__ __forceinline__ void stage_rc(int b, int& R, int& C) { const int st = b / 1024, sb = b % 1024, swz = sb ^ (((sb >> 9) & 1) << 5); R = (st >> 1) * 16 + swz / 64; C = (st & 1) * 32 + (swz % 64) / 2; }
__host__ __device__ __forceinline__ int perm32(int rho) { const int n = rho >> 4, i = rho & 15; return 8 * (i >> 2) + 4 * n + (i & 3); }

struct Unit { int pm, pn; };
struct Gemm { const bf16_t* A; const bf16_t* Bt; int M, N, K, lda, gap, ts; };

struct StaticOrder {
    int nM, nN, nwg, G, c;
    __host__ __device__ void init(int M_, int N_, int G_, int c_) { nM = M_ / BM; nN = N_ / BM; nwg = nM * nN; G = G_; c = c_; }
    __host__ __device__ bool next(int i, Unit& u) const {
        const long L = (long)i * G + c; if (L >= nwg) return false;
        int wgid = (int)L; { const int q = nwg / NXCD, r = nwg % NXCD, xcd = wgid % NXCD, off = wgid / NXCD; wgid = (xcd < r ? xcd * (q + 1) : r * (q + 1) + (xcd - r) * q) + off; }
        const int nig = WGM * nN, gid = wgid / nig, fm = gid * WGM, gsz = (nM - fm) < WGM ? (nM - fm) : WGM;
        u.pm = fm + ((wgid % nig) % gsz); u.pn = (wgid % nig) / gsz; return true;
    }
    __device__ __forceinline__ void a_ready(const Unit&) const {}
    __device__ __forceinline__ void done(const Unit&) const {}
};

template <int MODE> struct Epi {
    static constexpr bool PERM = true, AFTER_DRAIN = false;
    bf16_t* O; int ldc; const float* b0; const float* b1;
    __device__ __forceinline__ void operator()(const f32x4 (&acc)[2][2][4][2], const Unit& u, int wr, int wc, int fr, int fq) const {
        const int row0 = u.pm * BM + wr * 64 + fr;
        if constexpr (MODE == 1) {
            const int col0 = u.pn * HALF + wc * 32 + 8 * fq;
#pragma unroll
            for (int ai = 0; ai < 2; ++ai)
#pragma unroll
                for (int m = 0; m < 4; ++m) {
                    float o[8];
#pragma unroll
                    for (int n = 0; n < 2; ++n)
#pragma unroll
                        for (int j = 0; j < 4; ++j) { const float g = acc[ai][0][m][n][j], up = acc[ai][1][m][n][j]; o[n * 4 + j] = g * __builtin_amdgcn_rcpf(1.0f + __expf(-g)) * up; }
                    u32x4 w; w.x = cvt_pk_bf16(o[0], o[1]); w.y = cvt_pk_bf16(o[2], o[3]); w.z = cvt_pk_bf16(o[4], o[5]); w.w = cvt_pk_bf16(o[6], o[7]);
                    *(u32x4*)(O + (size_t)(row0 + ai * HALF + m * 16) * ldc + col0) = w;
                }
        } else {
            const int col0 = u.pn * BM + wc * 32 + 8 * fq;
#pragma unroll
            for (int ai = 0; ai < 2; ++ai)
#pragma unroll
                for (int m = 0; m < 4; ++m) {
                    bf16_t* rowp = O + (size_t)(row0 + ai * HALF + m * 16) * ldc + col0;
#pragma unroll
                    for (int bj = 0; bj < 2; ++bj) {
                        float o[8];
#pragma unroll
                        for (int n = 0; n < 2; ++n)
#pragma unroll
                            for (int j = 0; j < 4; ++j) o[n * 4 + j] = acc[ai][bj][m][n][j];
                        if constexpr (MODE == 2) {
                            if (u.pn == 12) {
                                if (bj == 1) {
#pragma unroll
                                    for (int j = 0; j < 8; ++j) o[j] = sigmoidf_(o[j]);
                                } else if (wc < 2) {
#pragma unroll
                                    for (int j = 0; j < 8; ++j) { const float e2 = __expf(2.0f * o[j]); o[j] = 1.0f - 2.0f * __builtin_amdgcn_rcpf(e2 + 1.0f); }
                                }
                            }
                        }
                        if constexpr (MODE == 3) {
                            const int cc = (u.pn & 3) * BM + bj * HALF + wc * 32 + 8 * fq;
                            if (u.pn < 4) {
#pragma unroll
                                for (int j = 0; j < 8; ++j) o[j] = 0.60653065971f * sigmoidf_(o[j] + b0[cc + j]);
                            } else if (u.pn < 8) {
#pragma unroll
                                for (int j = 0; j < 8; ++j) o[j] = sigmoidf_(o[j] + b1[cc + j]);
                            }
                        }
                        u32x4 w; w.x = cvt_pk_bf16(o[0], o[1]); w.y = cvt_pk_bf16(o[2], o[3]); w.z = cvt_pk_bf16(o[4], o[5]); w.w = cvt_pk_bf16(o[6], o[7]);
                        *(u32x4*)(rowp + bj * HALF) = w;
                    }
                }
        }
    }
};

template <class EpiT, class Sched, bool ALIGN_EPI = true, bool SP2 = true>
__device__ __forceinline__ void gemm_phase(PG8_LAS unsigned char* lds, const Gemm g, const Sched& S, const EpiT& E) {
    const int tid = threadIdx.x, wid = __builtin_amdgcn_readfirstlane(tid >> 6), lane = tid & 63, wr = wid >> 2, wc = wid & 3, fr = lane & 15, fq = lane >> 4;
    const int K = g.K, nt = K / BK, lda = g.lda, ts = g.ts;
    unsigned voffA[2], voffB[2];
#pragma unroll
    for (int i = 0; i < 2; ++i) { int R, C; stage_rc(tid * 16 + i * 8192, R, C); const int Rb = EpiT::PERM ? ((R & ~31) + perm32(R & 31)) : R;
        voffA[i] = (unsigned)(R * lda + C) * 2u; voffB[i] = (unsigned)(Rb * K + C) * 2u; }
    const size_t kstep = (size_t)(BK * 2);
    const size_t hstepA = (size_t)HALF * lda * 2, hstepB = (size_t)HALF * K * 2;
    const size_t tstepB = 2 * hstepB, rowA = (size_t)lda * 2;
    const unsigned ldsw = (unsigned)wid * 1024u;
    const int aoff = lds_byte(wr * 64 + fr, fq * 8), boff = lds_byte(wc * 32 + fr, fq * 8);
#define PG8_ABASE(pm) ((const char*)g.A + ((size_t)(pm) * BM + ((g.gap && (pm) >= 64) ? 1 : 0)) * rowA)
#define PG8_KOFF(t) (((t) < ts) ? (ptrdiff_t)(t) * (ptrdiff_t)kstep : (ptrdiff_t)((t) - ts) * (ptrdiff_t)kstep - (ptrdiff_t)rowA)
#define PG8_SA(b, h) (((b) * 2 + (h)) * HTB)
#define PG8_SB(b, h) ((4 + (b) * 2 + (h)) * HTB)
#define PG8_STAGE(bufoff, gbase, voff) do { _Pragma("unroll") for (int _i = 0; _i < 2; ++_i) \
        __builtin_amdgcn_global_load_lds((const unsigned*)((const char*)(gbase) + (voff)[_i]), (PG8_LAS unsigned*)(lds + (bufoff) + ldsw + _i * 8192), 16, 0, 0); } while (0)
#define PG8_LDA(dst, b, h) do { _Pragma("unroll") for (int m = 0; m < 4; ++m) _Pragma("unroll") for (int k = 0; k < 2; ++k) dst[m][k] = *(const PG8_LAS bf16x8*)(lds + PG8_SA(b, h) + aoff + m * 2048 + k * 1024); } while (0)
#define PG8_LDB(dst, b, h) do { _Pragma("unroll") for (int n = 0; n < 2; ++n) _Pragma("unroll") for (int k = 0; k < 2; ++k) dst[n][k] = *(const PG8_LAS bf16x8*)(lds + PG8_SB(b, h) + boff + n * 2048 + k * 1024); } while (0)
#define PG8_MMA(ai, bj, At, Bt) do { __builtin_amdgcn_s_setprio(1); _Pragma("unroll") for (int m = 0; m < 4; ++m) _Pragma("unroll") for (int n = 0; n < 2; ++n) _Pragma("unroll") for (int k = 0; k < 2; ++k) \
        acc[ai][bj][m][n] = __builtin_amdgcn_mfma_f32_16x16x32_bf16(Bt[n][k], At[m][k], acc[ai][bj][m][n], 0, 0, 0); __builtin_amdgcn_s_setprio(0); } while (0)
#define PG8_WAIT_V(n) asm volatile("s_waitcnt vmcnt(" #n ")" ::: "memory")
#define PG8_WAIT_L(n) asm volatile("s_waitcnt lgkmcnt(" #n ")" ::: "memory")
#define PG8_BAR __builtin_amdgcn_s_barrier()
#define PG8_SCHED __builtin_amdgcn_sched_barrier(0)
    Unit cur, nxt; int ui = 0;
    if (!S.next(0, cur)) return;
    f32x4 acc[2][2][4][2];
#pragma unroll
    for (int a = 0; a < 2; ++a)
#pragma unroll
        for (int b = 0; b < 2; ++b)
#pragma unroll
            for (int m = 0; m < 4; ++m)
#pragma unroll
                for (int n = 0; n < 2; ++n) acc[a][b][m][n] = (f32x4){0.f, 0.f, 0.f, 0.f};
    bf16x8 At[4][2], B0[2][2], B1[2][2];
    const char* cA = PG8_ABASE(cur.pm); const char* cB = (const char*)g.Bt + (size_t)cur.pn * tstepB;
    S.a_ready(cur);
    static_assert(SP2, "only the SP2 loop is kept");
    PG8_STAGE(PG8_SB(0, 0), cB, voffB); PG8_STAGE(PG8_SB(0, 1), cB + hstepB, voffB); PG8_STAGE(PG8_SA(0, 0), cA, voffA); PG8_STAGE(PG8_SA(0, 1), cA + hstepA, voffA);
    if (wr == 1) PG8_BAR;
    PG8_WAIT_V(2); PG8_BAR;
    PG8_STAGE(PG8_SB(1, 0), cB + kstep, voffB); PG8_STAGE(PG8_SA(1, 0), cA + kstep, voffA); PG8_STAGE(PG8_SB(1, 1), cB + hstepB + kstep, voffB);
    PG8_WAIT_V(6); PG8_BAR;
    for (;;) {
        const bool has_next = S.next(ui + 1, nxt);
        const char* nA = has_next ? PG8_ABASE(nxt.pm) : cA; const char* nB = has_next ? (const char*)g.Bt + (size_t)nxt.pn * tstepB : cB;
        for (int t = 0; t < nt; t += 2) {
            const bool last = (t == nt - 2);
            const char* a1 = cA + PG8_KOFF(t + 1);
            const char* a2 = last ? nA : cA + PG8_KOFF(t + 2); const char* b2 = last ? nB : cB + (size_t)(t + 2) * kstep;
            const char* a3 = a2 + kstep; const char* b3 = b2 + kstep;
            if (last && has_next) S.a_ready(nxt);
            PG8_LDB(B0, 0, 0); PG8_LDB(B1, 0, 1); PG8_SCHED; PG8_LDA(At, 0, 0); PG8_STAGE(PG8_SA(1, 1), a1 + hstepA, voffA);
            PG8_WAIT_V(8); PG8_WAIT_L(0); PG8_BAR; PG8_MMA(0, 0, At, B0); PG8_MMA(0, 1, At, B1); PG8_BAR; PG8_SCHED;
            PG8_LDA(At, 0, 1); PG8_STAGE(PG8_SB(0, 0), b2, voffB); PG8_STAGE(PG8_SB(0, 1), b2 + hstepB, voffB); PG8_STAGE(PG8_SA(0, 0), a2, voffA);
            PG8_WAIT_V(8); PG8_WAIT_L(0); PG8_BAR; PG8_MMA(1, 0, At, B0); PG8_MMA(1, 1, At, B1); PG8_BAR; PG8_SCHED;
            PG8_LDB(B0, 1, 0); PG8_LDB(B1, 1, 1); PG8_SCHED; PG8_LDA(At, 1, 0); PG8_STAGE(PG8_SA(0, 1), a2 + hstepA, voffA);
            PG8_WAIT_V(8); PG8_WAIT_L(0); PG8_BAR; PG8_MMA(0, 0, At, B0); PG8_MMA(0, 1, At, B1); PG8_BAR; PG8_SCHED;
            PG8_LDA(At, 1, 1); PG8_STAGE(PG8_SB(1, 0), b3, voffB); PG8_STAGE(PG8_SB(1, 1), b3 + hstepB, voffB); PG8_STAGE(PG8_SA(1, 0), a3, voffA);
            PG8_WAIT_V(8); PG8_WAIT_L(0); PG8_BAR; PG8_MMA(1, 0, At, B0); PG8_MMA(1, 1, At, B1); PG8_BAR; PG8_SCHED;
        }
        if constexpr (ALIGN_EPI) { if (wr == 0) PG8_BAR; }
        E(acc, cur, wr, wc, fr, fq); S.done(cur);
        if (!has_next) break;
#pragma unroll
        for (int a = 0; a < 2; ++a)
#pragma unroll
            for (int b = 0; b < 2; ++b)
#pragma unroll
                for (int m = 0; m < 4; ++m)
#pragma unroll
                    for (int n = 0; n < 2; ++n) acc[a][b][m][n] = (f32x4){0.f, 0.f, 0.f, 0.f};
        cur = nxt; cA = nA; cB = nB; ++ui;
        if constexpr (ALIGN_EPI) { if (wr == 1) PG8_BAR; }
    }
    PG8_WAIT_V(0);
    if constexpr (!ALIGN_EPI) { if (wr == 0) PG8_BAR; }
    PG8_BAR;
#undef PG8_ABASE
#undef PG8_KOFF
#undef PG8_SA
#undef PG8_SB
#undef PG8_STAGE
#undef PG8_LDA
#undef PG8_LDB
#undef PG8_MMA
#undef PG8_WAIT_V
#undef PG8_WAIT_L
#undef PG8_BAR
#undef PG8_SCHED
}
}

#define XB_TMO      128
#define XB_XCNT(j)  (256  + 64 * (j))
#define XB_XSUB(j)  (1280 + 64 * (j))
#define XB_XGEN(j)  (2304 + 64 * (j))
#define XB_TOP      3328
#define XB_TOPGEN   3392
#define XCD_BAR_WORDS 3456
#define XB_SPIN_CAP (1u << 24)

__device__ __forceinline__ unsigned xb_ld(unsigned* p)              { return __hip_atomic_load(p, __ATOMIC_RELAXED, __HIP_MEMORY_SCOPE_AGENT); }
__device__ __forceinline__ unsigned xb_add(unsigned* p, unsigned v) { return __hip_atomic_fetch_add(p, v, __ATOMIC_RELAXED, __HIP_MEMORY_SCOPE_AGENT); }
__device__ __forceinline__ unsigned xb_xcc_id() { return (unsigned)__builtin_amdgcn_s_getreg((3 << 11) | 20) & 0xFu; }
#define XB_SPIN(cond, bar) do { unsigned _sp = 0; while (cond) { __builtin_amdgcn_s_sleep(1); \
    if ((++_sp & 255u) == 0u) { if (xb_ld(&(bar)[XB_TMO])) break; if (_sp > XB_SPIN_CAP) { atomicAdd(&(bar)[XB_TMO], 1u); break; } } } } while (0)

struct XcdBarrier { unsigned* bar; unsigned x; volatile LAS unsigned* st; };

__device__ __forceinline__ XcdBarrier xcd_barrier_post(unsigned* bar, volatile LAS unsigned* st) {
    XcdBarrier b; b.bar = bar; b.x = xb_xcc_id(); b.st = st;
    if (threadIdx.x == 0) (void)xb_add(&bar[XB_XCNT(b.x)], 1u);
    return b;
}
__device__ __forceinline__ void xcd_barrier_complete(unsigned* bar, unsigned x, unsigned& nloc, unsigned& nx) {
    const unsigned G = gridDim.x * gridDim.y * gridDim.z;
    unsigned sum, cnt, mine, sp = 0u;
    for (;;) {
        sum = 0u; cnt = 0u; mine = 0u;
#pragma unroll
        for (unsigned j = 0; j < 16; ++j) { const unsigned c = xb_ld(&bar[XB_XCNT(j)]); sum += c; cnt += (c > 0u) ? 1u : 0u; mine = (j == x) ? c : mine; }
        if (sum == G) break;
        __builtin_amdgcn_s_sleep(1);
        if ((++sp & 255u) == 0u) { if (xb_ld(&bar[XB_TMO])) break; if (sp > XB_SPIN_CAP) { atomicAdd(&bar[XB_TMO], 1u); break; } }
    }
    nloc = mine > 0u ? mine : 1u; nx = cnt > 0u ? cnt : 1u;
}
__device__ __forceinline__ void xcd_barrier(const XcdBarrier& b) {
    asm volatile("s_waitcnt vmcnt(0)" ::: "memory");
    __syncthreads();
    if (threadIdx.x == 0) {
        unsigned* bar = b.bar;
        __builtin_amdgcn_s_waitcnt(0);
        unsigned nloc = b.st[0], nx = b.st[1];
        if (nloc == 0u) { xcd_barrier_complete(bar, b.x, nloc, nx); b.st[0] = nloc; b.st[1] = nx; }
        const unsigned old = xb_add(&bar[XB_XSUB(b.x)], 1u);
        const unsigned gen = old / nloc;
        if (old + 1u == (gen + 1u) * nloc) {
            __builtin_amdgcn_fence(__ATOMIC_RELEASE, "agent");
            asm volatile("s_waitcnt vmcnt(0)" ::: "memory");
            const unsigned og = xb_add(&bar[XB_TOP], 1u);
            const unsigned tg = og / nx;
            if (og + 1u == (tg + 1u) * nx) xb_add(&bar[XB_TOPGEN], 1u);
            else XB_SPIN(xb_ld(&bar[XB_TOPGEN]) == tg, bar);
            __builtin_amdgcn_fence(__ATOMIC_ACQUIRE, "agent");
            xb_add(&bar[XB_XGEN(b.x)], 1u);
            asm volatile("s_waitcnt vmcnt(0)" ::: "memory");
        } else {
            XB_SPIN(xb_ld(&bar[XB_XGEN(b.x)]) == gen, bar);
            __builtin_amdgcn_fence(__ATOMIC_ACQUIRE, "agent");
            asm volatile("s_waitcnt vmcnt(0)" ::: "memory");
        }
    }
    __syncthreads();
}

struct Args { const float* in[53]; float* out; unsigned char* ws; int ph_lo, ph_hi; };

enum { I_X = 0, I_L0F1 = 1, I_L0_MIX_PRE = 6, I_L0_MIX_POST = 7, I_W_IN = 8, I_PE_K = 9, I_W1_K = 10, I_W2_K = 11, I_PE_V = 12, I_W1_V = 13, I_W2_V = 14,
       I_CONV_W = 15, I_CONV_B = 16, I_W_OUT = 17, I_L0F2 = 18, I_L1F1 = 23, I_L1_MIX_PRE = 28, I_L1_MIX_POST = 29, I_MU = 30, I_W_R = 31, I_W_K = 32, I_W_V = 33, I_W_O = 34,
       I_W0 = 35, I_DEC1 = 36, I_DEC2 = 37, I_A0 = 38, I_A1 = 39, I_A2 = 40, I_G1 = 41, I_G2 = 42, I_K_K = 43, I_K_A = 44, I_R_K = 45, I_LNX_G = 46, I_LNX_B = 47, I_L1F2 = 48 };

template <class F> __device__ __forceinline__ void convert_rows(bf16* dst, int nrows, int K, F f, int gtid, int gsize) {
    const int total = nrows * (K / 8);
    for (int idx = gtid; idx < total; idx += gsize) {
        const int n = idx % nrows, k0 = (idx / nrows) * 8;
        float v[8];
#pragma unroll
        for (int j = 0; j < 8; ++j) v[j] = f(n, k0 + j);
        u32x4 w; w.x = cvt_pk_bf16(v[0], v[1]); w.y = cvt_pk_bf16(v[2], v[3]); w.z = cvt_pk_bf16(v[4], v[5]); w.w = cvt_pk_bf16(v[6], v[7]);
        *(u32x4*)(dst + (size_t)n * K + k0) = w;
    }
}
template <class RM, class SC> __device__ __forceinline__ void convert_t(bf16* dst, int dstK, int koff, const float* src, int Ksrc, int ncol, RM rowmap, SC scale, int gtid, int gsize) {
    const int total = ncol * (Ksrc / 8);
    for (int idx = gtid; idx < total; idx += gsize) {
        const int n = idx % ncol, k0 = (idx / ncol) * 8;
        float v[8];
#pragma unroll
        for (int j = 0; j < 8; ++j) v[j] = src[(size_t)(k0 + j) * ncol + n] * scale(k0 + j);
        u32x4 w; w.x = cvt_pk_bf16(v[0], v[1]); w.y = cvt_pk_bf16(v[2], v[3]); w.z = cvt_pk_bf16(v[4], v[5]); w.w = cvt_pk_bf16(v[6], v[7]);
        *(u32x4*)(dst + (size_t)rowmap(n) * dstK + koff + k0) = w;
    }
}
__device__ __forceinline__ void zero_rows(bf16* dst, size_t nelem, int gtid, int gsize) {
    for (size_t i = (size_t)gtid * 8; i < nelem; i += (size_t)gsize * 8) *(u32x4*)(dst + i) = (u32x4){0u, 0u, 0u, 0u};
}
__device__ __forceinline__ void convert_ffn(const Args& a, int base, int gtid, int gsize) {
    const float* wg = a.in[base + 2]; const float* wu = a.in[base + 3]; const float* wd = a.in[base + 4];
    unsigned char* W = a.ws + WS_W;
    auto one = [](int) { return 1.0f; };
    convert_t((bf16*)(W + W_GU), D, 0, wg, D, FF, [](int n) { return (n >> 7) * 256 + (n & 127); }, one, gtid, gsize);
    convert_t((bf16*)(W + W_GU), D, 0, wu, D, FF, [](int n) { return (n >> 7) * 256 + 128 + (n & 127); }, one, gtid, gsize);
    convert_t((bf16*)(W + W_DN), FF, 0, wd, FF, D, [](int n) { return n; }, one, gtid, gsize);
}
__device__ __forceinline__ void convert_mix0(const Args& a, int gtid, int gsize) {
    const float* win = a.in[I_W_IN]; const float* wout = a.in[I_W_OUT];
    unsigned char* W = a.ws + WS_W;
    auto one = [](int) { return 1.0f; };
    convert_t((bf16*)(W + W_IN), D, 0, win, D, 2840, [](int n) { return n < 512 ? n : (n < 536 ? n - 512 + 2816 : n - 24); }, one, gtid, gsize);
    zero_rows((bf16*)(W + W_IN) + (size_t)2840 * D, (size_t)(PROJ_LD - 2840) * D, gtid, gsize);
    convert_t((bf16*)(W + W_OUT), D, 0, wout, D, D, [](int n) { return n; }, one, gtid, gsize);
}
__device__ __forceinline__ void convert_mix1(const Args& a, int gtid, int gsize) {
    const float* mu = a.in[I_MU];
    unsigned char* W = a.ws + WS_W;
    bf16* Wrkv = (bf16*)(W + W_RKV); bf16* Wl2 = (bf16*)(W + W_L2);
    auto one = [](int) { return 1.0f; };
#define CONV_RKV(srcp, ncol, rowoff, mi) \
    convert_t(Wrkv, 2 * D, 0, srcp, D, ncol, [](int n) { return n + (rowoff); }, [=](int k) { return 1.0f - mu[(mi) * 1024 + k]; }, gtid, gsize); \
    convert_t(Wrkv, 2 * D, D, srcp, D, ncol, [](int n) { return n + (rowoff); }, [=](int k) { return mu[(mi) * 1024 + k]; }, gtid, gsize);
    CONV_RKV(a.in[I_W_R], 1024, 0, 0)
    CONV_RKV(a.in[I_W_K], 1024, 1024, 2)
    CONV_RKV(a.in[I_W_V], 1024, 2048, 3)
    CONV_RKV(a.in[I_DEC1], 64, 3072, 1)
    CONV_RKV(a.in[I_A1], 64, 3136, 4)
    CONV_RKV(a.in[I_G1], 128, 3200, 5)
#undef CONV_RKV
    zero_rows(Wl2, (size_t)EAG_LD * 256, gtid, gsize);
    convert_t((bf16*)(W + W_O), D, 0, a.in[I_W_O], D, D, [](int n) { return n; }, one, gtid, gsize);
}
__device__ __forceinline__ void convert_mix1_l2(const Args& a, int gtid, int gsize) {
    unsigned char* W = a.ws + WS_W; bf16* Wl2 = (bf16*)(W + W_L2);
    auto one = [](int) { return 1.0f; };
    convert_t(Wl2, 256, 0, a.in[I_DEC2], 64, 1024, [](int n) { return n; }, one, gtid, gsize);
    convert_t(Wl2, 256, 64, a.in[I_A2], 64, 1024, [](int n) { return n + 1024; }, one, gtid, gsize);
    convert_t(Wl2, 256, 128, a.in[I_G2], 128, 1024, [](int n) { return n + 2048; }, one, gtid, gsize);
}

template <bool HAS_D, bool HAS_XN>
__device__ __forceinline__ void row_pass(const float* xin, float* xout, const bf16* dd, const float* gpost, float c, const float* gpre, bf16* xn, int gw, int nw, int lane) {
    for (int row = gw; row < M; row += nw) {
        f32x4 x[4];
#pragma unroll
        for (int j = 0; j < 4; ++j) x[j] = *(const f32x4*)(xin + (size_t)row * D + lane * 4 + 256 * j);
        if constexpr (HAS_D) {
            f32x4 d[4]; float ss = 0.f;
#pragma unroll
            for (int j = 0; j < 4; ++j) { const u32x2 w = *(const u32x2*)(dd + (size_t)row * D + lane * 4 + 256 * j); d[j] = (f32x4){bflo(w.x), bfhi(w.x), bflo(w.y), bfhi(w.y)};
                ss += (d[j].x * d[j].x + d[j].y * d[j].y) + (d[j].z * d[j].z + d[j].w * d[j].w); }
            const float rstd = c * rsqrtf(wave_sum(ss) * (1.0f / D) + EPS);
#pragma unroll
            for (int j = 0; j < 4; ++j) { const f32x4 g = *(const f32x4*)(gpost + lane * 4 + 256 * j); x[j] = x[j] + d[j] * g * rstd; *(f32x4*)(xout + (size_t)row * D + lane * 4 + 256 * j) = x[j]; }
        }
        if constexpr (HAS_XN) {
            float ss = 0.f;
#pragma unroll
            for (int j = 0; j < 4; ++j) ss += (x[j].x * x[j].x + x[j].y * x[j].y) + (x[j].z * x[j].z + x[j].w * x[j].w);
            const float rstd = rsqrtf(wave_sum(ss) * (1.0f / D) + EPS);
            const size_t prow = (size_t)row + (row >= SEQ ? 2 : 1);
#pragma unroll
            for (int j = 0; j < 4; ++j) { const f32x4 g = *(const f32x4*)(gpre + lane * 4 + 256 * j); const f32x4 y = x[j] * g * rstd;
                u32x2 w; w.x = cvt_pk_bf16(y.x, y.y); w.y = cvt_pk_bf16(y.z, y.w); *(u32x2*)(xn + prow * D + lane * 4 + 256 * j) = w; }
        }
    }
    if constexpr (HAS_XN) { if (blockIdx.x == 0) { const int t = threadIdx.x; if (t < 256) { u32x4 z = (u32x4){0u, 0u, 0u, 0u}; const size_t prow = (t < 128) ? 0 : (size_t)SEQ + 1; *(u32x4*)(xn + prow * D + (t & 127) * 8) = z; } } }
}

__device__ __forceinline__ void compress_phase(const Args& a, LAS unsigned char* lds) {
    LAS float* xs = (LAS float*)lds;
    LAS float* part = xs + 2048;
    LAS float* hid = part + 512;
    const bf16* proj = (const bf16*)(a.ws + WS_BIG);
    const int tid = threadIdx.x;
    for (int task = blockIdx.x; task < 2 * NB * NCMP * 2; task += gridDim.x) {
        const int g = task & 1, i = (task >> 1) % NCMP, b = ((task >> 1) / NCMP) & 1, kv = (task >> 1) / NCMP / 2;
        const float* pe = a.in[kv ? I_PE_V : I_PE_K]; const float* w1 = a.in[kv ? I_W1_V : I_W1_K]; const float* w2 = a.in[kv ? I_W2_V : I_W2_K];
        const int coff = (kv ? PC_VC : PC_KC) + g * 64;
        for (int e = tid; e < 2048; e += 512) { const int pos = e >> 6, d = e & 63; xs[e] = bf2f(proj[(size_t)(b * SEQ + 16 * i + pos) * PROJ_LD + coff + d]) + pe[e]; }
        __syncthreads();
        { const int p = tid >> 7, n = tid & 127; float acc = 0.f;
            for (int kk = p * 512; kk < p * 512 + 512; ++kk) acc += xs[kk] * w1[(size_t)kk * 128 + n];
            part[p * 128 + n] = acc; }
        __syncthreads();
        if (tid < 128) { const float h = (part[tid] + part[128 + tid]) + (part[256 + tid] + part[384 + tid]);
            const float u = 0.7978845608028654f * (h + 0.044715f * h * h * h); const float e2 = __expf(2.0f * u); const float th = 1.0f - 2.0f / (e2 + 1.0f);
            hid[tid] = 0.5f * h * (1.0f + th); }
        __syncthreads();
        if (tid < 64) { float o = 0.f; for (int n = 0; n < 128; ++n) o += hid[n] * w2[n * 64 + tid];
            bf16* dst = (bf16*)(a.ws + (kv ? WS_VC : WS_KC)); dst[((size_t)(b * NCMP + i) * 2 + g) * 64 + tid] = f2bf(o); }
        __syncthreads();
    }
}

__device__ __forceinline__ void dot4_row(const u32x4* kp, const LAS float* qs, float (&dot)[4]) {
    dot[0] = dot[1] = dot[2] = dot[3] = 0.f;
#pragma unroll
    for (int c = 0; c < 8; ++c) {
        const u32x4 kw = kp[c];
        const float k8[8] = {bflo(kw.x), bfhi(kw.x), bflo(kw.y), bfhi(kw.y), bflo(kw.z), bfhi(kw.z), bflo(kw.w), bfhi(kw.w)};
#pragma unroll
        for (int r = 0; r < 4; ++r) {
            const f32x4 q0 = *(const LAS f32x4*)(qs + r * 64 + c * 8), q1 = *(const LAS f32x4*)(qs + r * 64 + c * 8 + 4);
            float d = dot[r];
            d = fmaf(k8[0], q0.x, d); d = fmaf(k8[1], q0.y, d); d = fmaf(k8[2], q0.z, d); d = fmaf(k8[3], q0.w, d);
            d = fmaf(k8[4], q1.x, d); d = fmaf(k8[5], q1.y, d); d = fmaf(k8[6], q1.z, d); d = fmaf(k8[7], q1.w, d);
            dot[r] = d;
        }
        __builtin_amdgcn_sched_barrier(0);
    }
}
__device__ __forceinline__ void softmax4(LAS float* sc, int n, int lane) {
    f32x4 mx = (f32x4){-INFINITY, -INFINITY, -INFINITY, -INFINITY};
#pragma unroll 1
    for (int i = lane; i < n; i += 64) { const f32x4 s = *(const LAS f32x4*)(sc + i * 4); mx.x = fmaxf(mx.x, s.x); mx.y = fmaxf(mx.y, s.y); mx.z = fmaxf(mx.z, s.z); mx.w = fmaxf(mx.w, s.w); }
    mx.x = wave_max(mx.x); mx.y = wave_max(mx.y); mx.z = wave_max(mx.z); mx.w = wave_max(mx.w);
    if (!(mx.x > -INFINITY)) mx.x = 0.f; if (!(mx.y > -INFINITY)) mx.y = 0.f; if (!(mx.z > -INFINITY)) mx.z = 0.f; if (!(mx.w > -INFINITY)) mx.w = 0.f;
    f32x4 sm = (f32x4){0.f, 0.f, 0.f, 0.f};
#pragma unroll 1
    for (int i = lane; i < n; i += 64) { f32x4 s = *(const LAS f32x4*)(sc + i * 4); s.x = __expf(s.x - mx.x); s.y = __expf(s.y - mx.y); s.z = __expf(s.z - mx.z); s.w = __expf(s.w - mx.w);
        sm += s; *(LAS f32x4*)(sc + i * 4) = s; }
    sm.x = wave_sum(sm.x); sm.y = wave_sum(sm.y); sm.z = wave_sum(sm.z); sm.w = wave_sum(sm.w);
    const f32x4 inv = (f32x4){1.0f / fmaxf(sm.x, 1e-30f), 1.0f / fmaxf(sm.y, 1e-30f), 1.0f / fmaxf(sm.z, 1e-30f), 1.0f / fmaxf(sm.w, 1e-30f)};
#pragma unroll 1
    for (int i = lane; i < n; i += 64) { f32x4 s = *(const LAS f32x4*)(sc + i * 4); *(LAS f32x4*)(sc + i * 4) = s * inv; }
}

__device__ __forceinline__ void nsa_phase(const Args& a, LAS unsigned char* lds) {
    const int tid = threadIdx.x, wave = tid >> 6, lane = tid & 63;
    LAS float* sc0 = (LAS float*)(lds + wave * 18432);
    LAS float* qs0 = sc0 + 4096;
    LAS int* sel0 = (LAS int*)(qs0 + 256);
    const bf16* proj = (const bf16*)(a.ws + WS_BIG);
    const bf16* KC = (const bf16*)(a.ws + WS_KC); const bf16* VC = (const bf16*)(a.ws + WS_VC);
    bf16* att = (bf16*)(a.ws + WS_Y);
    const int gw = blockIdx.x * 8 + wave, nw = gridDim.x * 8;
    for (int task = gw; task < NB * 2 * SEQ; task += nw) {
        LAS float* sc = sc0; LAS float* qs = qs0; LAS int* sel = sel0;
        asm volatile("" : "+v"(sc), "+v"(qs), "+v"(sel));
        const int t = task & (SEQ - 1), g = (task >> 14) & 1, b = task >> 15;
        const size_t tok = (size_t)b * SEQ + t;
        float slope[4];
#pragma unroll
        for (int r = 0; r < 4; ++r) { slope[r] = exp2f(-(float)(g * 4 + r + 1)); qs[r * 64 + lane] = bf2f(proj[tok * PROJ_LD + PC_Q + (g * 4 + r) * 64 + lane]) * 0.125f; }
        float gate[12];
#pragma unroll
        for (int j = 0; j < 12; ++j) gate[j] = sigmoidf_(bf2f(proj[tok * PROJ_LD + PC_G + g * 12 + j]));
        const int ncv = (t >= 31) ? ((t - 31) >> 4) + 1 : 0;
#pragma unroll 1
        for (int base = 0; base < ncv; base += 64) {
            const int n = base + lane;
            if (n < ncv) {
                float dot[4]; dot4_row((const u32x4*)(KC + ((size_t)(b * NCMP + n) * 2 + g) * 64), qs, dot);
                const float dist = (float)(t - (16 * n + 31));
                *(LAS f32x4*)(sc + n * 4) = (f32x4){dot[0] - slope[0] * dist, dot[1] - slope[1] * dist, dot[2] - slope[2] * dist, dot[3] - slope[3] * dist};
            }
        }
        softmax4(sc, ncv, lane);
        float ocmp[4] = {0.f, 0.f, 0.f, 0.f};
#pragma unroll 4
        for (int n = 0; n < ncv; ++n) { const f32x4 p = *(const LAS f32x4*)(sc + n * 4); const float v = bf2f(VC[((size_t)(b * NCMP + n) * 2 + g) * 64 + lane]);
            ocmp[0] += p.x * v; ocmp[1] += p.y * v; ocmp[2] += p.z * v; ocmp[3] += p.w * v; }
        const int blk_t = t >> 6;
        float val[4];
#pragma unroll
        for (int i = 0; i < 4; ++i) {
            const int j = lane + 64 * i;
            float ps[5];
#pragma unroll
            for (int q = 0; q < 5; ++q) { const int n = 4 * j - 1 + q; if (n >= 0 && n < ncv) { const f32x4 p = *(const LAS f32x4*)(sc + n * 4); ps[q] = ((p.x + p.y) + p.z) + p.w; } else ps[q] = 0.f; }
            float v = (((ps[1] + ps[2]) + ps[3]) + ps[4]) - 0.5f * ps[4] + 0.5f * ps[0];
            const bool forced = (j == 0) || (j == blk_t) || (j == blk_t - 1);
            val[i] = (j <= blk_t && !forced) ? v : -INFINITY;
        }
        const int nsel = blk_t + 1 < 16 ? blk_t + 1 : 16;
        int nf = 0;
        if (lane == 0) { sel[0] = blk_t; int q = 1; if (blk_t >= 1) sel[q++] = blk_t - 1; if (blk_t >= 2) sel[q++] = 0; }
        nf = 1 + (blk_t >= 1 ? 1 : 0) + (blk_t >= 2 ? 1 : 0);
#pragma unroll 1
        for (int k = nf; k < nsel; ++k) {
            float bv = val[0]; int bj = lane;
#pragma unroll
            for (int i = 1; i < 4; ++i) if (val[i] > bv) { bv = val[i]; bj = lane + 64 * i; }
#pragma unroll
            for (int o = 1; o < 64; o <<= 1) { const float ov = __shfl_xor(bv, o); const int oj = __shfl_xor(bj, o); if (ov > bv || (ov == bv && oj < bj)) { bv = ov; bj = oj; } }
            if ((bj & 63) == lane) {
#pragma unroll
                for (int i = 0; i < 4; ++i) if ((bj >> 6) == i) val[i] = -INFINITY;
            }
            if (lane == 0) sel[k] = bj;
        }
#pragma unroll 1
        for (int k = 0; k < nsel; ++k) {
            const int j = sel[k], pos = 64 * j + lane, dd = t - pos;
            f32x4 s = (f32x4){-INFINITY, -INFINITY, -INFINITY, -INFINITY};
            if (dd >= 0) { float dot[4]; dot4_row((const u32x4*)(proj + ((size_t)b * SEQ + pos) * PROJ_LD + PC_KS + g * 64), qs, dot); const float dist = (float)dd;
                s = (f32x4){dot[0] - slope[0] * dist, dot[1] - slope[1] * dist, dot[2] - slope[2] * dist, dot[3] - slope[3] * dist}; }
            *(LAS f32x4*)(sc + (k * 64 + lane) * 4) = s;
        }
        softmax4(sc, nsel * 64, lane);
        float oslc[4] = {0.f, 0.f, 0.f, 0.f};
#pragma unroll 1
        for (int k = 0; k < nsel; ++k) {
            const int j = sel[k];
#pragma unroll 4
            for (int i = 0; i < 64; ++i) { const f32x4 p = *(const LAS f32x4*)(sc + (k * 64 + i) * 4); const float v = bf2f(proj[((size_t)b * SEQ + 64 * j + i) * PROJ_LD + PC_VS + g * 64 + lane]);
                oslc[0] += p.x * v; oslc[1] += p.y * v; oslc[2] += p.z * v; oslc[3] += p.w * v; }
        }
#pragma unroll 1
        for (int base = 0; base < 512; base += 64) {
            const int idx = base + lane, pos = t - 511 + idx;
            f32x4 s = (f32x4){-INFINITY, -INFINITY, -INFINITY, -INFINITY};
            if (pos >= 0) { float dot[4]; dot4_row((const u32x4*)(proj + ((size_t)b * SEQ + pos) * PROJ_LD + PC_KW + g * 64), qs, dot); const float dist = (float)(511 - idx);
                s = (f32x4){dot[0] - slope[0] * dist, dot[1] - slope[1] * dist, dot[2] - slope[2] * dist, dot[3] - slope[3] * dist}; }
            *(LAS f32x4*)(sc + idx * 4) = s;
        }
        softmax4(sc, 512, lane);
        float owin[4] = {0.f, 0.f, 0.f, 0.f};
        { const int i0 = t >= 511 ? 0 : 511 - t;
#pragma unroll 4
            for (int idx = i0; idx < 512; ++idx) { const f32x4 p = *(const LAS f32x4*)(sc + idx * 4); const float v = bf2f(proj[((size_t)b * SEQ + t - 511 + idx) * PROJ_LD + PC_VW + g * 64 + lane]);
                owin[0] += p.x * v; owin[1] += p.y * v; owin[2] += p.z * v; owin[3] += p.w * v; } }
#pragma unroll
        for (int r = 0; r < 4; ++r) att[tok * D + (g * 4 + r) * 64 + lane] = f2bf(gate[r * 3 + 0] * ocmp[r] + gate[r * 3 + 1] * oslc[r] + gate[r * 3 + 2] * owin[r]);
    }
    {
        const float* cw = a.in[I_CONV_W]; const float* cbias = a.in[I_CONV_B];
        const int gt = blockIdx.x * 512 + tid, gs = gridDim.x * 512;
        for (int idx = gt; idx < M * 512; idx += gs) {
            const int c = idx & 511; const int tok = idx >> 9, t = tok & (SEQ - 1);
            const bf16* p = proj + (size_t)tok * PROJ_LD;
            float y = cbias[c] + cw[2 * 512 + c] * (bf2f(p[PC_CC + c]) * bf2f(p[PC_CU + c]));
            if (t >= 1) y += cw[512 + c] * (bf2f(p[PC_CC + c - PROJ_LD]) * bf2f(p[PC_CU + c - PROJ_LD]));
            if (t >= 2) y += cw[c] * (bf2f(p[PC_CC + c - 2 * PROJ_LD]) * bf2f(p[PC_CU + c - 2 * PROJ_LD]));
            att[(size_t)tok * D + 512 + c] = f2bf(bf2f(p[PC_CB + c]) * y);
        }
    }
}

constexpr int SC_TB = 32;
__device__ __forceinline__ void scan_phase(const Args& a, LAS unsigned char* lds) {
    const int tid = threadIdx.x, wave = tid >> 6, lane = tid & 63;
    if (wave != 0) return;
    LAS float* Wd = (LAS float*)lds;
    LAS float* KK = Wd + SC_TB * 64; LAS float* BB = KK + SC_TB * 64; LAS float* KP = BB + SC_TB * 64; LAS float* RR = KP + SC_TB * 64; LAS float* VV = RR + SC_TB * 64; LAS float* GG = VV + SC_TB * 64;
    LAS float* Yt = GG + SC_TB * 64;
    LAS float* RK = Yt + SC_TB * 65;
    LAS float* MR = RK + SC_TB;
    const bf16* rkv = (const bf16*)(a.ws + WS_BIG); const bf16* eag = (const bf16*)(a.ws + WS_EAG);
    bf16* yo = (bf16*)(a.ws + WS_Y);
    for (int task = blockIdx.x; task < NB * 16; task += gridDim.x) {
        const int b = task >> 4, h = task & 15, ch = h * 64 + lane;
        const float kk_c = a.in[I_K_K][ch], ka_c = a.in[I_K_A][ch], rk_c = a.in[I_R_K][ch], lg = a.in[I_LNX_G][ch], lb = a.in[I_LNX_B][ch];
        f32x2 S[32];
#pragma unroll
        for (int j = 0; j < 32; ++j) S[j] = (f32x2){0.f, 0.f};
        for (int t0 = 0; t0 < SEQ; t0 += SC_TB) {
            for (int s = 0; s < SC_TB; ++s) {
                const size_t tok = (size_t)b * SEQ + t0 + s;
                const float r = bf2f(rkv[tok * RKV_LD + ch]), k = bf2f(rkv[tok * RKV_LD + 1024 + ch]), v = bf2f(rkv[tok * RKV_LD + 2048 + ch]);
                const float e = bf2f(eag[tok * EAG_LD + ch]), al = bf2f(eag[tok * EAG_LD + 1024 + ch]), gg = bf2f(eag[tok * EAG_LD + 2048 + ch]);
                const float kkr = k * kk_c; const float ss = wave_sum(kkr * kkr); const float kk = kkr * rsqrtf(fmaxf(ss, 1e-12f));
                const float kp = k * (1.0f + (al - 1.0f) * ka_c);
                const float rk = wave_sum(r * kp * rk_c);
                Wd[s * 64 + lane] = __expf(-e); KK[s * 64 + lane] = kk; BB[s * 64 + lane] = kk * al; KP[s * 64 + lane] = kp; RR[s * 64 + lane] = r; VV[s * 64 + lane] = v; GG[s * 64 + lane] = gg;
                if (lane == 0) RK[s] = rk;
            }
            for (int s = 0; s < SC_TB; ++s) {
                const float vi = VV[s * 64 + lane];
                f32x2 sa2 = (f32x2){0.f, 0.f};
#pragma unroll
                for (int j = 0; j < 32; j += 2) { const f32x4 kk4 = *(const LAS f32x4*)(KK + s * 64 + j * 2); sa2 += S[j] * (f32x2){kk4.x, kk4.y}; sa2 += S[j + 1] * (f32x2){kk4.z, kk4.w}; }
                const float sa = -(sa2.x + sa2.y);
                f32x2 y2 = (f32x2){0.f, 0.f};
#pragma unroll
                for (int j = 0; j < 32; j += 2) {
                    const f32x4 w4 = *(const LAS f32x4*)(Wd + s * 64 + j * 2), b4 = *(const LAS f32x4*)(BB + s * 64 + j * 2), k4 = *(const LAS f32x4*)(KP + s * 64 + j * 2), r4 = *(const LAS f32x4*)(RR + s * 64 + j * 2);
                    S[j] = S[j] * (f32x2){w4.x, w4.y} + (f32x2){b4.x, b4.y} * sa + (f32x2){k4.x, k4.y} * vi;
                    S[j + 1] = S[j + 1] * (f32x2){w4.z, w4.w} + (f32x2){b4.z, b4.w} * sa + (f32x2){k4.z, k4.w} * vi;
                    y2 += S[j] * (f32x2){r4.x, r4.y}; y2 += S[j + 1] * (f32x2){r4.z, r4.w};
                }
                Yt[s * 65 + lane] = y2.x + y2.y;
            }
            if (lane < SC_TB) { float m = 0.f; for (int i = 0; i < 64; ++i) m += Yt[lane * 65 + i]; m *= (1.0f / 64.0f); float q = 0.f; for (int i = 0; i < 64; ++i) { const float d = Yt[lane * 65 + i] - m; q += d * d; }
                MR[lane] = m; MR[SC_TB + lane] = rsqrtf(q * (1.0f / 64.0f) + 64e-5f); }
            for (int s = 0; s < SC_TB; ++s) {
                const size_t tok = (size_t)b * SEQ + t0 + s;
                const float o = ((Yt[s * 65 + lane] - MR[s]) * MR[SC_TB + s] * lg + lb + RK[s] * VV[s * 64 + lane]) * GG[s * 64 + lane];
                yo[tok * D + ch] = f2bf(o);
            }
        }
    }
}

constexpr int N_PHASES = 23;
__global__ void __launch_bounds__(512, 2) mk_fwd(Args args) {
    extern __shared__ __attribute__((aligned(16))) unsigned char lds_raw[];
    LAS unsigned char* lds = (LAS unsigned char*)lds_raw;
    const int tid = threadIdx.x, lane = tid & 63, wave = __builtin_amdgcn_readfirstlane(tid >> 6);
    const int G = gridDim.x, gw = blockIdx.x * 8 + wave, nw = G * 8, gtid = blockIdx.x * 512 + tid, gsize = G * 512;
    unsigned char* ws = args.ws;
    volatile LAS unsigned* lctl = (volatile LAS unsigned*)(lds + LDS_CTL_OFF);
    if (tid < 16) lctl[tid] = 0u;
    __syncthreads();
    const int lo = args.ph_lo, hi = args.ph_hi;
    XcdBarrier bar; bar.bar = (unsigned*)(ws + WS_CTL) + CW_BAR; bar.x = 0; bar.st = nullptr;
    if (hi - lo > 1) bar = xcd_barrier_post((unsigned*)(ws + WS_CTL) + CW_BAR, lctl + 8);
#define IN(k) (lo <= (k) && (k) < hi)
#define SEAM(k) do { if (IN(k) && IN((k) + 1)) xcd_barrier(bar); } while (0)
    float* X = args.out;
    bf16* XNp = (bf16*)(ws + WS_XN);
    const pg8::bf16_t* XNa = (const pg8::bf16_t*)(ws + WS_XN) + D;
    bf16* DD = (bf16*)(ws + WS_DD);
    pg8::bf16_t* BIG = (pg8::bf16_t*)(ws + WS_BIG);
    pg8::bf16_t* YY = (pg8::bf16_t*)(ws + WS_Y);
    const pg8::bf16_t* Wb = (const pg8::bf16_t*)(ws + WS_W);

#define FFN_G1(k) if (IN(k)) { pg8::Gemm g{XNa, (const pg8::bf16_t*)((const unsigned char*)Wb + W_GU), M, 2 * FF, D, D, 1, D / 64}; pg8::StaticOrder S; S.init(M, 2 * FF, G, (int)blockIdx.x); \
        pg8::Epi<1> E{BIG, FF, nullptr, nullptr}; pg8::gemm_phase(lds, g, S, E); } SEAM(k);
#define FFN_G2(k) if (IN(k)) { pg8::Gemm g{BIG, (const pg8::bf16_t*)((const unsigned char*)Wb + W_DN), M, D, FF, FF, 0, FF / 64}; pg8::StaticOrder S; S.init(M, D, G, (int)blockIdx.x); \
        pg8::Epi<0> E{(pg8::bf16_t*)DD, D, nullptr, nullptr}; pg8::gemm_phase(lds, g, S, E); } SEAM(k);

    if (IN(0)) { row_pass<false, true>(args.in[I_X], nullptr, nullptr, nullptr, 0.f, args.in[I_L0F1 + 0], XNp, gw, nw, lane); convert_ffn(args, I_L0F1, gtid, gsize); } SEAM(0);
    FFN_G1(1) FFN_G2(2)
    if (IN(3)) { row_pass<true, true>(args.in[I_X], X, DD, args.in[I_L0F1 + 1], 0.5f, args.in[I_L0_MIX_PRE], XNp, gw, nw, lane); convert_mix0(args, gtid, gsize); } SEAM(3);
    if (IN(4)) { pg8::Gemm g{XNa, (const pg8::bf16_t*)((const unsigned char*)Wb + W_IN), M, PROJ_LD, D, D, 1, D / 64}; pg8::StaticOrder S; S.init(M, PROJ_LD, G, (int)blockIdx.x);
        pg8::Epi<0> E{BIG, PROJ_LD, nullptr, nullptr}; pg8::gemm_phase(lds, g, S, E); } SEAM(4);
    if (IN(5)) { compress_phase(args, lds); } SEAM(5);
    if (IN(6)) { nsa_phase(args, lds); } SEAM(6);
    if (IN(7)) { pg8::Gemm g{YY, (const pg8::bf16_t*)((const unsigned char*)Wb + W_OUT), M, D, D, D, 0, D / 64}; pg8::StaticOrder S; S.init(M, D, G, (int)blockIdx.x);
        pg8::Epi<0> E{(pg8::bf16_t*)DD, D, nullptr, nullptr}; pg8::gemm_phase(lds, g, S, E); } SEAM(7);
    if (IN(8)) { row_pass<true, true>(X, X, DD, args.in[I_L0_MIX_POST], 1.0f, args.in[I_L0F2 + 0], XNp, gw, nw, lane); convert_ffn(args, I_L0F2, gtid, gsize); } SEAM(8);
    FFN_G1(9) FFN_G2(10)
    if (IN(11)) { row_pass<true, true>(X, X, DD, args.in[I_L0F2 + 1], 0.5f, args.in[I_L1F1 + 0], XNp, gw, nw, lane); convert_ffn(args, I_L1F1, gtid, gsize); } SEAM(11);
    FFN_G1(12) FFN_G2(13)
    if (IN(14)) { row_pass<true, true>(X, X, DD, args.in[I_L1F1 + 1], 0.5f, args.in[I_L1_MIX_PRE], XNp, gw, nw, lane); convert_mix1(args, gtid, gsize); } SEAM(14);
    if (IN(15)) { pg8::Gemm g{XNa, (const pg8::bf16_t*)((const unsigned char*)Wb + W_RKV), M, RKV_LD, 2 * D, D, 1, D / 64}; pg8::StaticOrder S; S.init(M, RKV_LD, G, (int)blockIdx.x);
        pg8::Epi<2> E{BIG, RKV_LD, nullptr, nullptr}; pg8::gemm_phase(lds, g, S, E); convert_mix1_l2(args, gtid, gsize); } SEAM(15);
    if (IN(16)) { pg8::Gemm g{BIG + 3072, (const pg8::bf16_t*)((const unsigned char*)Wb + W_L2), M, EAG_LD, 256, RKV_LD, 0, 4}; pg8::StaticOrder S; S.init(M, EAG_LD, G, (int)blockIdx.x);
        pg8::Epi<3> E{(pg8::bf16_t*)(ws + WS_EAG), EAG_LD, args.in[I_W0], args.in[I_A0]}; pg8::gemm_phase(lds, g, S, E); } SEAM(16);
    if (IN(17)) { scan_phase(args, lds); } SEAM(17);
    if (IN(18)) { pg8::Gemm g{YY, (const pg8::bf16_t*)((const unsigned char*)Wb + W_O), M, D, D, D, 0, D / 64}; pg8::StaticOrder S; S.init(M, D, G, (int)blockIdx.x);
        pg8::Epi<0> E{(pg8::bf16_t*)DD, D, nullptr, nullptr}; pg8::gemm_phase(lds, g, S, E); } SEAM(18);
    if (IN(19)) { row_pass<true, true>(X, X, DD, args.in[I_L1_MIX_POST], 1.0f, args.in[I_L1F2 + 0], XNp, gw, nw, lane); convert_ffn(args, I_L1F2, gtid, gsize); } SEAM(19);
    FFN_G1(20) FFN_G2(21)
    if (IN(22)) { row_pass<true, false>(X, X, DD, args.in[I_L1F2 + 1], 0.5f, nullptr, nullptr, gw, nw, lane); }
#undef IN
#undef SEAM
}

extern "C" void kernel_launch(void* const* d_in, const int* in_sizes, int n_in, void* d_out, int out_size, void* d_ws, size_t ws_size, hipStream_t stream) {
    static int grid = 0;
    if (grid == 0) {
        if (n_in != 53 || out_size != M * D || ws_size < WS_END) { fprintf(stderr, "kernel_launch: unexpected shapes (n_in %d, out %d, ws %zu)\n", n_in, out_size, ws_size); grid = -1; return; }
        int dev = 0, cus = 0;
        if (hipGetDevice(&dev) != hipSuccess || hipDeviceGetAttribute(&cus, hipDeviceAttributeMultiprocessorCount, dev) != hipSuccess) { grid = -1; return; }
        if (hipFuncSetAttribute((const void*)mk_fwd, hipFuncAttributeMaxDynamicSharedMemorySize, LDS_BYTES) != hipSuccess) { fprintf(stderr, "kernel_launch: hipFuncSetAttribute failed\n"); grid = -1; return; }
        int per_cu = 0;
        if (hipOccupancyMaxActiveBlocksPerMultiprocessor(&per_cu, (const void*)mk_fwd, 512, LDS_BYTES) != hipSuccess || per_cu < 1) { fprintf(stderr, "kernel_launch: occupancy query says %d\n", per_cu); }
        (void)hipGetLastError();
        grid = cus;
    }
    if (grid < 0) return;
    (void)hipMemsetAsync((char*)d_ws + WS_CTL, 0, CTL_ZERO_BYTES, stream);
    Args a{};
    for (int i = 0; i < 53; ++i) a.in[i] = (const float*)d_in[i];
    a.out = (float*)d_out; a.ws = (unsigned char*)d_ws;
#if MK_ONE_LAUNCH
    a.ph_lo = 0; a.ph_hi = N_PHASES;
    hipLaunchKernelGGL(mk_fwd, dim3(grid), dim3(512), LDS_BYTES, stream, a);
#else
    for (int p = 0; p < N_PHASES; ++p) { a.ph_lo = p; a.ph_hi = p + 1; hipLaunchKernelGGL(mk_fwd, dim3(grid), dim3(512), LDS_BYTES, stream, a); }
#endif
}
```

```cpp
#include <hip/hip_runtime.h>
#include <cstdio>
#include <cstdint>

#ifndef MK_ONE_LAUNCH
#define MK_ONE_LAUNCH 1
#endif

#define LAS __attribute__((address_space(3)))
typedef unsigned short bf16;
typedef short bf16x8 __attribute__((ext_vector_type(8)));
typedef float f32x4 __attribute__((ext_vector_type(4)));
typedef float f32x2 __attribute__((ext_vector_type(2)));
typedef unsigned u32x4 __attribute__((ext_vector_type(4)));
typedef unsigned u32x2 __attribute__((ext_vector_type(2)));

constexpr int NB = 2, SEQ = 16384, M = NB * SEQ, D = 1024, FF = 2816;
constexpr int NCMP = 1023, NSLC = 256;
constexpr int PROJ_LD = 3072;
constexpr int PC_Q = 0, PC_KC = 512, PC_VC = 640, PC_KS = 768, PC_VS = 896, PC_KW = 1024, PC_VW = 1152, PC_CB = 1280, PC_CC = 1792, PC_CU = 2304, PC_G = 2816;
constexpr int RKV_LD = 3328;
constexpr int EAG_LD = 3072;
constexpr float EPS = 1e-6f;

constexpr size_t MiB = 1u << 20;
constexpr size_t WS_CTL = 0, CTL_ZERO_BYTES = 1 * MiB;
constexpr size_t WS_KC = 1 * MiB, WS_VC = 2 * MiB;
constexpr size_t WS_W = 8 * MiB;
constexpr size_t WS_BIG = 28 * MiB;
constexpr size_t WS_EAG = 236 * MiB;
constexpr size_t WS_XN = 236 * MiB;
constexpr size_t WS_DD = 302 * MiB;
constexpr size_t WS_ATT = 236 * MiB;
constexpr size_t WS_Y = 428 * MiB;
constexpr size_t WS_PQ = 428 * MiB;
constexpr size_t WS_XR = 302 * MiB, WS_XK = 366 * MiB, WS_XV = 430 * MiB;
constexpr size_t WS_RKS = 494 * MiB;
constexpr size_t WS_END = 496 * MiB;
constexpr size_t W_GU = 0, W_DN = 11 * MiB;
constexpr size_t W_IN = 0, W_OUT = 6 * MiB, W_CMP = 8 * MiB;
constexpr size_t WS_PEB = 1 * MiB + 768 * 1024;
constexpr size_t W_R = 0, W_K = 2 * MiB, W_V = 4 * MiB, W_LORA = 6 * MiB, W_L2 = 13 * MiB, W_O = 15 * MiB;

constexpr int CW_BAR = 4096;

constexpr int LDS_CTL_OFF = 147456;
constexpr int LDS_BYTES = 147456 + 256;

__device__ __forceinline__ float bf2f(bf16 b) { return __uint_as_float(((unsigned)b) << 16); }
__device__ __forceinline__ float bflo(unsigned u) { return __uint_as_float(u << 16); }
__device__ __forceinline__ float bfhi(unsigned u) { return __uint_as_float(u & 0xffff0000u); }
typedef __bf16 nbf16x2 __attribute__((ext_vector_type(2)));
typedef float nf32x2 __attribute__((ext_vector_type(2)));
__device__ __forceinline__ unsigned cvt_pk_bf16(float lo, float hi) { const nf32x2 v = {lo, hi}; return __builtin_bit_cast(unsigned, __builtin_convertvector(v, nbf16x2)); }
__device__ __forceinline__ bf16 f2bf(float f) { return (bf16)(cvt_pk_bf16(f, 0.f) & 0xffffu); }
__device__ __forceinline__ float wave_sum(float v) {
#pragma unroll
    for (int o = 1; o < 64; o <<= 1) v += __shfl_xor(v, o);
    return v;
}
template <int CTRL, int ROWMASK> __device__ __forceinline__ float dpp_add(float x) { const int t = __builtin_amdgcn_update_dpp(0, __float_as_int(x), CTRL, ROWMASK, 0xF, false); return x + __int_as_float(t); }
__device__ __forceinline__ float wave_sum_dpp(float v) {
    v = dpp_add<0xB1, 0xF>(v); v = dpp_add<0x4E, 0xF>(v); v = dpp_add<0x124, 0xF>(v); v = dpp_add<0x128, 0xF>(v);
    v = dpp_add<0x142, 0xA>(v); v = dpp_add<0x143, 0xC>(v);
    return __int_as_float(__builtin_amdgcn_readlane(__float_as_int(v), 63));
}
template <int CTRL> __device__ __forceinline__ float dpp_mov(float x) { return __int_as_float(__builtin_amdgcn_mov_dpp(__float_as_int(x), CTRL, 0xf, 0xf, true)); }
template <int CTRL> __device__ __forceinline__ int dpp_movi(int x) { return __builtin_amdgcn_mov_dpp(x, CTRL, 0xf, 0xf, true); }
__device__ __forceinline__ float xor32_max(float x) { auto rr = __builtin_amdgcn_permlane32_swap(__float_as_uint(x), __float_as_uint(x), false, false); return fmaxf(__uint_as_float(rr[0]), __uint_as_float(rr[1])); }
__device__ __forceinline__ float xor32_sum(float x) { auto rr = __builtin_amdgcn_permlane32_swap(__float_as_uint(x), __float_as_uint(x), false, false); return __uint_as_float(rr[0]) + __uint_as_float(rr[1]); }
__device__ __forceinline__ float red8(float v) { v += dpp_mov<0xB1>(v); v += dpp_mov<0x4E>(v); v += dpp_mov<0x141>(v); return v; }
__device__ __forceinline__ float wave_max(float v) {
#pragma unroll
    for (int o = 1; o < 64; o <<= 1) v = fmaxf(v, __shfl_xor(v, o));
    return v;
}
__device__ __forceinline__ float sigmoidf_(float x) { return __builtin_amdgcn_rcpf(1.0f + __expf(-x)); }

namespace pg8 {
#define PG8_LAS __attribute__((address_space(3)))
typedef unsigned short bf16_t;
constexpr int BM = 256, BK = 64, HALF = 128, HTB = HALF * BK * 2, STAGE_BYTES = 8 * HTB, NXCD = 8, WGM = 8;

__host__ __device__ __forceinline__ int lds_byte(int r, int c) { const int st = (r >> 4) * 2 + (c >> 5), rr = r & 15, cc = c & 31, ob = rr * 64 + cc * 2; return st * 1024 + (ob ^ (((ob >> 9) & 1) << 5)); }
__host__ __device__ __forceinline__ void stage_rc(int b, int& R, int& C) { const int st = b / 1024, sb = b % 1024, swz = sb ^ (((sb >> 9) & 1) << 5); R = (st >> 1) * 16 + swz / 64; C = (st & 1) * 32 + (swz % 64) / 2; }
__host__ __device__ __forceinline__ int perm32(int rho) { const int n = rho >> 4, i = rho & 15; return 8 * (i >> 2) + 4 * n + (i & 3); }

struct Unit { int pm, pn; };
struct Gemm { const bf16_t* A; const bf16_t* Bt; int M, N, K, lda, gap, ts, ldb = 0; };

struct StaticOrder {
    int nM, nN, nwg, G, c, rev = 0;
    __host__ __device__ void init(int M_, int N_, int G_, int c_) { nM = M_ / BM; nN = N_ / BM; nwg = nM * nN; G = G_; c = c_; }
    __host__ __device__ bool next(int i, Unit& u) const {
        const int rounds = nwg / G; const bool flip = rev && rounds * G == nwg;
        if (flip && i >= rounds) return false;
        const long L = (long)(flip ? rounds - 1 - i : i) * G + c; if (L >= nwg) return false;
        int wgid = (int)L; { const int q = nwg / NXCD, r = nwg % NXCD, xcd = wgid % NXCD, off = wgid / NXCD; wgid = (xcd < r ? xcd * (q + 1) : r * (q + 1) + (xcd - r) * q) + off; }
        const int nig = WGM * nN, gid = wgid / nig, fm = gid * WGM, gsz = (nM - fm) < WGM ? (nM - fm) : WGM;
        u.pm = fm + ((wgid % nig) % gsz); u.pn = (wgid % nig) / gsz; return true;
    }
    __device__ __forceinline__ void a_ready(const Unit&) const {}
    __device__ __forceinline__ void done(const Unit&) const {}
};

struct SplitTiles {
    int G, c, n;
    __host__ __device__ bool next(int i, Unit& u) const { const int L = i * G + c; if (L >= n) return false; u.pm = L & 31; u.pn = L >> 5; return true; }
    __device__ __forceinline__ void a_ready(const Unit&) const {}
    __device__ __forceinline__ void done(const Unit&) const {}
};

template <int MODE> struct Epi {
    static constexpr bool PERM = true, AFTER_DRAIN = false;
    bf16_t* O; int ldc; const float* b0; const float* b1;
    __device__ __forceinline__ void operator()(const f32x4 (&acc)[2][2][4][2], const Unit& u, int wr, int wc, int, int) const {
        int ln_ = threadIdx.x; asm volatile("" : "+v"(ln_));
        const int fr = ln_ & 15, fq = (ln_ >> 4) & 3;
        if constexpr (MODE == 4 || MODE == 6) {
            const int row0 = u.pm * BM + wr * 64 + fr;
            const int kv = u.pm >> 4, col0 = wc * 32 + 8 * fq; float* H = (float*)O + (MODE == 6 ? (size_t)u.pn * 8192 * 128 : (size_t)0);
#pragma unroll
            for (int ai = 0; ai < 2; ++ai)
#pragma unroll
                for (int m = 0; m < 4; ++m) {
                    float o[8];
#pragma unroll
                    for (int n = 0; n < 2; ++n)
#pragma unroll
                        for (int j = 0; j < 4; ++j) {
                            if constexpr (MODE == 6) o[n * 4 + j] = kv ? acc[ai][1][m][n][j] : acc[ai][0][m][n][j];
                            else { const float hh = (kv ? acc[ai][1][m][n][j] : acc[ai][0][m][n][j]) + b0[kv * 128 + col0 + n * 4 + j];
                                const float uu = 0.7978845608028654f * (hh + 0.044715f * hh * hh * hh); const float e2 = __expf(2.0f * uu); o[n * 4 + j] = 0.5f * hh * (2.0f - 2.0f * __builtin_amdgcn_rcpf(e2 + 1.0f)); } }
                    float* hp = H + (size_t)(row0 + ai * HALF + m * 16) * 128 + col0;
                    *(f32x4*)hp = (f32x4){o[0], o[1], o[2], o[3]}; *(f32x4*)(hp + 4) = (f32x4){o[4], o[5], o[6], o[7]};
                }
        } else if constexpr (MODE == 1) {
            const int row0 = u.pm * BM + wr * 64 + fr;
            const int col0 = u.pn * HALF + wc * 32 + 8 * fq;
#pragma unroll
            for (int ai = 0; ai < 2; ++ai)
#pragma unroll
                for (int m = 0; m < 4; ++m) {
                    float o[8];
#pragma unroll
                    for (int n = 0; n < 2; ++n)
#pragma unroll
                        for (int j = 0; j < 4; ++j) { const float g = acc[ai][0][m][n][j], up = acc[ai][1][m][n][j]; o[n * 4 + j] = g * __builtin_amdgcn_rcpf(1.0f + __expf(-g)) * up; }
                    u32x4 w; w.x = cvt_pk_bf16(o[0], o[1]); w.y = cvt_pk_bf16(o[2], o[3]); w.z = cvt_pk_bf16(o[4], o[5]); w.w = cvt_pk_bf16(o[6], o[7]);
                    *(u32x4*)(O + (size_t)(row0 + ai * HALF + m * 16) * ldc + col0) = w;
                }
        } else {
            const int row0 = u.pm * BM + wr * 64 + fr;
            const int col0 = u.pn * BM + wc * 32 + 8 * fq;
#pragma unroll
            for (int ai = 0; ai < 2; ++ai)
#pragma unroll
                for (int m = 0; m < 4; ++m) {
                    bf16_t* rowp = O + (size_t)(row0 + ai * HALF + m * 16) * ldc + col0;
#pragma unroll
                    for (int bj = 0; bj < 2; ++bj) {
                        float o[8];
#pragma unroll
                        for (int n = 0; n < 2; ++n)
#pragma unroll
                            for (int j = 0; j < 4; ++j) o[n * 4 + j] = acc[ai][bj][m][n][j];
                        if constexpr (MODE == 2 || MODE == 5) {
                            if (u.pn == (MODE == 2 ? 12 : 0)) {
                                if (bj == 1) {
#pragma unroll
                                    for (int j = 0; j < 8; ++j) o[j] = sigmoidf_(o[j]);
                                } else if (wc < 2) {
#pragma unroll
                                    for (int j = 0; j < 8; ++j) { const float e2 = __expf(2.0f * o[j]); o[j] = 1.0f - 2.0f * __builtin_amdgcn_rcpf(e2 + 1.0f); }
                                }
                            }
                        }
                        if constexpr (MODE == 3) {
                            const int cc = (u.pn & 3) * BM + bj * HALF + wc * 32 + 8 * fq;
                            if (u.pn < 4) {
#pragma unroll
                                for (int j = 0; j < 8; ++j) o[j] = 0.60653065971f * sigmoidf_(o[j] + b0[cc + j]);
                            } else if (u.pn < 8) {
#pragma unroll
                                for (int j = 0; j < 8; ++j) o[j] = sigmoidf_(o[j] + b1[cc + j]);
                            }
                        }
                        u32x4 w; w.x = cvt_pk_bf16(o[0], o[1]); w.y = cvt_pk_bf16(o[2], o[3]); w.z = cvt_pk_bf16(o[4], o[5]); w.w = cvt_pk_bf16(o[6], o[7]);
                        *(u32x4*)(rowp + bj * HALF) = w;
                    }
                }
        }
    }
};

template <class EpiT, class Sched, bool CMPA = false, bool ALIGN_EPI = true, bool SP2 = true>
__device__ __forceinline__ void gemm_phase(PG8_LAS unsigned char* lds, const Gemm g, const Sched& S, const EpiT& E) {
    const int tid = threadIdx.x, wid = __builtin_amdgcn_readfirstlane(tid >> 6), lane = tid & 63, wr = wid >> 2, wc = wid & 3, fr = lane & 15, fq = lane >> 4;
    const int K = g.K, nt = K / BK, lda = g.lda, ts = g.ts, ldb = g.ldb ? g.ldb : g.K;
    unsigned voffA[2], voffB[2];
#pragma unroll
    for (int i = 0; i < 2; ++i) { int R, C; stage_rc(tid * 16 + i * 8192, R, C); const int Rb = EpiT::PERM ? ((R & ~31) + perm32(R & 31)) : R;
        voffA[i] = CMPA ? (unsigned)((R >> 1) * 16 * lda + (R & 1) * 64 + C) * 2u : (unsigned)(R * lda + C) * 2u; voffB[i] = (unsigned)(Rb * ldb + C) * 2u; }
    const size_t kstep = (size_t)(BK * 2), kstepA = CMPA ? (size_t)lda * 2 : kstep;
    const size_t hstepA = CMPA ? (size_t)64 * 16 * lda * 2 : (size_t)HALF * lda * 2, hstepB = (size_t)HALF * ldb * 2;
    const size_t tstepB = 2 * hstepB, rowA = (size_t)lda * 2;
    const unsigned ldsw = (unsigned)wid * 1024u;
    const int aoff = lds_byte(wr * 64 + fr, fq * 8), boff = lds_byte(wc * 32 + fr, fq * 8);
#define PG8_BBASE(pn) (CMPA ? (const char*)g.Bt + (size_t)(pn) * ((size_t)nt * kstep) : (const char*)g.Bt + (size_t)(pn) * tstepB)
#define PG8_ASLICE(pn) (CMPA ? (size_t)(pn) * ((size_t)nt * kstepA) : (size_t)0)
#define PG8_ABASE(pm) (CMPA ? (const char*)g.A + ((size_t)((pm) & 15) * 128 * 16 * lda + (size_t)((pm) >> 4) * 128) * 2 : (const char*)g.A + ((size_t)(pm) * BM + ((g.gap && (pm) >= 64) ? 1 : 0)) * rowA)
#define PG8_KOFF(t) (CMPA ? (ptrdiff_t)(t) * (ptrdiff_t)kstepA : (((t) < ts) ? (ptrdiff_t)(t) * (ptrdiff_t)kstep : (ptrdiff_t)((t) - ts) * (ptrdiff_t)kstep - (ptrdiff_t)rowA))
#define PG8_SA(b, h) (((b) * 2 + (h)) * HTB)
#define PG8_SB(b, h) ((4 + (b) * 2 + (h)) * HTB)
#define PG8_STAGE(bufoff, gbase, voff) do { _Pragma("unroll") for (int _i = 0; _i < 2; ++_i) \
        __builtin_amdgcn_global_load_lds((const unsigned*)((const char*)(gbase) + (voff)[_i]), (PG8_LAS unsigned*)(lds + (bufoff) + ldsw + _i * 8192), 16, 0, 0); } while (0)
#define PG8_LDA(dst, b, h) do { _Pragma("unroll") for (int m = 0; m < 4; ++m) _Pragma("unroll") for (int k = 0; k < 2; ++k) dst[m][k] = *(const PG8_LAS bf16x8*)(lds + PG8_SA(b, h) + aoff + m * 2048 + k * 1024); } while (0)
#define PG8_LDB(dst, b, h) do { _Pragma("unroll") for (int n = 0; n < 2; ++n) _Pragma("unroll") for (int k = 0; k < 2; ++k) dst[n][k] = *(const PG8_LAS bf16x8*)(lds + PG8_SB(b, h) + boff + n * 2048 + k * 1024); } while (0)
#define PG8_MMA(ai, bj, At, Bt) do { __builtin_amdgcn_s_setprio(1); _Pragma("unroll") for (int m = 0; m < 4; ++m) _Pragma("unroll") for (int n = 0; n < 2; ++n) _Pragma("unroll") for (int k = 0; k < 2; ++k) \
        acc[ai][bj][m][n] = __builtin_amdgcn_mfma_f32_16x16x32_bf16(Bt[n][k], At[m][k], acc[ai][bj][m][n], 0, 0, 0); __builtin_amdgcn_s_setprio(0); } while (0)
#define PG8_WAIT_V(n) asm volatile("s_waitcnt vmcnt(" #n ")" ::: "memory")
#define PG8_WAIT_L(n) asm volatile("s_waitcnt lgkmcnt(" #n ")" ::: "memory")
#define PG8_BAR __builtin_amdgcn_s_barrier()
#define PG8_SCHED __builtin_amdgcn_sched_barrier(0)
    Unit cur, nxt; int ui = 0;
    if (!S.next(0, cur)) return;
    f32x4 acc[2][2][4][2];
#pragma unroll
    for (int a = 0; a < 2; ++a)
#pragma unroll
        for (int b = 0; b < 2; ++b)
#pragma unroll
            for (int m = 0; m < 4; ++m)
#pragma unroll
                for (int n = 0; n < 2; ++n) acc[a][b][m][n] = (f32x4){0.f, 0.f, 0.f, 0.f};
    bf16x8 At[4][2], B0[2][2], B1[2][2];
    const char* cA = PG8_ABASE(cur.pm) + PG8_ASLICE(cur.pn); const char* cB = PG8_BBASE(cur.pn);
    S.a_ready(cur);
    static_assert(SP2, "only the SP2 loop is kept");
    PG8_STAGE(PG8_SB(0, 0), cB, voffB); PG8_STAGE(PG8_SB(0, 1), cB + hstepB, voffB); PG8_STAGE(PG8_SA(0, 0), cA, voffA); PG8_STAGE(PG8_SA(0, 1), cA + hstepA, voffA);
    if (wr == 1) PG8_BAR;
    PG8_WAIT_V(2); PG8_BAR;
    PG8_STAGE(PG8_SB(1, 0), cB + kstep, voffB); PG8_STAGE(PG8_SA(1, 0), cA + kstepA, voffA); PG8_STAGE(PG8_SB(1, 1), cB + hstepB + kstep, voffB);
    PG8_WAIT_V(6); PG8_BAR;
    for (;;) {
        const bool has_next = S.next(ui + 1, nxt);
        const char* nA = has_next ? PG8_ABASE(nxt.pm) + PG8_ASLICE(nxt.pn) : cA; const char* nB = has_next ? PG8_BBASE(nxt.pn) : cB;
        for (int t = 0; t < nt; t += 2) {
            const bool last = (t == nt - 2);
            const char* a1 = cA + PG8_KOFF(t + 1);
            const char* a2 = last ? nA : cA + PG8_KOFF(t + 2); const char* b2 = last ? nB : cB + (size_t)(t + 2) * kstep;
            const char* a3 = a2 + kstepA; const char* b3 = b2 + kstep;
            if (last && has_next) S.a_ready(nxt);
            PG8_LDB(B0, 0, 0); PG8_LDB(B1, 0, 1); PG8_SCHED; PG8_LDA(At, 0, 0); PG8_STAGE(PG8_SA(1, 1), a1 + hstepA, voffA);
            PG8_WAIT_V(8); PG8_WAIT_L(0); PG8_BAR; PG8_MMA(0, 0, At, B0); PG8_MMA(0, 1, At, B1); PG8_BAR; PG8_SCHED;
            PG8_LDA(At, 0, 1); PG8_STAGE(PG8_SB(0, 0), b2, voffB); PG8_STAGE(PG8_SB(0, 1), b2 + hstepB, voffB); PG8_STAGE(PG8_SA(0, 0), a2, voffA);
            PG8_WAIT_V(8); PG8_WAIT_L(0); PG8_BAR; PG8_MMA(1, 0, At, B0); PG8_MMA(1, 1, At, B1); PG8_BAR; PG8_SCHED;
            PG8_LDB(B0, 1, 0); PG8_LDB(B1, 1, 1); PG8_SCHED; PG8_LDA(At, 1, 0); PG8_STAGE(PG8_SA(0, 1), a2 + hstepA, voffA);
            PG8_WAIT_V(8); PG8_WAIT_L(0); PG8_BAR; PG8_MMA(0, 0, At, B0); PG8_MMA(0, 1, At, B1); PG8_BAR; PG8_SCHED;
            PG8_LDA(At, 1, 1); PG8_STAGE(PG8_SB(1, 0), b3, voffB); PG8_STAGE(PG8_SB(1, 1), b3 + hstepB, voffB); PG8_STAGE(PG8_SA(1, 0), a3, voffA);
            PG8_WAIT_V(8); PG8_WAIT_L(0); PG8_BAR; PG8_MMA(1, 0, At, B0); PG8_MMA(1, 1, At, B1); PG8_BAR; PG8_SCHED;
        }
        if constexpr (ALIGN_EPI) { if (wr == 0) PG8_BAR; }
        E(acc, cur, wr, wc, fr, fq); S.done(cur);
        if (!has_next) break;
#pragma unroll
        for (int a = 0; a < 2; ++a)
#pragma unroll
            for (int b = 0; b < 2; ++b)
#pragma unroll
                for (int m = 0; m < 4; ++m)
#pragma unroll
                    for (int n = 0; n < 2; ++n) acc[a][b][m][n] = (f32x4){0.f, 0.f, 0.f, 0.f};
        cur = nxt; cA = nA; cB = nB; ++ui;
        if constexpr (ALIGN_EPI) { if (wr == 1) PG8_BAR; }
    }
    PG8_WAIT_V(0);
    if constexpr (!ALIGN_EPI) { if (wr == 0) PG8_BAR; }
    PG8_BAR;
#undef PG8_BBASE
#undef PG8_ASLICE
#undef PG8_ABASE
#undef PG8_KOFF
#undef PG8_SA
#undef PG8_SB
#undef PG8_STAGE
#undef PG8_LDA
#undef PG8_LDB
#undef PG8_MMA
#undef PG8_WAIT_V
#undef PG8_WAIT_L
#undef PG8_BAR
#undef PG8_SCHED
}
}

#define XB_TMO      128
#define XB_XCNT(j)  (256  + 64 * (j))
#define XB_XSUB(j)  (1280 + 64 * (j))
#define XB_XGEN(j)  (2304 + 64 * (j))
#define XB_TOP      3328
#define XB_TOPGEN   3392
#define XCD_BAR_WORDS 3456
#define XB_SPIN_CAP (1u << 24)

__device__ __forceinline__ unsigned xb_ld(unsigned* p)              { return __hip_atomic_load(p, __ATOMIC_RELAXED, __HIP_MEMORY_SCOPE_AGENT); }
__device__ __forceinline__ unsigned xb_add(unsigned* p, unsigned v) { return __hip_atomic_fetch_add(p, v, __ATOMIC_RELAXED, __HIP_MEMORY_SCOPE_AGENT); }
__device__ __forceinline__ unsigned xb_xcc_id() { return (unsigned)__builtin_amdgcn_s_getreg((3 << 11) | 20) & 0xFu; }
#define XB_SPIN(cond, bar) do { unsigned _sp = 0; while (cond) { __builtin_amdgcn_s_sleep(1); \
    if ((++_sp & 255u) == 0u) { if (xb_ld(&(bar)[XB_TMO])) break; if (_sp > XB_SPIN_CAP) { atomicAdd(&(bar)[XB_TMO], 1u); break; } } } } while (0)

struct XcdBarrier { unsigned* bar; unsigned x; volatile LAS unsigned* st; };

__device__ __forceinline__ XcdBarrier xcd_barrier_post(unsigned* bar, volatile LAS unsigned* st) {
    XcdBarrier b; b.bar = bar; b.x = xb_xcc_id(); b.st = st;
    if (threadIdx.x == 0) (void)xb_add(&bar[XB_XCNT(b.x)], 1u);
    return b;
}
__device__ __forceinline__ void xcd_barrier_complete(unsigned* bar, unsigned x, unsigned& nloc, unsigned& nx) {
    const unsigned G = gridDim.x * gridDim.y * gridDim.z;
    unsigned sum, cnt, mine, sp = 0u;
    for (;;) {
        sum = 0u; cnt = 0u; mine = 0u;
#pragma unroll
        for (unsigned j = 0; j < 16; ++j) { const unsigned c = xb_ld(&bar[XB_XCNT(j)]); sum += c; cnt += (c > 0u) ? 1u : 0u; mine = (j == x) ? c : mine; }
        if (sum == G) break;
        __builtin_amdgcn_s_sleep(1);
        if ((++sp & 255u) == 0u) { if (xb_ld(&bar[XB_TMO])) break; if (sp > XB_SPIN_CAP) { atomicAdd(&bar[XB_TMO], 1u); break; } }
    }
    nloc = mine > 0u ? mine : 1u; nx = cnt > 0u ? cnt : 1u;
}
__device__ __forceinline__ void xcd_barrier(const XcdBarrier& b) {
    asm volatile("s_waitcnt vmcnt(0)" ::: "memory");
    __syncthreads();
    if (threadIdx.x == 0) {
        unsigned* bar = b.bar;
        __builtin_amdgcn_s_waitcnt(0);
        unsigned nloc = b.st[0], nx = b.st[1];
        if (nloc == 0u) { xcd_barrier_complete(bar, b.x, nloc, nx); b.st[0] = nloc; b.st[1] = nx; }
        const unsigned old = xb_add(&bar[XB_XSUB(b.x)], 1u);
        const unsigned gen = old / nloc;
        if (old + 1u == (gen + 1u) * nloc) {
            __builtin_amdgcn_fence(__ATOMIC_RELEASE, "agent");
            asm volatile("s_waitcnt vmcnt(0)" ::: "memory");
            const unsigned og = xb_add(&bar[XB_TOP], 1u);
            const unsigned tg = og / nx;
            if (og + 1u == (tg + 1u) * nx) xb_add(&bar[XB_TOPGEN], 1u);
            else XB_SPIN(xb_ld(&bar[XB_TOPGEN]) == tg, bar);
            __builtin_amdgcn_fence(__ATOMIC_ACQUIRE, "agent");
            xb_add(&bar[XB_XGEN(b.x)], 1u);
            asm volatile("s_waitcnt vmcnt(0)" ::: "memory");
        } else {
            XB_SPIN(xb_ld(&bar[XB_XGEN(b.x)]) == gen, bar);
            __builtin_amdgcn_fence(__ATOMIC_ACQUIRE, "agent");
            asm volatile("s_waitcnt vmcnt(0)" ::: "memory");
        }
    }
    __syncthreads();
}

struct Args { const float* in[53]; float* out; unsigned char* ws; int ph_lo, ph_hi; };

enum { I_X = 0, I_L0F1 = 1, I_L0_MIX_PRE = 6, I_L0_MIX_POST = 7, I_W_IN = 8, I_PE_K = 9, I_W1_K = 10, I_W2_K = 11, I_PE_V = 12, I_W1_V = 13, I_W2_V = 14,
       I_CONV_W = 15, I_CONV_B = 16, I_W_OUT = 17, I_L0F2 = 18, I_L1F1 = 23, I_L1_MIX_PRE = 28, I_L1_MIX_POST = 29, I_MU = 30, I_W_R = 31, I_W_K = 32, I_W_V = 33, I_W_O = 34,
       I_W0 = 35, I_DEC1 = 36, I_DEC2 = 37, I_A0 = 38, I_A1 = 39, I_A2 = 40, I_G1 = 41, I_G2 = 42, I_K_K = 43, I_K_A = 44, I_R_K = 45, I_LNX_G = 46, I_LNX_B = 47, I_L1F2 = 48 };

template <class RM, class SC> __device__ __forceinline__ void convert_t(bf16* dst, int dstK, int koff, const float* src, int Ksrc, int ncol, RM rowmap, SC scale, int gtid, int gsize, LAS unsigned char* lds, int rot = 0) {
    const int lane = gtid & 63, nwv = gsize >> 6, gwv = ((gtid >> 6) + nwv - rot % nwv) % nwv;
    LAS float* scr = (LAS float*)(lds + ((gtid >> 6) & 7) * 8704);
    const int nblk = (ncol + 31) >> 5, nitems = (Ksrc >> 6) * nblk;
    for (int it = gwv; it < nitems; it += nwv) {
        const int kb = it / nblk, nb = it - kb * nblk, k0 = kb * 64, n0 = nb * 32;
        const int nn = n0 + (lane & 31); const bool nok = nn < ncol;
        float v[32];
        const float* sp = src + (size_t)(k0 + (lane >> 5)) * ncol + (nok ? nn : 0);
#pragma unroll
        for (int i = 0; i < 32; ++i) v[i] = sp[(size_t)(2 * i) * ncol];
#pragma unroll
        for (int i = 0; i < 32; ++i) { const int kk = 2 * i + (lane >> 5); scr[kk * 33 + (lane & 31)] = nok ? v[i] * scale(k0 + kk) : 0.f; }
        const int cch = lane & 7;
#pragma unroll
        for (int j = 0; j < 4; ++j) { const int n = (lane >> 3) + 8 * j; const LAS float* s = scr + (8 * cch) * 33 + n;
            u32x4 o; o.x = cvt_pk_bf16(s[0 * 33], s[1 * 33]); o.y = cvt_pk_bf16(s[2 * 33], s[3 * 33]); o.z = cvt_pk_bf16(s[4 * 33], s[5 * 33]); o.w = cvt_pk_bf16(s[6 * 33], s[7 * 33]);
            if (n0 + n < ncol) *(u32x4*)(dst + (size_t)rowmap(n0 + n) * dstK + koff + k0 + 8 * cch) = o; }
    }
}
__device__ __forceinline__ void zero_rows(bf16* dst, size_t nelem, int gtid, int gsize) {
    for (size_t i = (size_t)gtid * 8; i < nelem; i += (size_t)gsize * 8) *(u32x4*)(dst + i) = (u32x4){0u, 0u, 0u, 0u};
}
__device__ __forceinline__ void convert_ffn(const Args& a, int base, int gtid, int gsize, LAS unsigned char* lds) {
    const float* wg = a.in[base + 2]; const float* wu = a.in[base + 3]; const float* wd = a.in[base + 4];
    unsigned char* W = a.ws + WS_W;
    auto one = [](int) { return 1.0f; };
    convert_t((bf16*)(W + W_GU), D, 0, wg, D, FF, [](int n) { return (n >> 7) * 256 + (n & 127); }, one, gtid, gsize, lds, 0);
    convert_t((bf16*)(W + W_GU), D, 0, wu, D, FF, [](int n) { return (n >> 7) * 256 + 128 + (n & 127); }, one, gtid, gsize, lds, 1408);
    convert_t((bf16*)(W + W_DN), FF, 0, wd, FF, D, [](int n) { return n; }, one, gtid, gsize, lds, 2816);
}
__device__ __forceinline__ void convert_mix0(const Args& a, int gtid, int gsize, LAS unsigned char* lds) {
    const float* win = a.in[I_W_IN]; const float* wout = a.in[I_W_OUT];
    unsigned char* W = a.ws + WS_W;
    auto one = [](int) { return 1.0f; };
    convert_t((bf16*)(W + W_IN), D, 0, win, D, 2840, [](int n) { return n < 512 ? n : (n < 536 ? n - 512 + 2816 : n - 24); }, one, gtid, gsize, lds);
    zero_rows((bf16*)(W + W_IN) + (size_t)2840 * D, (size_t)(PROJ_LD - 2840) * D, gtid, gsize);
    convert_t((bf16*)(W + W_OUT), D, 0, wout, D, D, [](int n) { return n; }, one, gtid, gsize, lds);
    convert_t((bf16*)(W + W_CMP), 2048, 0, a.in[I_W1_K], 2048, 128, [](int n) { return n; }, one, gtid, gsize, lds);
    convert_t((bf16*)(W + W_CMP), 2048, 0, a.in[I_W1_V], 2048, 128, [](int n) { return n + 128; }, one, gtid, gsize, lds);
    { const int gw_ = gtid >> 6, ln = gtid & 63; if (gw_ < 256) { const int kv = gw_ >> 7, n = gw_ & 127; const float* pe = a.in[kv ? I_PE_V : I_PE_K]; const float* w1 = a.in[kv ? I_W1_V : I_W1_K];
        float s = 0.f; for (int kk = ln; kk < 2048; kk += 64) s += pe[kk] * w1[(size_t)kk * 128 + n]; s = wave_sum(s); if (ln == 0) ((float*)(a.ws + WS_PEB))[gw_] = s; } }
}
__device__ __forceinline__ void convert_mix1(const Args& a, int gtid, int gsize, LAS unsigned char* lds) {
    const float* mu = a.in[I_MU];
    unsigned char* W = a.ws + WS_W;
    bf16* Wlo = (bf16*)(W + W_LORA); bf16* Wl2 = (bf16*)(W + W_L2);
    auto one = [](int) { return 1.0f; };
    convert_t((bf16*)(W + W_R), D, 0, a.in[I_W_R], D, D, [](int n) { return n; }, one, gtid, gsize, lds, 0);
    convert_t((bf16*)(W + W_K), D, 0, a.in[I_W_K], D, D, [](int n) { return n; }, one, gtid, gsize, lds, 512);
    convert_t((bf16*)(W + W_V), D, 0, a.in[I_W_V], D, D, [](int n) { return n; }, one, gtid, gsize, lds, 1024);
#define CONV_LORA(srcp, ncol, rowoff, mi) \
    convert_t(Wlo, 2 * D, 0, srcp, D, ncol, [](int n) { return n + (rowoff); }, [=](int k) { return 1.0f - mu[(mi) * 1024 + k]; }, gtid, gsize, lds, 1536); \
    convert_t(Wlo, 2 * D, D, srcp, D, ncol, [](int n) { return n + (rowoff); }, [=](int k) { return mu[(mi) * 1024 + k]; }, gtid, gsize, lds, 1700);
    CONV_LORA(a.in[I_DEC1], 64, 0, 1)
    CONV_LORA(a.in[I_A1], 64, 64, 4)
    CONV_LORA(a.in[I_G1], 128, 128, 5)
#undef CONV_LORA
    zero_rows(Wl2, (size_t)EAG_LD * 256, gtid, gsize);
    convert_t((bf16*)(W + W_O), D, 0, a.in[I_W_O], D, D, [](int n) { return n; }, one, gtid, gsize, lds);
}
__device__ __forceinline__ void convert_mix1_l2(const Args& a, int gtid, int gsize, LAS unsigned char* lds) {
    unsigned char* W = a.ws + WS_W; bf16* Wl2 = (bf16*)(W + W_L2);
    auto one = [](int) { return 1.0f; };
    convert_t(Wl2, 256, 0, a.in[I_DEC2], 64, 1024, [](int n) { return n; }, one, gtid, gsize, lds);
    convert_t(Wl2, 256, 64, a.in[I_A2], 64, 1024, [](int n) { return n + 1024; }, one, gtid, gsize, lds);
    convert_t(Wl2, 256, 128, a.in[I_G2], 128, 1024, [](int n) { return n + 2048; }, one, gtid, gsize, lds);
}

template <bool HAS_A, bool TWO, bool WRITE_X, bool HAS_XN>
__device__ __forceinline__ void row_pass(const float* xin, float* xout, const bf16* da, const float* ga, float ca, const bf16* db, const float* gb, float cb, const float* gpre, bf16* xn, int gw, int nw, int lane) {
    f32x4 gA[4], gB[4], gP[4];
#pragma unroll
    for (int j = 0; j < 4; ++j) { if constexpr (HAS_A) gA[j] = *(const f32x4*)(ga + lane * 4 + 256 * j); if constexpr (TWO) gB[j] = *(const f32x4*)(gb + lane * 4 + 256 * j);
        if constexpr (HAS_XN) gP[j] = *(const f32x4*)(gpre + lane * 4 + 256 * j); }
    for (int row = gw; row < M; row += nw) {
        f32x4 x[4];
#pragma unroll
        for (int j = 0; j < 4; ++j) x[j] = *(const f32x4*)(xin + (size_t)row * D + lane * 4 + 256 * j);
        if constexpr (HAS_A) {
            f32x4 d[4]; float ss = 0.f;
#pragma unroll
            for (int j = 0; j < 4; ++j) { const u32x2 w = *(const u32x2*)(da + (size_t)row * D + lane * 4 + 256 * j); d[j] = (f32x4){bflo(w.x), bfhi(w.x), bflo(w.y), bfhi(w.y)};
                ss += (d[j].x * d[j].x + d[j].y * d[j].y) + (d[j].z * d[j].z + d[j].w * d[j].w); }
            const float rstd = ca * rsqrtf(wave_sum(ss) * (1.0f / D) + EPS);
#pragma unroll
            for (int j = 0; j < 4; ++j) x[j] = x[j] + d[j] * gA[j] * rstd;
        }
        if constexpr (TWO) {
            f32x4 d[4]; float ss = 0.f;
#pragma unroll
            for (int j = 0; j < 4; ++j) { const u32x2 w = *(const u32x2*)(db + (size_t)row * D + lane * 4 + 256 * j); d[j] = (f32x4){bflo(w.x), bfhi(w.x), bflo(w.y), bfhi(w.y)};
                ss += (d[j].x * d[j].x + d[j].y * d[j].y) + (d[j].z * d[j].z + d[j].w * d[j].w); }
            const float rstd = cb * rsqrtf(wave_sum(ss) * (1.0f / D) + EPS);
#pragma unroll
            for (int j = 0; j < 4; ++j) x[j] = x[j] + d[j] * gB[j] * rstd;
        }
        if constexpr (WRITE_X) {
#pragma unroll
            for (int j = 0; j < 4; ++j) *(f32x4*)(xout + (size_t)row * D + lane * 4 + 256 * j) = x[j];
        }
        if constexpr (HAS_XN) {
            float ss = 0.f;
#pragma unroll
            for (int j = 0; j < 4; ++j) ss += (x[j].x * x[j].x + x[j].y * x[j].y) + (x[j].z * x[j].z + x[j].w * x[j].w);
            const float rstd = rsqrtf(wave_sum(ss) * (1.0f / D) + EPS);
            const size_t prow = (size_t)row + (row >= SEQ ? 2 : 1);
#pragma unroll
            for (int j = 0; j < 4; ++j) { const f32x4 y = x[j] * gP[j] * rstd;
                u32x2 w; w.x = cvt_pk_bf16(y.x, y.y); w.y = cvt_pk_bf16(y.z, y.w); *(u32x2*)(xn + prow * D + lane * 4 + 256 * j) = w; }
        }
    }
    if constexpr (HAS_XN) { if (blockIdx.x == 0) { const int t = threadIdx.x; if (t < 256) { u32x4 z = (u32x4){0u, 0u, 0u, 0u}; const size_t prow = (t < 128) ? 0 : (size_t)SEQ + 1; *(u32x4*)(xn + prow * D + (t & 127) * 8) = z; } } }
}

__device__ __forceinline__ void rwkv_mix_phase(const Args& a, int gtid, int gsize) {
    const bf16* xn = (const bf16*)(a.ws + WS_XN); const float* mu = a.in[I_MU];
    bf16* xr = (bf16*)(a.ws + WS_XR); bf16* xk = (bf16*)(a.ws + WS_XK); bf16* xv = (bf16*)(a.ws + WS_XV);
    const int c8 = gtid & 127, tl = gtid >> 7, nl = gsize >> 7, run = (M + nl - 1) / nl;
    float mr[8], mk[8], mv[8];
    { const float* m = mu + c8 * 8;
#pragma unroll
      for (int j = 0; j < 8; ++j) { mr[j] = m[j]; mk[j] = m[2 * 1024 + j]; mv[j] = m[3 * 1024 + j]; } }
    const int t_beg = tl * run, t_end = (t_beg + run < M) ? t_beg + run : M;
    u32x4 pw = (u32x4){0u, 0u, 0u, 0u};
    if (t_beg < t_end) { const size_t prow0 = (size_t)t_beg + (t_beg >= SEQ ? 2 : 1); pw = *(const u32x4*)(xn + (prow0 - 1) * D + c8 * 8); }
    for (int tok = t_beg; tok < t_end; ++tok) {
        const size_t prow = (size_t)tok + (tok >= SEQ ? 2 : 1);
        if ((tok & (SEQ - 1)) == 0) pw = (u32x4){0u, 0u, 0u, 0u};
        const u32x4 hw = *(const u32x4*)(xn + prow * D + c8 * 8);
        const float h[8] = {bflo(hw.x), bfhi(hw.x), bflo(hw.y), bfhi(hw.y), bflo(hw.z), bfhi(hw.z), bflo(hw.w), bfhi(hw.w)};
        const float p[8] = {bflo(pw.x), bfhi(pw.x), bflo(pw.y), bfhi(pw.y), bflo(pw.z), bfhi(pw.z), bflo(pw.w), bfhi(pw.w)};
#define MIX_ONE(mm, dstp) do { float o[8]; \
            _Pragma("unroll") for (int j = 0; j < 8; ++j) o[j] = h[j] + (p[j] - h[j]) * mm[j]; \
            u32x4 w; w.x = cvt_pk_bf16(o[0], o[1]); w.y = cvt_pk_bf16(o[2], o[3]); w.z = cvt_pk_bf16(o[4], o[5]); w.w = cvt_pk_bf16(o[6], o[7]); \
            *(u32x4*)((dstp) + (size_t)tok * D + c8 * 8) = w; } while (0)
        MIX_ONE(mr, xr); MIX_ONE(mk, xk); MIX_ONE(mv, xv);
#undef MIX_ONE
        pw = hw;
    }
}

constexpr int CMP_SPLIT = 8;
__device__ __forceinline__ void compress_stage2(const Args& a, int gw, int nw, int lane) {
    const float* part = (const float*)(a.ws + WS_XN); const float* peb = (const float*)(a.ws + WS_PEB);
    for (int m = gw; m < 8192; m += nw) {
        const int kv = m >> 12, mm = m & 4095, g = mm & 1, i = (mm >> 1) & 1023, b = mm >> 11;
        if (i >= NCMP) continue;
        float h0 = peb[kv * 128 + lane], h1 = peb[kv * 128 + 64 + lane];
#pragma unroll
        for (int s = 0; s < CMP_SPLIT; ++s) { const float* p = part + ((size_t)s * 8192 + m) * 128; h0 += p[lane]; h1 += p[64 + lane]; }
        { const float u0 = 0.7978845608028654f * (h0 + 0.044715f * h0 * h0 * h0), u1 = 0.7978845608028654f * (h1 + 0.044715f * h1 * h1 * h1);
          h0 = 0.5f * h0 * (2.0f - 2.0f * __builtin_amdgcn_rcpf(__expf(2.0f * u0) + 1.0f)); h1 = 0.5f * h1 * (2.0f - 2.0f * __builtin_amdgcn_rcpf(__expf(2.0f * u1) + 1.0f)); }
        const float* w2 = a.in[kv ? I_W2_V : I_W2_K];
        float o0 = 0.f, o1 = 0.f;
#pragma unroll
        for (int n = 0; n < 64; ++n) { o0 = fmaf(__int_as_float(__builtin_amdgcn_readlane(__float_as_int(h0), n)), w2[n * 64 + lane], o0); o1 = fmaf(__int_as_float(__builtin_amdgcn_readlane(__float_as_int(h1), n)), w2[(64 + n) * 64 + lane], o1); }
        bf16* dst = (bf16*)(a.ws + (kv ? WS_VC : WS_KC)); dst[((size_t)(b * NCMP + i) * 2 + g) * 64 + lane] = f2bf(o0 + o1);
    }
}

typedef float f32x16 __attribute__((ext_vector_type(16)));
typedef short s16x4 __attribute__((ext_vector_type(4)));
constexpr int NK_KS = 144, NK_VS = 144;
constexpr int NL_K = 0, NL_V = 2 * 128 * NK_KS, NL_IMP = NL_V + 2 * 128 * NK_VS, NL_SELM = NL_IMP + 64 * 264 * 4, NL_UN = NL_SELM + 64 * 8 * 4, NL_ULIST = NL_UN + 72 * 4, NL_END = NL_ULIST + 260 * 4;
static_assert(NL_END <= LDS_CTL_OFF, "NSA LDS map");
constexpr float LOG2E = 1.4426950408889634f;

struct SmState { float m, l; f32x16 o0, o1; };
struct TileSrc { const bf16* k; const bf16* v; int stride; int nvalid; };

__device__ __forceinline__ void tile_load(const TileSrc& s, int tid, u32x4& kr, u32x4& vr) {
    const int row = tid >> 3, chk = tid & 7;
    if (row < s.nvalid) { kr = *(const u32x4*)(s.k + (size_t)row * s.stride + chk * 8); if (s.v) vr = *(const u32x4*)(s.v + (size_t)row * s.stride + chk * 8); }
    else { kr = (u32x4){0u, 0u, 0u, 0u}; vr = (u32x4){0u, 0u, 0u, 0u}; }
}
__device__ __forceinline__ void tile_store(LAS unsigned char* kb, LAS unsigned char* vb, int tid, const u32x4& kr, const u32x4& vr) {
    const int row = tid >> 3, chk = tid & 7;
    *(LAS u32x4*)(kb + row * NK_KS + chk * 16) = kr; *(LAS u32x4*)(vb + row * NK_VS + chk * 16) = vr;
    if (chk == 0) *(LAS u32x4*)(kb + row * NK_KS + 128) = (u32x4){cvt_pk_bf16((float)row, 0.f), 0u, 0u, 0u};
}
__device__ __forceinline__ void qk64(const LAS unsigned char* kb, int lane, const bf16x8 (&qf)[4], unsigned qx0, int lo, int hi, bool allvalid, f32x16& a0, f32x16& a1) {
#pragma unroll
    for (int e = 0; e < 16; ++e) { a0[e] = 0.f; a1[e] = 0.f; }
    const int c32 = lane & 31, h = lane >> 5;
    const LAS unsigned char* kp = kb + c32 * NK_KS + h * 16;
#pragma unroll
    for (int ks = 0; ks < 4; ++ks) { const bf16x8 k0 = *(const LAS bf16x8*)(kp + ks * 32), k1 = *(const LAS bf16x8*)(kp + 32 * NK_KS + ks * 32);
        a0 = __builtin_amdgcn_mfma_f32_32x32x16_bf16(k0, qf[ks], a0, 0, 0, 0); a1 = __builtin_amdgcn_mfma_f32_32x32x16_bf16(k1, qf[ks], a1, 0, 0, 0); }
    { const bf16x8 k0 = *(const LAS bf16x8*)(kb + c32 * NK_KS + 128), k1 = *(const LAS bf16x8*)(kb + (32 + c32) * NK_KS + 128);
      union { u32x4 u; bf16x8 b; } qx; qx.u = (u32x4){(lane < 32) ? qx0 : 0u, 0u, 0u, 0u};
      a0 = __builtin_amdgcn_mfma_f32_32x32x16_bf16(k0, qx.b, a0, 0, 0, 0); a1 = __builtin_amdgcn_mfma_f32_32x32x16_bf16(k1, qx.b, a1, 0, 0, 0); }
    if (!allvalid) {
        if (hi < lo) { lo = 1000; hi = 1000; }
        const unsigned span = (unsigned)(hi - lo); const int l0 = lo - 4 * h, l1 = lo - 4 * h - 32;
#pragma unroll
        for (int e = 0; e < 16; ++e) { const int ce = (e & 3) + 8 * (e >> 2);
            a0[e] = ((unsigned)(ce - l0) <= span) ? a0[e] : -INFINITY; a1[e] = ((unsigned)(ce - l1) <= span) ? a1[e] : -INFINITY; }
    }
}
__device__ __forceinline__ void tile64(const LAS unsigned char* kb, const LAS unsigned char* vb, int lane, const bf16x8 (&qf)[4], unsigned qx0, int lo, int hi, bool allvalid, float C1, float tc2, SmState& st) {
    f32x16 a0, a1;
    qk64(kb, lane, qf, qx0, lo, hi, allvalid, a0, a1);
    float tmax = fmaxf(a0[0], a1[0]);
#pragma unroll
    for (int e = 1; e < 16; ++e) tmax = fmaxf(tmax, fmaxf(a0[e], a1[e]));
    tmax = xor32_max(fmaf(tmax, C1, tc2));
    const float mn = fmaxf(st.m, tmax);
    if (!__all(mn == st.m)) { const float al = __builtin_amdgcn_exp2f(st.m - mn); st.l *= al; st.m = mn;
#pragma unroll
        for (int e = 0; e < 16; ++e) { st.o0[e] *= al; st.o1[e] *= al; } }
    float ps = 0.f; const float off = tc2 - st.m;
#pragma unroll
    for (int e = 0; e < 16; ++e) { a0[e] = __builtin_amdgcn_exp2f(fmaf(a0[e], C1, off)); a1[e] = __builtin_amdgcn_exp2f(fmaf(a1[e], C1, off)); ps += a0[e] + a1[e]; }
    st.l += ps;
    const int i16 = lane & 15, g4 = lane >> 4;
    const LAS unsigned char* vp = vb + (4 * (g4 >> 1) + (i16 >> 2)) * NK_VS + (16 * (g4 & 1) + 4 * (i16 & 3)) * 2;
#pragma unroll
    for (int hf = 0; hf < 2; ++hf)
#pragma unroll
        for (int sk = 0; sk < 2; ++sk) {
            const f32x16& pp = hf ? a1 : a0;
            bf16x8 pf; { union { u32x4 u; bf16x8 b; } cv; cv.u.x = cvt_pk_bf16(pp[8 * sk + 0], pp[8 * sk + 1]); cv.u.y = cvt_pk_bf16(pp[8 * sk + 2], pp[8 * sk + 3]); cv.u.z = cvt_pk_bf16(pp[8 * sk + 4], pp[8 * sk + 5]); cv.u.w = cvt_pk_bf16(pp[8 * sk + 6], pp[8 * sk + 7]); pf = cv.b; }
#pragma unroll
            for (int dt = 0; dt < 2; ++dt) {
                const s16x4 v0 = __builtin_amdgcn_ds_read_tr16_b64_v4i16((LAS s16x4*)(vp + (32 * hf + 16 * sk) * NK_VS + dt * 64));
                const s16x4 v1 = __builtin_amdgcn_ds_read_tr16_b64_v4i16((LAS s16x4*)(vp + (32 * hf + 16 * sk + 8) * NK_VS + dt * 64));
                const bf16x8 vf = (bf16x8){v0.x, v0.y, v0.z, v0.w, v1.x, v1.y, v1.z, v1.w};
                if (dt == 0) st.o0 = __builtin_amdgcn_mfma_f32_32x32x16_bf16(vf, pf, st.o0, 0, 0, 0);
                else st.o1 = __builtin_amdgcn_mfma_f32_32x32x16_bf16(vf, pf, st.o1, 0, 0, 0);
            }
        }
}
__device__ __forceinline__ int imp_idx(int token, int j) { return token * 264 + (j >> 5) * 33 + (j & 31); }

#ifndef NSA_DUP
#define NSA_DUP 0
#endif
#define NSA_REP(bit) for (int rep_ = 0; rep_ < ((NSA_DUP >> (bit)) & 1) + 1; ++rep_)
__device__ __forceinline__ void nsa_mfma_phase(const Args& a, LAS unsigned char* lds) {
    const int tid0 = threadIdx.x, wave = __builtin_amdgcn_readfirstlane(tid0 >> 6);
    const bf16* proj = (const bf16*)(a.ws + WS_BIG);
    const bf16* KC = (const bf16*)(a.ws + WS_KC); const bf16* VC = (const bf16*)(a.ws + WS_VC);
    bf16* att = (bf16*)(a.ws + WS_ATT);
    LAS float* IMP = (LAS float*)(lds + NL_IMP); LAS unsigned* SELM = (LAS unsigned*)(lds + NL_SELM); LAS unsigned* UN = (LAS unsigned*)(lds + NL_UN); LAS int* ULIST = (LAS int*)(lds + NL_ULIST);
    const int G = gridDim.x;
    for (int ui = 0; ; ++ui) {
        const int u = ui * G + blockIdx.x; if (u >= NB * 2 * (SEQ / 64)) break;
        int tid = tid0; asm volatile("" : "+v"(tid));
        const int lane = tid & 63, h = lane >> 5, c32 = lane & 31, tl = c32 >> 2, r = c32 & 3;
        const int bg = u >> 8, tsw = ((u & 7) << 5) | ((u & 255) >> 3), tile = (bg & 1) ? 255 - tsw : tsw, b = bg >> 1, g = bg & 1;
        const int t0 = tile * 64, tokl = wave * 8 + tl, t = t0 + tokl;
        const size_t tok = (size_t)b * SEQ + t;
        const float slope = exp2f(-(float)(g * 4 + r + 1)), sl2 = slope * LOG2E, C1 = 0.125f * LOG2E;
        const unsigned qx_one = cvt_pk_bf16(8.0f * slope, 0.f), qx_cmp = cvt_pk_bf16(128.0f * slope, 0.f);
        bf16x8 qf[4];
#pragma unroll
        for (int ks = 0; ks < 4; ++ks) qf[ks] = *(const bf16x8*)(proj + tok * PROJ_LD + PC_Q + (g * 4 + r) * 64 + ks * 16 + h * 8);
        f32x16 out0, out1;
#pragma unroll
        for (int e = 0; e < 16; ++e) { out0[e] = 0.f; out1[e] = 0.f; }
        SmState st;
        u32x4 kr, vr, kr2, vr2;
#define NSA_STATE_INIT() do { st.m = -1e30f; st.l = 0.f; _Pragma("unroll") for (int e = 0; e < 16; ++e) { st.o0[e] = 0.f; st.o1[e] = 0.f; } } while (0)
#define NSA_STATE_FOLD(gi) do { const float lt = xor32_sum(st.l); const float gt_ = sigmoidf_(bf2f(proj[((size_t)b * SEQ + t) * PROJ_LD + PC_G + (g * 4 + r) * 3 + (gi)])); const float sc_ = gt_ / fmaxf(lt, 1e-30f); _Pragma("unroll") for (int e = 0; e < 16; ++e) { out0[e] += st.o0[e] * sc_; out1[e] += st.o1[e] * sc_; } } while (0)
#define NSA_KB(i) (lds + NL_K + ((((i) >> 1) & 1) * 128 + ((i) & 1) * 64) * NK_KS)
#define NSA_VB(i) (lds + NL_V + ((((i) >> 1) & 1) * 128 + ((i) & 1) * 64) * NK_VS)
#define NSA_PIPE(N, SRC, ...) do { const int n_ = (N); \
        tile_load(SRC(0), tid, kr, vr); tile_store(NSA_KB(0), NSA_VB(0), tid, kr, vr); \
        if (1 < n_) { tile_load(SRC(1), tid, kr, vr); tile_store(NSA_KB(1), NSA_VB(1), tid, kr, vr); } \
        __syncthreads(); \
        if (2 < n_) tile_load(SRC(2), tid, kr, vr); \
        if (3 < n_) tile_load(SRC(3), tid, kr2, vr2); \
        for (int ip_ = 0; 2 * ip_ < n_; ++ip_) { \
            { const int i = 2 * ip_; __VA_ARGS__ } \
            if (2 * ip_ + 1 < n_) { const int i = 2 * ip_ + 1; __VA_ARGS__ } \
            if (2 * ip_ + 2 < n_) tile_store(NSA_KB(2 * ip_ + 2), NSA_VB(2 * ip_ + 2), tid, kr, vr); \
            if (2 * ip_ + 3 < n_) tile_store(NSA_KB(2 * ip_ + 3), NSA_VB(2 * ip_ + 3), tid, kr2, vr2); \
            __syncthreads(); \
            if (2 * ip_ + 4 < n_) tile_load(SRC(2 * ip_ + 4), tid, kr, vr); \
            if (2 * ip_ + 5 < n_) tile_load(SRC(2 * ip_ + 5), tid, kr2, vr2); \
        } } while (0)
        const int ntc = (4 * tile + 3 + 63) >> 6;
        auto cmp_src = [&](int i) { const int n0 = 64 * (ntc - 1 - i); TileSrc s; s.k = KC + ((size_t)(b * NCMP + n0) * 2 + g) * 64; s.v = VC + ((size_t)(b * NCMP + n0) * 2 + g) * 64; s.stride = 128; s.nvalid = NCMP - n0; return s; };
        float m_cmp, invl_cmp;
        NSA_REP(0) {
            NSA_STATE_INIT();
            __syncthreads();
            NSA_PIPE(ntc, cmp_src, { const int n0 = 64 * (ntc - 1 - i); const int hi = (t - 31 - 16 * n0) >> 4; const bool allv = __all(hi >= 63);
                tile64(NSA_KB(i), NSA_VB(i), lane, qf, qx_cmp, 0, hi, allv, C1, sl2 * (float)(16 * n0 + 31 - t), st); });
            const float lt = xor32_sum(st.l);
            m_cmp = st.m; invl_cmp = 1.0f / fmaxf(lt, 1e-30f);
        }
        NSA_STATE_FOLD(0);
        if (tile >= 16) {
            NSA_REP(1) {
            auto cmpk_src = [&](int i) { TileSrc s = cmp_src(i); s.v = nullptr; return s; };
            NSA_PIPE(ntc, cmpk_src, { const int n0 = 64 * (ntc - 1 - i); const int hi = (t - 31 - 16 * n0) >> 4;
                  f32x16 a0, a1; qk64(NSA_KB(i), lane, qf, qx_cmp, 0, hi, false, a0, a1);
                  const float off2 = sl2 * (float)(16 * n0 + 31 - t) - m_cmp;
                  float mv[8], hv[8];
                  _Pragma("unroll") for (int hf = 0; hf < 2; ++hf)
                    _Pragma("unroll") for (int gq = 0; gq < 4; ++gq) {
                        const f32x16& s = hf ? a1 : a0;
                        const float p0 = __builtin_amdgcn_exp2f(fmaf(s[4 * gq], C1, off2)) * invl_cmp, p1 = __builtin_amdgcn_exp2f(fmaf(s[4 * gq + 1], C1, off2)) * invl_cmp,
                                    p2 = __builtin_amdgcn_exp2f(fmaf(s[4 * gq + 2], C1, off2)) * invl_cmp, p3 = __builtin_amdgcn_exp2f(fmaf(s[4 * gq + 3], C1, off2)) * invl_cmp;
                        float mainv = ((p0 + p1) + p2) + 0.5f * p3, halfv = 0.5f * p3;
                        mainv += dpp_mov<0xB1>(mainv); mainv += dpp_mov<0x4E>(mainv); halfv += dpp_mov<0xB1>(halfv); halfv += dpp_mov<0x4E>(halfv);
                        mv[4 * hf + gq] = mainv; hv[4 * hf + gq] = halfv; }
                  _Pragma("unroll") for (int q = 0; q < 8; ++q) {
                        auto rr = __builtin_amdgcn_permlane32_swap(__float_as_uint(q ? hv[q - 1] : 0.f), __float_as_uint(hv[q]), false, false);
                        const float tot = mv[q] + __uint_as_float(h ? rr[0] : rr[1]);
                        const int j = (n0 >> 2) + 2 * q + h;
                        if (r == 0 && j < NSLC) IMP[imp_idx(tokl, j)] = tot; }
                  if (i > 0 && h == 1 && r == 0) { const int jn = (n0 >> 2) + 16; if (jn < NSLC) IMP[imp_idx(tokl, jn)] += hv[7]; } });
            }
            NSA_REP(2) {
                const int ttl = lane >> 3, sl = lane & 7, tk = wave * 8 + ttl;
                float cand[32];
#pragma unroll
                for (int i = 0; i < 32; ++i) { const int j = 32 * sl + i; const float v = IMP[tk * 264 + sl * 33 + i]; const bool forced = (j == 0) || (j == tile) || (j == tile - 1); cand[i] = (j <= tile && !forced) ? v : -1.0f; }
                float top[13];
#pragma unroll
                for (int q = 0; q < 13; ++q) top[q] = -1.0f;
#pragma unroll
                for (int i = 0; i < 32; ++i) { const float x = cand[i];
#pragma unroll
                    for (int q = 12; q >= 1; --q) top[q] = __builtin_amdgcn_fmed3f(top[q - 1], top[q], x);
                    top[0] = fmaxf(top[0], x); }
#define NSA_MERGE(CTRL) do { float oth[13]; _Pragma("unroll") for (int q = 0; q < 13; ++q) oth[q] = dpp_mov<CTRL>(top[q]); \
                    _Pragma("unroll") for (int i = 0; i < 13; ++i) { const float x = oth[i]; _Pragma("unroll") for (int q = 12; q >= 1; --q) top[q] = __builtin_amdgcn_fmed3f(top[q - 1], top[q], x); top[0] = fmaxf(top[0], x); } } while (0)
                NSA_MERGE(0xB1); NSA_MERGE(0x4E); NSA_MERGE(0x141);
#undef NSA_MERGE
                const float T = top[12];
                unsigned bgt = 0u, beq = 0u, bforced = 0u;
#pragma unroll
                for (int i = 0; i < 32; ++i) { const int j = 32 * sl + i; if (cand[i] > T) bgt |= 1u << i; if (cand[i] == T) beq |= 1u << i; if ((j == 0) || (j == tile) || (j == tile - 1)) bforced |= 1u << i; }
                int cgt = __popc(bgt); cgt += dpp_movi<0xB1>(cgt); cgt += dpp_movi<0x4E>(cgt); cgt += dpp_movi<0x141>(cgt);
                const int need_eq = 13 - cgt;
                int ce_inc = __popc(beq);
#pragma unroll
                for (int d = 1; d < 8; d <<= 1) { const int y = __shfl_up(ce_inc, d); if (sl >= d) ce_inc += y; }
                const int before = ce_inc - __popc(beq);
                int ntake = need_eq - before; ntake = ntake < 0 ? 0 : ntake;
                unsigned keep = 0u, mm = beq;
                for (int q = 0; q < ntake && mm; ++q) { const unsigned low = mm & (0u - mm); keep |= low; mm ^= low; }
                const unsigned mask = bgt | keep | bforced;
                SELM[tk * 8 + sl] = mask;
                unsigned um = mask; um |= __shfl_xor(um, 8); um |= __shfl_xor(um, 16); um |= __shfl_xor(um, 32);
                if (lane < 8) UN[wave * 8 + lane] = um;
            }
        } else {
            if (tid < 64 * 8) { const unsigned mask = ((tid & 7) == 0) ? ((1u << (tile + 1)) - 1u) : 0u; SELM[tid] = mask; if (tid < 64) UN[tid] = ((tid & 7) == 0) ? mask : 0u; }
        }
        __syncthreads();
        if (tid < 256) {
            unsigned um[8]; int above = 0, total = 0;
#pragma unroll
            for (int d = 0; d < 8; ++d) { unsigned x = 0u;
#pragma unroll
                for (int w = 0; w < 8; ++w) x |= UN[w * 8 + d];
                um[d] = x; total += __popc(x); }
            const int dj = tid >> 5, bj = tid & 31; unsigned mine = 0u;
#pragma unroll
            for (int d = 0; d < 8; ++d) { if (d > dj) above += __popc(um[d]); if (d == dj) mine = um[d]; }
            above += __popc(bj == 31 ? 0u : (mine >> (bj + 1)));
            if ((mine >> bj) & 1u) ULIST[1 + above] = tid;
            if (tid == 0) ULIST[0] = total;
        }
        __syncthreads();
        {
            const int nu = __builtin_amdgcn_readfirstlane(ULIST[0]);
            auto slc_src = [&](int i) { const int j = ULIST[1 + i]; TileSrc s; s.k = proj + ((size_t)b * SEQ + 64 * j) * PROJ_LD + PC_KS + g * 64; s.v = proj + ((size_t)b * SEQ + 64 * j) * PROJ_LD + PC_VS + g * 64; s.stride = PROJ_LD; s.nvalid = 64; return s; };
            NSA_REP(3) {
            NSA_STATE_INIT();
            NSA_PIPE(nu, slc_src, { const int j = __builtin_amdgcn_readfirstlane(ULIST[1 + i]);
                const bool sel = (SELM[tokl * 8 + (j >> 5)] >> (j & 31)) & 1u;
                if (__any(sel)) { const int hi = sel ? (t - 64 * j) : -1; const bool allv = __all(hi >= 63);
                    tile64(NSA_KB(i), NSA_VB(i), lane, qf, qx_one, 0, hi, allv, C1, sl2 * (float)(64 * j - t), st); } });
            }
            NSA_STATE_FOLD(1);
        }
        {
            const int nwt = tile + 1 < 9 ? tile + 1 : 9;
            auto win_src = [&](int i) { const int j = tile - i; TileSrc s; s.k = proj + ((size_t)b * SEQ + 64 * j) * PROJ_LD + PC_KW + g * 64; s.v = proj + ((size_t)b * SEQ + 64 * j) * PROJ_LD + PC_VW + g * 64; s.stride = PROJ_LD; s.nvalid = 64; return s; };
            NSA_REP(4) {
            NSA_STATE_INIT();
            NSA_PIPE(nwt, win_src, { const int j = tile - i; const int hi = t - 64 * j, lo = t - 511 - 64 * j; const bool allv = __all(hi >= 63 && lo <= 0);
                tile64(NSA_KB(i), NSA_VB(i), lane, qf, qx_one, lo, hi, allv, C1, sl2 * (float)(64 * j - t), st); });
            }
            NSA_STATE_FOLD(2);
        }
#pragma unroll
        for (int dt = 0; dt < 2; ++dt)
#pragma unroll
            for (int gq = 0; gq < 4; ++gq) {
                const f32x16& o = dt ? out1 : out0;
                u32x2 w; w.x = cvt_pk_bf16(o[4 * gq], o[4 * gq + 1]); w.y = cvt_pk_bf16(o[4 * gq + 2], o[4 * gq + 3]);
                *(u32x2*)(att + tok * D + (g * 4 + r) * 64 + 32 * dt + 8 * gq + 4 * h) = w;
            }
#undef NSA_STATE_INIT
#undef NSA_STATE_FOLD
#undef NSA_KB
#undef NSA_VB
#undef NSA_PIPE
    }
    NSA_REP(5) {
        const float* cw = a.in[I_CONV_W]; const float* cbias = a.in[I_CONV_B];
        const int gt = blockIdx.x * 512 + tid0, gs = gridDim.x * 512;
        for (int idx = gt; idx < M * 64; idx += gs) {
            const int c0 = (idx & 63) * 8; const int tokn = idx >> 6, tt = tokn & (SEQ - 1);
            const bf16* p = proj + (size_t)tokn * PROJ_LD;
            float z[3][8];
#pragma unroll
            for (int k = 0; k < 3; ++k) {
                if (tt >= 2 - k) { const u32x4 cc = *(const u32x4*)(p + PC_CC + c0 - (2 - k) * PROJ_LD), cu = *(const u32x4*)(p + PC_CU + c0 - (2 - k) * PROJ_LD);
                    z[k][0] = bflo(cc.x) * bflo(cu.x); z[k][1] = bfhi(cc.x) * bfhi(cu.x); z[k][2] = bflo(cc.y) * bflo(cu.y); z[k][3] = bfhi(cc.y) * bfhi(cu.y);
                    z[k][4] = bflo(cc.z) * bflo(cu.z); z[k][5] = bfhi(cc.z) * bfhi(cu.z); z[k][6] = bflo(cc.w) * bflo(cu.w); z[k][7] = bfhi(cc.w) * bfhi(cu.w); }
                else {
#pragma unroll
                    for (int j = 0; j < 8; ++j) z[k][j] = 0.f; }
            }
            const u32x4 cbv = *(const u32x4*)(p + PC_CB + c0);
            const float cbf[8] = {bflo(cbv.x), bfhi(cbv.x), bflo(cbv.y), bfhi(cbv.y), bflo(cbv.z), bfhi(cbv.z), bflo(cbv.w), bfhi(cbv.w)};
            float o[8];
#pragma unroll
            for (int j = 0; j < 8; ++j) { float y = cbias[c0 + j] + cw[2 * 512 + c0 + j] * z[2][j]; y += cw[512 + c0 + j] * z[1][j]; y += cw[c0 + j] * z[0][j]; o[j] = cbf[j] * y; }
            u32x4 w; w.x = cvt_pk_bf16(o[0], o[1]); w.y = cvt_pk_bf16(o[2], o[3]); w.z = cvt_pk_bf16(o[4], o[5]); w.w = cvt_pk_bf16(o[6], o[7]);
            *(u32x4*)(att + (size_t)tokn * D + 512 + c0) = w;
        }
    }
}

constexpr int SC_NCH = 64, SC_L = SEQ / SC_NCH, SC_NT = NB * 16 * SC_NCH;
constexpr int SM_L = 16;
constexpr int SM_RS = 144, SM_TS = 48;
constexpr int SM_AK = 0, SM_BH = 2304, SM_KH = 4608, SM_RH = 6912, SM_VV = 9216, SM_GAB = 11520, SM_GAK = 12672, SM_HRB = 13440, SM_HRK = 14208, SM_TT = 14976,
              SM_CL = 15744, SM_SS = 16000, SM_RK = 16064, SM_WAVE = 16128, SM_T1 = 0, SM_T2 = 16 * 65 * 4;
static_assert(2 * 16 * 65 * 4 <= SM_GAB, "MFMA scan LDS overlay");
static_assert(8 * SM_WAVE <= LDS_CTL_OFF, "MFMA scan LDS");
__device__ __forceinline__ bf16x8 sm_acc_hi(const f32x16& x, int ks) {
    union { u32x4 u; bf16x8 b; } c; c.u = (u32x4){cvt_pk_bf16(x[8 * ks], x[8 * ks + 1]), cvt_pk_bf16(x[8 * ks + 2], x[8 * ks + 3]), cvt_pk_bf16(x[8 * ks + 4], x[8 * ks + 5]), cvt_pk_bf16(x[8 * ks + 6], x[8 * ks + 7])}; return c.b; }
__device__ __forceinline__ bf16x8 sm_a_perm(const LAS unsigned char* tile, int rs, int row, int k0, int h) {
    const u32x2 lo = *(const LAS u32x2*)(tile + row * rs + (k0 + 4 * h) * 2), hi = *(const LAS u32x2*)(tile + row * rs + (k0 + 8 + 4 * h) * 2);
    union { u32x4 u; bf16x8 b; } c; c.u = (u32x4){lo.x, lo.y, hi.x, hi.y}; return c.b; }
__device__ __forceinline__ bf16x8 sm_nat(const LAS unsigned char* tile, int rs, int row, int k0, int h) { return *(const LAS bf16x8*)(tile + row * rs + (k0 + 8 * h) * 2); }
__device__ __forceinline__ bf16x8 sm_tr(const LAS unsigned char* tile, int col0, int lane) {
    const int i16 = lane & 15, g4 = lane >> 4;
    const LAS unsigned char* p = tile + (4 * (g4 >> 1) + (i16 >> 2)) * SM_RS + (col0 + 16 * (g4 & 1) + 4 * (i16 & 3)) * 2;
    const s16x4 v0 = __builtin_amdgcn_ds_read_tr16_b64_v4i16((LAS s16x4*)p), v1 = __builtin_amdgcn_ds_read_tr16_b64_v4i16((LAS s16x4*)(p + 8 * SM_RS));
    return (bf16x8){v0.x, v0.y, v0.z, v0.w, v1.x, v1.y, v1.z, v1.w};
}
#define SM_MFMA(a, b, c) __builtin_amdgcn_mfma_f32_32x32x16_bf16(a, b, c, 0, 0, 0)

__device__ __forceinline__ void scan_a_mfma_task(const Args& a, int task, int lane_in, LAS unsigned char* L) {
    int lane = lane_in; asm volatile("" : "+v"(lane));
    bf16* rkv = (bf16*)(a.ws + WS_BIG); const bf16* eag = (const bf16*)(a.ws + WS_EAG);
    float* pq = (float*)(a.ws + WS_PQ); float* rks = (float*)(a.ws + WS_RKS);
    const int c = task % SC_NCH, bh = task / SC_NCH, b = bh >> 4, hd = bh & 15, hb = hd * 64;
    LAS float* GAB = (LAS float*)(L + SM_GAB); LAS float* CL = (LAS float*)(L + SM_CL); LAS float* T1 = (LAS float*)(L + SM_T1); LAS float* T2 = (LAS float*)(L + SM_T2);
    LAS float* SS = (LAS float*)(L + SM_SS); LAS float* RK = (LAS float*)(L + SM_RK);
    f32x16 ZT[2][4];
#pragma unroll
    for (int jt = 0; jt < 2; ++jt)
#pragma unroll
        for (int zt = 0; zt < 4; ++zt)
#pragma unroll
            for (int e = 0; e < 16; ++e) { const int j = 32 * jt + (e & 3) + 8 * (e >> 2) + 4 * (lane >> 5), z = 32 * zt + (lane & 31); ZT[jt][zt][e] = (zt < 2 && j == z) ? 1.f : 0.f; }
    const size_t tokb = (size_t)b * SEQ + (size_t)c * SC_L;
#pragma unroll 1
    for (int mc = 0; mc < SC_L / SM_L; ++mc) {
        asm volatile("" : "+v"(lane));
        const int h = lane >> 5, c32 = lane & 31, t16 = c32 & 15, ch = hb + lane;
        const size_t tok0 = tokb + (size_t)mc * SM_L;
        {
            int ch_o = ch; asm volatile("" : "+v"(ch_o));
            const float kk_c = a.in[I_K_K][ch_o], ka_c = a.in[I_K_A][ch_o], rk_c = a.in[I_R_K][ch_o];
            unsigned rk_[SM_L], ea_[SM_L];
            {
                const int lr = lane >> 3, lc = lane & 7;
                const u32x4* pr = (const u32x4*)(rkv + (tok0 + lr) * RKV_LD + hb) + lc; const u32x4* pe = (const u32x4*)(eag + (tok0 + lr) * EAG_LD + hb) + lc;
                u32x4 gr[2], gk[2], gv[2], ge[2], ga[2];
#pragma unroll
                for (int i = 0; i < 2; ++i) { gr[i] = pr[i * RKV_LD]; gk[i] = pr[i * RKV_LD + 128]; gv[i] = pr[i * RKV_LD + 256]; ge[i] = pe[i * EAG_LD]; ga[i] = pe[i * EAG_LD + 128]; }
#pragma unroll
                for (int i = 0; i < 2; ++i) { LAS unsigned char* w = L + (lr + 8 * i) * SM_RS + lc * 16;
                    *(LAS u32x4*)(w + SM_AK) = gr[i]; *(LAS u32x4*)(w + SM_BH) = gk[i]; *(LAS u32x4*)(w + SM_VV) = gv[i]; *(LAS u32x4*)(w + SM_KH) = ge[i]; *(LAS u32x4*)(w + SM_RH) = ga[i]; }
#pragma unroll
                for (int s = 0; s < SM_L; ++s) { const LAS unsigned char* q = L + s * SM_RS + lane * 2;
                    const unsigned r = *(const LAS unsigned short*)(q + SM_AK), k = *(const LAS unsigned short*)(q + SM_BH), e = *(const LAS unsigned short*)(q + SM_KH), al = *(const LAS unsigned short*)(q + SM_RH);
                    rk_[s] = r | (k << 16); ea_[s] = al | (e << 16); }
            }
#pragma unroll
            for (int s = 0; s < SM_L; ++s) { const float k = bfhi(rk_[s]), kkr = k * kk_c, al = bflo(ea_[s]); T1[s * 65 + lane] = kkr * kkr; T2[s * 65 + lane] = bflo(rk_[s]) * (k * (1.0f + (al - 1.0f) * ka_c)) * rk_c; }
            { const int st = lane >> 2, pt = lane & 3; float s1 = 0.f, s2 = 0.f;
#pragma unroll
              for (int q = 0; q < 16; ++q) { s1 += T1[st * 65 + pt * 16 + q]; s2 += T2[st * 65 + pt * 16 + q]; }
              s1 += dpp_mov<0xB1>(s1); s1 += dpp_mov<0x4E>(s1); s2 += dpp_mov<0xB1>(s2); s2 += dpp_mov<0x4E>(s2);
              if (pt == 0) { SS[st] = s1; RK[st] = s2; } }
            if (lane < SM_L) rks[(tok0 + lane) * 16 + hd] = RK[lane];
            float cum = 0.f, cprev = 1.f;
#pragma unroll
            for (int s = 0; s < SM_L; ++s) {
                const float k = bfhi(rk_[s]), al = bflo(ea_[s]), r = bflo(rk_[s]);
                const float kk = k * kk_c * rsqrtf(fmaxf(SS[s], 1e-12f)), kp = k * (1.0f + (al - 1.0f) * ka_c);
                cum += bfhi(ea_[s]); const float ct = __expf(-cum), ict = __expf(cum);
                const float akv = kk * cprev, bhv = kk * al * ict, khv = kp * ict, rhv = r * ct;
                *(LAS bf16*)(L + SM_AK + s * SM_RS + lane * 2) = f2bf(akv); *(LAS bf16*)(L + SM_BH + s * SM_RS + lane * 2) = f2bf(bhv);
                *(LAS bf16*)(L + SM_KH + s * SM_RS + lane * 2) = f2bf(khv); *(LAS bf16*)(L + SM_RH + s * SM_RS + lane * 2) = f2bf(rhv);
                cprev = ct;
            }
            CL[lane] = cprev;
        }
        __builtin_amdgcn_sched_barrier(0);
        {
            f32x16 gab, gak, hrb, hrk;
#pragma unroll
            for (int e = 0; e < 16; ++e) { gab[e] = 0.f; gak[e] = 0.f; hrb[e] = 0.f; hrk[e] = 0.f; }
#pragma unroll
            for (int ks = 0; ks < 4; ++ks) {
                const bf16x8 fa = sm_nat(L + SM_AK, SM_RS, t16, 16 * ks, h), fr = sm_nat(L + SM_RH, SM_RS, t16, 16 * ks, h), fb = sm_nat(L + SM_BH, SM_RS, t16, 16 * ks, h), fk = sm_nat(L + SM_KH, SM_RS, t16, 16 * ks, h);
                gab = SM_MFMA(fa, fb, gab); gak = SM_MFMA(fa, fk, gak); hrb = SM_MFMA(fr, fb, hrb); hrk = SM_MFMA(fr, fk, hrk);
            }
            if (c32 < 16) {
#pragma unroll
                for (int e = 0; e < 8; ++e) { const int t = (e & 3) + 8 * (e >> 2) + 4 * h, s = c32;
                    GAB[t * 17 + s] = (s < t) ? gab[e] : 0.f;
                    *(LAS bf16*)(L + SM_GAK + t * SM_TS + s * 2) = f2bf((s < t) ? gak[e] : 0.f);
                    *(LAS bf16*)(L + SM_HRB + t * SM_TS + s * 2) = f2bf((s <= t) ? hrb[e] : 0.f);
                    *(LAS bf16*)(L + SM_HRK + t * SM_TS + s * 2) = f2bf((s <= t) ? hrk[e] : 0.f); }
            }
        }
        __builtin_amdgcn_sched_barrier(0);
        if (lane < 16) {
            float tc[16];
#pragma unroll
            for (int t = 0; t < 16; ++t) { float v = (t == lane) ? 1.f : 0.f;
#pragma unroll
                for (int s = 0; s < t; ++s) v -= GAB[t * 17 + s] * tc[s];
                tc[t] = v; *(LAS bf16*)(L + SM_TT + t * SM_TS + lane * 2) = f2bf(v); }
        }
        __builtin_amdgcn_sched_barrier(0);
#pragma unroll
        for (int zt = 0; zt < 4; ++zt) {
            f32x16 x, o;
#pragma unroll
            for (int e = 0; e < 16; ++e) { x[e] = 0.f; o[e] = 0.f; }
#pragma unroll
            for (int jt = 0; jt < 2; ++jt)
#pragma unroll
                for (int ks = 0; ks < 2; ++ks) {
                    const bf16x8 fa = sm_a_perm(L + SM_AK, SM_RS, t16, 32 * jt + 16 * ks, h), fr = sm_a_perm(L + SM_RH, SM_RS, t16, 32 * jt + 16 * ks, h);
                    const bf16x8 zh = sm_acc_hi(ZT[jt][zt], ks);
                    x = SM_MFMA(fa, zh, x); o = SM_MFMA(fr, zh, o);
                }
            if (zt >= 2) { const bf16x8 fv = sm_tr(L + SM_VV, 32 * (zt - 2), lane);
                x = SM_MFMA(sm_a_perm(L + SM_GAK, SM_TS, t16, 0, h), fv, x); o = SM_MFMA(sm_a_perm(L + SM_HRK, SM_TS, t16, 0, h), fv, o); }
            f32x16 sa;
#pragma unroll
            for (int e = 0; e < 16; ++e) sa[e] = 0.f;
            { const bf16x8 xh = sm_acc_hi(x, 0); const bf16x8 ft = sm_a_perm(L + SM_TT, SM_TS, t16, 0, h); sa = SM_MFMA(ft, xh, sa); }
#pragma unroll
            for (int e = 0; e < 16; ++e) sa[e] = -sa[e];
            const bf16x8 sh = sm_acc_hi(sa, 0);
            { const bf16x8 fh = sm_a_perm(L + SM_HRB, SM_TS, t16, 0, h); o = SM_MFMA(fh, sh, o); }
#pragma unroll
            for (int e = 0; e < 8; ++e) { const int t = (e & 3) + 8 * (e >> 2) + 4 * h;
                rkv[(tok0 + t) * RKV_LD + (zt < 2 ? hb + 32 * zt : 1024 + hb + 32 * (zt - 2)) + c32] = f2bf(o[e]); }
#pragma unroll
            for (int jt = 0; jt < 2; ++jt) {
                const bf16x8 fb = sm_tr(L + SM_BH, 32 * jt, lane);
                ZT[jt][zt] = SM_MFMA(fb, sh, ZT[jt][zt]);
                if (zt >= 2) ZT[jt][zt] = SM_MFMA(sm_tr(L + SM_KH, 32 * jt, lane), sm_tr(L + SM_VV, 32 * (zt - 2), lane), ZT[jt][zt]);
#pragma unroll
                for (int g = 0; g < 4; ++g) { const f32x4 c4 = *(const LAS f32x4*)(CL + 32 * jt + 8 * g + 4 * h);
                    ZT[jt][zt][4 * g] *= c4.x; ZT[jt][zt][4 * g + 1] *= c4.y; ZT[jt][zt][4 * g + 2] *= c4.z; ZT[jt][zt][4 * g + 3] *= c4.w; }

            }
            __builtin_amdgcn_sched_barrier(0);
        }
    }
    if (c < SC_NCH - 1) {
        float* dst = pq + ((size_t)(bh * (SC_NCH - 1) + c) * 2) * 4096;
#pragma unroll
        for (int jt = 0; jt < 2; ++jt)
#pragma unroll
            for (int zt = 0; zt < 4; ++zt)
#pragma unroll
                for (int g = 0; g < 4; ++g) { const int z = 32 * zt + (lane & 31), j0 = 32 * jt + 8 * g + 4 * (lane >> 5);
                    *(f32x4*)(dst + (size_t)z * 64 + j0) = (f32x4){ZT[jt][zt][4 * g], ZT[jt][zt][4 * g + 1], ZT[jt][zt][4 * g + 2], ZT[jt][zt][4 * g + 3]}; }
    }
}
__device__ __forceinline__ void scan_pass_a_mfma(const Args& a, LAS unsigned char* lds) {
    const int tid = threadIdx.x, wave = __builtin_amdgcn_readfirstlane(tid >> 6), lane = tid & 63, G = gridDim.x;
    for (int task = wave * G + blockIdx.x; task < SC_NT; task += 8 * G)
    {   unsigned z = 0u; asm volatile("" : "+v"(z));
        scan_a_mfma_task(a, task, (int)__builtin_amdgcn_mbcnt_hi(~0u, __builtin_amdgcn_mbcnt_lo(~0u, z)), lds + wave * SM_WAVE); }
}
#define PB_WAIT(n) asm volatile("s_waitcnt vmcnt(" #n ")" ::: "memory")
__device__ __forceinline__ void scan_pass_b(const Args& a, LAS unsigned char* lds) {
    const int tid = threadIdx.x, wave = __builtin_amdgcn_readfirstlane(tid >> 6), lane = tid & 63;
    LAS float* Pl = (LAS float*)lds;
    LAS float* Ql = Pl + 4 * 4096;
    float* pq = (float*)(a.ws + WS_PQ);
    for (int u = blockIdx.x; u < NB * 16 * 8; u += gridDim.x) {
        const int xcd = u & 7, idx = u >> 3, bh = (xcd * 4 + (idx >> 3)) & (NB * 16 - 1), row = (idx & 7) * 8 + wave;
        float* pc = pq + ((size_t)(bh * (SC_NCH - 1)) * 2) * 4096;
        float cur = 0.f;
        __syncthreads();
#define PB_ISSUE(cc) do { const int c_ = (cc) < SC_NCH - 1 ? (cc) : SC_NCH - 2; const float* g_ = pc + (size_t)c_ * 2 * 4096; LAS float* d_ = Pl + ((cc) & 3) * 4096 + wave * 256; \
            __builtin_amdgcn_global_load_lds((const unsigned*)(g_ + tid * 4), (LAS unsigned*)d_, 16, 0, 0); __builtin_amdgcn_global_load_lds((const unsigned*)(g_ + 2048 + tid * 4), (LAS unsigned*)(d_ + 2048), 16, 0, 0); \
            __builtin_amdgcn_global_load_lds((const unsigned*)(g_ + 4096 + row * 64 + lane), (LAS unsigned*)(Ql + ((cc) & 3) * 512 + wave * 64), 4, 0, 0); } while (0)
        PB_ISSUE(0); PB_ISSUE(1); PB_ISSUE(2);
        for (int c = 0; c < SC_NCH - 1; ++c) {
            if (c >= 3) PB_WAIT(9); else PB_WAIT(6);
            __builtin_amdgcn_s_barrier(); asm volatile("" ::: "memory");
            PB_ISSUE(c + 3);
            const LAS float* P = Pl + (c & 3) * 4096 + lane;
            float a0 = Ql[(c & 3) * 512 + wave * 64 + lane], a1 = 0.f, a2 = 0.f, a3 = 0.f;
#pragma unroll
            for (int k = 0; k < 64; k += 4) {
#define PB_BC(kk) __int_as_float(__builtin_amdgcn_readlane(__float_as_int(cur), (kk)))
                a0 = fmaf(PB_BC(k), P[k * 64], a0); a1 = fmaf(PB_BC(k + 1), P[(k + 1) * 64], a1); a2 = fmaf(PB_BC(k + 2), P[(k + 2) * 64], a2); a3 = fmaf(PB_BC(k + 3), P[(k + 3) * 64], a3);
            }
            cur = (a0 + a1) + (a2 + a3);
            pc[(size_t)c * 2 * 4096 + 4096 + row * 64 + lane] = cur;
        }
        PB_WAIT(0);
    }
}
__device__ __forceinline__ void pc_seg_load(const bf16* half_base, u32x2 (&out)[2][4]) {
#pragma unroll
    for (int gq = 0; gq < 4; ++gq) { const u32x4 L = ((const u32x4*)half_base)[gq];
        auto s0 = __builtin_amdgcn_permlane32_swap(L.x, L.z, false, false); auto s1 = __builtin_amdgcn_permlane32_swap(L.y, L.w, false, false);
        out[0][gq] = (u32x2){s0[0], s1[0]}; out[1][gq] = (u32x2){s0[1], s1[1]}; }
}
__device__ __forceinline__ void pc_seg_store(bf16* half_base, const u32x2 (&in)[2][4]) {
#pragma unroll
    for (int gq = 0; gq < 4; ++gq) {
        auto s0 = __builtin_amdgcn_permlane32_swap(in[0][gq].x, in[1][gq].x, false, false); auto s1 = __builtin_amdgcn_permlane32_swap(in[0][gq].y, in[1][gq].y, false, false);
        ((u32x4*)half_base)[gq] = (u32x4){s0[0], s1[0], s0[1], s1[1]}; }
}
constexpr int SCC_SS = 144;
__device__ __forceinline__ void scan_pass_c(const Args& a, LAS unsigned char* lds) {
    const int tid = threadIdx.x, wave = __builtin_amdgcn_readfirstlane(tid >> 6), lane = tid & 63, h32 = lane >> 5, c32 = lane & 31;
    bf16* rkv = (bf16*)(a.ws + WS_BIG); const bf16* eag = (const bf16*)(a.ws + WS_EAG);
    const float* pq = (const float*)(a.ws + WS_PQ); const float* rks = (const float*)(a.ws + WS_RKS);
    LAS unsigned char* SH = lds; LAS unsigned char* SL = lds + 64 * SCC_SS;
    for (int u = blockIdx.x; u < SC_NT; u += gridDim.x) {
        const int c = u % SC_NCH, bh = u / SC_NCH, b = bh >> 4, h = bh & 15, hb = h * 64;
        __syncthreads();
        if (c > 0) { const float* sp = pq + ((size_t)(bh * (SC_NCH - 1) + c - 1) * 2 + 1) * 4096 + tid * 8;
            const f32x4 x0 = *(const f32x4*)sp, x1 = *(const f32x4*)(sp + 4);
            const float xs[8] = {x0.x, x0.y, x0.z, x0.w, x1.x, x1.y, x1.z, x1.w};
            unsigned hi[4], lo[4];
#pragma unroll
            for (int q = 0; q < 4; ++q) { hi[q] = cvt_pk_bf16(xs[2 * q], xs[2 * q + 1]); lo[q] = cvt_pk_bf16(xs[2 * q] - bflo(hi[q]), xs[2 * q + 1] - bfhi(hi[q])); }
            *(LAS u32x4*)(SH + (tid >> 3) * SCC_SS + (tid & 7) * 16) = (u32x4){hi[0], hi[1], hi[2], hi[3]};
            *(LAS u32x4*)(SL + (tid >> 3) * SCC_SS + (tid & 7) * 16) = (u32x4){lo[0], lo[1], lo[2], lo[3]}; }
        __syncthreads();
        const size_t tok = (size_t)b * SEQ + (size_t)c * SC_L + wave * 32 + c32;
        f32x16 acc0, acc1;
#pragma unroll
        for (int e = 0; e < 16; ++e) { acc0[e] = 0.f; acc1[e] = 0.f; }
        if (c > 0) {
#pragma unroll
            for (int ks = 0; ks < 4; ++ks) {
                const bf16x8 pf = *(const bf16x8*)(rkv + tok * RKV_LD + hb + ks * 16 + h32 * 8);
                const bf16x8 a0h = *(const LAS bf16x8*)(SH + c32 * SCC_SS + h32 * 16 + ks * 32), a0l = *(const LAS bf16x8*)(SL + c32 * SCC_SS + h32 * 16 + ks * 32);
                const bf16x8 a1h = *(const LAS bf16x8*)(SH + (32 + c32) * SCC_SS + h32 * 16 + ks * 32), a1l = *(const LAS bf16x8*)(SL + (32 + c32) * SCC_SS + h32 * 16 + ks * 32);
                acc0 = __builtin_amdgcn_mfma_f32_32x32x16_bf16(a0h, pf, acc0, 0, 0, 0); acc0 = __builtin_amdgcn_mfma_f32_32x32x16_bf16(a0l, pf, acc0, 0, 0, 0);
                acc1 = __builtin_amdgcn_mfma_f32_32x32x16_bf16(a1h, pf, acc1, 0, 0, 0); acc1 = __builtin_amdgcn_mfma_f32_32x32x16_bf16(a1l, pf, acc1, 0, 0, 0);
            }
        }
        u32x2 yqw[2][4], vw[2][4], gw2[2][4];
        pc_seg_load(rkv + tok * RKV_LD + 1024 + hb + 32 * h32, yqw); pc_seg_load(rkv + tok * RKV_LD + 2048 + hb + 32 * h32, vw); pc_seg_load(eag + tok * EAG_LD + 2048 + hb + 32 * h32, gw2);
        float y[32]; float sum = 0.f;
#pragma unroll
        for (int it = 0; it < 2; ++it)
#pragma unroll
            for (int gq = 0; gq < 4; ++gq) {
                const u32x2 w = yqw[it][gq];
                const float q4[4] = {bflo(w.x), bfhi(w.x), bflo(w.y), bfhi(w.y)};
#pragma unroll
                for (int j = 0; j < 4; ++j) { const float v = (it ? acc1[4 * gq + j] : acc0[4 * gq + j]) + q4[j]; y[it * 16 + gq * 4 + j] = v; sum += v; }
            }
        const float mean = xor32_sum(sum) * (1.0f / 64.0f); float qs = 0.f;
#pragma unroll
        for (int e = 0; e < 32; ++e) { const float d = y[e] - mean; qs += d * d; }
        const float rstd = rsqrtf(xor32_sum(qs) * (1.0f / 64.0f) + 64e-5f);
        const float rkc = rks[tok * 16 + h];
        u32x2 ow[2][4];
#pragma unroll
        for (int it = 0; it < 2; ++it)
#pragma unroll
            for (int gq = 0; gq < 4; ++gq) {
                const int i0 = 32 * it + 8 * gq + 4 * h32;
                const f32x4 lg = *(const f32x4*)(a.in[I_LNX_G] + hb + i0), lb = *(const f32x4*)(a.in[I_LNX_B] + hb + i0);
                const float v4[4] = {bflo(vw[it][gq].x), bfhi(vw[it][gq].x), bflo(vw[it][gq].y), bfhi(vw[it][gq].y)}, g4[4] = {bflo(gw2[it][gq].x), bfhi(gw2[it][gq].x), bflo(gw2[it][gq].y), bfhi(gw2[it][gq].y)};
                const float l4[4] = {lg.x, lg.y, lg.z, lg.w}, b4[4] = {lb.x, lb.y, lb.z, lb.w};
                float o[4];
#pragma unroll
                for (int j = 0; j < 4; ++j) o[j] = ((y[it * 16 + gq * 4 + j] - mean) * rstd * l4[j] + b4[j] + rkc * v4[j]) * g4[j];
                ow[it][gq] = (u32x2){cvt_pk_bf16(o[0], o[1]), cvt_pk_bf16(o[2], o[3])};
            }
        pc_seg_store(rkv + tok * RKV_LD + hb + 32 * h32, ow);
    }
}

constexpr int N_PHASES = 27;
__global__ void __launch_bounds__(512, 2) mk_fwd(Args args) {
    extern __shared__ __attribute__((aligned(16))) unsigned char lds_raw[];
    LAS unsigned char* lds = (LAS unsigned char*)lds_raw;
    const int tid = threadIdx.x;
    const int G = gridDim.x, nw = G * 8, gsize = G * 512;
#define TIDO() ({ int t_ = threadIdx.x; asm volatile("" : "+v"(t_)); t_; })
#define lane (TIDO() & 63)
#define gw ((int)blockIdx.x * 8 + (TIDO() >> 6))
#define gtid ((int)blockIdx.x * 512 + TIDO())
    unsigned char* ws = args.ws;
    volatile LAS unsigned* lctl = (volatile LAS unsigned*)(lds + LDS_CTL_OFF);
    if (tid < 16) lctl[tid] = 0u;
    __syncthreads();
    const int lo = args.ph_lo, hi = args.ph_hi;
    XcdBarrier bar; bar.bar = (unsigned*)(ws + WS_CTL) + CW_BAR; bar.x = 0; bar.st = nullptr;
    if (hi - lo > 1) bar = xcd_barrier_post((unsigned*)(ws + WS_CTL) + CW_BAR, lctl + 8);
#define IN(k) (lo <= (k) && (k) < hi)
#ifndef PROBE_DUP
#define PROBE_DUP 0u
#endif
#define RUN(k, ...) do { if (IN(k)) { __VA_ARGS__; if ((PROBE_DUP >> (k)) & 1u) { xcd_barrier(bar); __VA_ARGS__; } } if (IN(k) && IN((k) + 1)) xcd_barrier(bar); } while (0)
    float* X = args.out;
    bf16* XNp = (bf16*)(ws + WS_XN);
    const pg8::bf16_t* XNa = (const pg8::bf16_t*)(ws + WS_XN) + D;
    bf16* DD = (bf16*)(ws + WS_DD);
    pg8::bf16_t* BIG = (pg8::bf16_t*)(ws + WS_BIG);
    pg8::bf16_t* YY = (pg8::bf16_t*)(ws + WS_Y);
    const unsigned char* Wb = ws + WS_W;
    const int bx = (int)blockIdx.x;

#define GEMM_CALL(MODE, Aptr, Woff, N_, K_, lda_, gap_, ts_, Optr, ldc_, b0_, b1_) do { pg8::Gemm g{Aptr, (const pg8::bf16_t*)(Wb + (Woff)), M, N_, K_, lda_, gap_, ts_}; pg8::StaticOrder S; S.init(M, N_, G, bx); \
        pg8::Epi<MODE> E{Optr, ldc_, b0_, b1_}; pg8::gemm_phase(lds, g, S, E); } while (0)
#define FFN_G1(k) RUN(k, GEMM_CALL(1, XNa, W_GU, 2 * FF, D, D, 1, D / 64, BIG, FF, nullptr, nullptr))
#define FFN_G2(k, outp) RUN(k, do { pg8::Gemm g{BIG, (const pg8::bf16_t*)(Wb + W_DN), M, D, FF, FF, 0, FF / 64}; pg8::StaticOrder S; S.init(M, D, G, bx); S.rev = 1; \
        pg8::Epi<0> E{(pg8::bf16_t*)(outp), D, nullptr, nullptr}; pg8::gemm_phase(lds, g, S, E); } while (0))
    bf16* DY = (bf16*)(ws + WS_Y);
    const pg8::bf16_t* ATT = (const pg8::bf16_t*)(ws + WS_ATT);

    RUN(0, row_pass<false, false, false, true>(args.in[I_X], nullptr, nullptr, nullptr, 0.f, nullptr, nullptr, 0.f, args.in[I_L0F1 + 0], XNp, gw, nw, lane); convert_ffn(args, I_L0F1, gtid, gsize, lds));
    FFN_G1(1); FFN_G2(2, DY);
    RUN(3, row_pass<true, false, false, true>(args.in[I_X], nullptr, DY, args.in[I_L0F1 + 1], 0.5f, nullptr, nullptr, 0.f, args.in[I_L0_MIX_PRE], XNp, gw, nw, lane); convert_mix0(args, gtid, gsize, lds));
    RUN(4, GEMM_CALL(0, XNa, W_IN, PROJ_LD, D, D, 1, D / 64, BIG, PROJ_LD, nullptr, nullptr));
    RUN(5, do {
        pg8::Gemm g{BIG + PC_KC, (const pg8::bf16_t*)(Wb + W_CMP), 8192, 256, 2048 / CMP_SPLIT, PROJ_LD, 0, 32, 2048}; pg8::SplitTiles S{G, bx, CMP_SPLIT * 32};
        pg8::Epi<6> E{(pg8::bf16_t*)(ws + WS_XN), 128, nullptr, nullptr}; pg8::gemm_phase<pg8::Epi<6>, pg8::SplitTiles, true>(lds, g, S, E); } while (0));
    RUN(6, compress_stage2(args, gw, nw, lane));
    RUN(7, nsa_mfma_phase(args, lds));
    RUN(8, GEMM_CALL(0, ATT, W_OUT, D, D, D, 0, D / 64, (pg8::bf16_t*)DD, D, nullptr, nullptr));
    RUN(9, row_pass<true, true, true, true>(args.in[I_X], X, DY, args.in[I_L0F1 + 1], 0.5f, DD, args.in[I_L0_MIX_POST], 1.0f, args.in[I_L0F2 + 0], XNp, gw, nw, lane); convert_ffn(args, I_L0F2, gtid, gsize, lds));
    FFN_G1(10); FFN_G2(11, DD);
    RUN(12, row_pass<true, false, false, true>(X, nullptr, DD, args.in[I_L0F2 + 1], 0.5f, nullptr, nullptr, 0.f, args.in[I_L1F1 + 0], XNp, gw, nw, lane); convert_ffn(args, I_L1F1, gtid, gsize, lds));
    FFN_G1(13); FFN_G2(14, DY);
    RUN(15, row_pass<true, true, true, true>(X, X, DD, args.in[I_L0F2 + 1], 0.5f, DY, args.in[I_L1F1 + 1], 0.5f, args.in[I_L1_MIX_PRE], XNp, gw, nw, lane); convert_mix1(args, gtid, gsize, lds));
    RUN(16, rwkv_mix_phase(args, gtid, gsize));
    RUN(17, GEMM_CALL(0, (const pg8::bf16_t*)(ws + WS_XR), W_R, D, D, D, 0, D / 64, BIG, RKV_LD, nullptr, nullptr);
            GEMM_CALL(0, (const pg8::bf16_t*)(ws + WS_XK), W_K, D, D, D, 0, D / 64, BIG + 1024, RKV_LD, nullptr, nullptr);
            GEMM_CALL(0, (const pg8::bf16_t*)(ws + WS_XV), W_V, D, D, D, 0, D / 64, BIG + 2048, RKV_LD, nullptr, nullptr);
            GEMM_CALL(5, XNa, W_LORA, 256, 2 * D, D, 1, D / 64, BIG + 3072, RKV_LD, nullptr, nullptr);
            convert_mix1_l2(args, gtid, gsize, lds));
    RUN(18, do { pg8::Gemm g{BIG + 3072, (const pg8::bf16_t*)(Wb + W_L2), M, 2048, 128, RKV_LD, 0, 2, 256}; pg8::StaticOrder S; S.init(M, 2048, G, bx);
                 pg8::Epi<3> E{(pg8::bf16_t*)(ws + WS_EAG), EAG_LD, args.in[I_W0], args.in[I_A0]}; pg8::gemm_phase(lds, g, S, E); } while (0);
            do { pg8::Gemm g{BIG + 3072 + 128, (const pg8::bf16_t*)(Wb + W_L2) + (size_t)2048 * 256 + 128, M, 1024, 128, RKV_LD, 0, 2, 256}; pg8::StaticOrder S; S.init(M, 1024, G, bx);
                 pg8::Epi<0> E{(pg8::bf16_t*)(ws + WS_EAG) + 2048, EAG_LD, nullptr, nullptr}; pg8::gemm_phase(lds, g, S, E); } while (0));
    RUN(19, scan_pass_a_mfma(args, lds));
    RUN(20, scan_pass_b(args, lds));
    RUN(21, scan_pass_c(args, lds));
    RUN(22, GEMM_CALL(0, BIG, W_O, D, D, RKV_LD, 0, D / 64, (pg8::bf16_t*)DD, D, nullptr, nullptr));
    RUN(23, row_pass<true, false, false, true>(X, nullptr, DD, args.in[I_L1_MIX_POST], 1.0f, nullptr, nullptr, 0.f, args.in[I_L1F2 + 0], XNp, gw, nw, lane); convert_ffn(args, I_L1F2, gtid, gsize, lds));
    FFN_G1(24); FFN_G2(25, DY);
    RUN(26, row_pass<true, true, true, false>(X, X, DD, args.in[I_L1_MIX_POST], 1.0f, DY, args.in[I_L1F2 + 1], 0.5f, nullptr, nullptr, gw, nw, lane));
#undef IN
#undef RUN
#undef lane
#undef gw
#undef gtid
#undef TIDO
}

extern "C" void kernel_launch(void* const* d_in, const int* in_sizes, int n_in, void* d_out, int out_size, void* d_ws, size_t ws_size, hipStream_t stream) {
    static int grid = 0;
    if (grid == 0) {
        if (n_in != 53 || out_size != M * D || ws_size < WS_END) { fprintf(stderr, "kernel_launch: unexpected shapes (n_in %d, out %d, ws %zu)\n", n_in, out_size, ws_size); grid = -1; return; }
        int dev = 0, cus = 0;
        if (hipGetDevice(&dev) != hipSuccess || hipDeviceGetAttribute(&cus, hipDeviceAttributeMultiprocessorCount, dev) != hipSuccess) { grid = -1; return; }
        if (hipFuncSetAttribute((const void*)mk_fwd, hipFuncAttributeMaxDynamicSharedMemorySize, LDS_BYTES) != hipSuccess) { fprintf(stderr, "kernel_launch: hipFuncSetAttribute failed\n"); grid = -1; return; }
        int per_cu = 0;
        if (hipOccupancyMaxActiveBlocksPerMultiprocessor(&per_cu, (const void*)mk_fwd, 512, LDS_BYTES) != hipSuccess || per_cu < 1) { fprintf(stderr, "kernel_launch: occupancy query says %d\n", per_cu); }
        (void)hipGetLastError();
        grid = cus;
    }
    if (grid < 0) return;
    (void)hipMemsetAsync((char*)d_ws + WS_CTL, 0, CTL_ZERO_BYTES, stream);
    Args a{};
    for (int i = 0; i < 53; ++i) a.in[i] = (const float*)d_in[i];
    a.out = (float*)d_out; a.ws = (unsigned char*)d_ws;
#if MK_ONE_LAUNCH
    a.ph_lo = 0; a.ph_hi = N_PHASES;
    hipLaunchKernelGGL(mk_fwd, dim3(grid), dim3(512), LDS_BYTES, stream, a);
#else
    for (int p = 0; p < N_PHASES; ++p) { a.ph_lo = p; a.ph_hi = p + 1; hipLaunchKernelGGL(mk_fwd, dim3(grid), dim3(512), LDS_BYTES, stream, a); }
#endif
}
```

```cpp
#include <hip/hip_runtime.h>
#include <cstdio>
#include <cstdint>

#ifndef MK_ONE_LAUNCH
#define MK_ONE_LAUNCH 1
#endif

#define LAS __attribute__((address_space(3)))
typedef unsigned short bf16;
typedef short bf16x8 __attribute__((ext_vector_type(8)));
typedef float f32x4 __attribute__((ext_vector_type(4)));
typedef float f32x2 __attribute__((ext_vector_type(2)));
typedef unsigned u32x4 __attribute__((ext_vector_type(4)));
typedef unsigned u32x2 __attribute__((ext_vector_type(2)));

constexpr int NB = 2, SEQ = 16384, M = NB * SEQ, D = 1024, FF = 2816;
constexpr int NCMP = 1023, NSLC = 256;
constexpr int PROJ_LD = 3072;
constexpr int PC_Q = 0, PC_KC = 512, PC_VC = 640, PC_KS = 768, PC_VS = 896, PC_KW = 1024, PC_VW = 1152, PC_CB = 1280, PC_CC = 1792, PC_CU = 2304, PC_G = 2816;
constexpr int RKV_LD = 3328;
constexpr int EAG_LD = 3072;
constexpr float EPS = 1e-6f;

constexpr size_t MiB = 1u << 20;
constexpr size_t WS_CTL = 0, CTL_ZERO_BYTES = 1 * MiB;
constexpr size_t WS_KC = 1 * MiB, WS_VC = 2 * MiB;
constexpr size_t WS_W = 8 * MiB;
constexpr size_t WS_BIG = 28 * MiB;
constexpr size_t WS_EAG = 236 * MiB;
constexpr size_t WS_XN = 236 * MiB;
constexpr size_t WS_DD = 302 * MiB;
constexpr size_t WS_ATT = 236 * MiB;
constexpr size_t WS_Y = 428 * MiB;
constexpr size_t WS_PQ = 428 * MiB;
constexpr size_t WS_XR = 302 * MiB, WS_XK = 366 * MiB, WS_XV = 430 * MiB;
constexpr size_t WS_RKS = 494 * MiB;
constexpr size_t WS_END = 496 * MiB;
constexpr size_t W_GU = 0, W_DN = 11 * MiB;
constexpr size_t W_IN = 0, W_OUT = 6 * MiB, W_CMP = 8 * MiB;
constexpr size_t WS_PEB = 1 * MiB + 768 * 1024;
constexpr size_t W_R = 0, W_K = 2 * MiB, W_V = 4 * MiB, W_LORA = 6 * MiB, W_L2 = 13 * MiB, W_O = 15 * MiB;

constexpr int CW_BAR = 4096;

constexpr int LDS_CTL_OFF = 147456;
constexpr int LDS_BYTES = 147456 + 256;

__device__ __forceinline__ float bf2f(bf16 b) { return __uint_as_float(((unsigned)b) << 16); }
__device__ __forceinline__ float bflo(unsigned u) { return __uint_as_float(u << 16); }
__device__ __forceinline__ float bfhi(unsigned u) { return __uint_as_float(u & 0xffff0000u); }
typedef __bf16 nbf16x2 __attribute__((ext_vector_type(2)));
typedef float nf32x2 __attribute__((ext_vector_type(2)));
__device__ __forceinline__ unsigned cvt_pk_bf16(float lo, float hi) { const nf32x2 v = {lo, hi}; return __builtin_bit_cast(unsigned, __builtin_convertvector(v, nbf16x2)); }
__device__ __forceinline__ bf16 f2bf(float f) { return (bf16)(cvt_pk_bf16(f, 0.f) & 0xffffu); }
__device__ __forceinline__ float wave_sum(float v) {
#pragma unroll
    for (int o = 1; o < 64; o <<= 1) v += __shfl_xor(v, o);
    return v;
}
template <int CTRL, int ROWMASK> __device__ __forceinline__ float dpp_add(float x) { const int t = __builtin_amdgcn_update_dpp(0, __float_as_int(x), CTRL, ROWMASK, 0xF, false); return x + __int_as_float(t); }
__device__ __forceinline__ float wave_sum_dpp(float v) {
    v = dpp_add<0xB1, 0xF>(v); v = dpp_add<0x4E, 0xF>(v); v = dpp_add<0x124, 0xF>(v); v = dpp_add<0x128, 0xF>(v);
    v = dpp_add<0x142, 0xA>(v); v = dpp_add<0x143, 0xC>(v);
    return __int_as_float(__builtin_amdgcn_readlane(__float_as_int(v), 63));
}
template <int CTRL> __device__ __forceinline__ float dpp_mov(float x) { return __int_as_float(__builtin_amdgcn_mov_dpp(__float_as_int(x), CTRL, 0xf, 0xf, true)); }
template <int CTRL> __device__ __forceinline__ int dpp_movi(int x) { return __builtin_amdgcn_mov_dpp(x, CTRL, 0xf, 0xf, true); }
__device__ __forceinline__ float xor32_max(float x) { auto rr = __builtin_amdgcn_permlane32_swap(__float_as_uint(x), __float_as_uint(x), false, false); return fmaxf(__uint_as_float(rr[0]), __uint_as_float(rr[1])); }
__device__ __forceinline__ float xor32_sum(float x) { auto rr = __builtin_amdgcn_permlane32_swap(__float_as_uint(x), __float_as_uint(x), false, false); return __uint_as_float(rr[0]) + __uint_as_float(rr[1]); }
__device__ __forceinline__ float red8(float v) { v += dpp_mov<0xB1>(v); v += dpp_mov<0x4E>(v); v += dpp_mov<0x141>(v); return v; }
__device__ __forceinline__ float wave_max(float v) {
#pragma unroll
    for (int o = 1; o < 64; o <<= 1) v = fmaxf(v, __shfl_xor(v, o));
    return v;
}
__device__ __forceinline__ float sigmoidf_(float x) { return __builtin_amdgcn_rcpf(1.0f + __expf(-x)); }

namespace pg8 {
#define PG8_LAS __attribute__((address_space(3)))
typedef unsigned short bf16_t;
constexpr int BM = 256, BK = 64, HALF = 128, HTB = HALF * BK * 2, STAGE_BYTES = 8 * HTB, NXCD = 8, WGM = 8;

__host__ __device__ __forceinline__ int lds_byte(int r, int c) { const int st = (r >> 4) * 2 + (c >> 5), rr = r & 15, cc = c & 31, ob = rr * 64 + cc * 2; return st * 1024 + (ob ^ (((ob >> 9) & 1) << 5)); }
__host__ __device__ __forceinline__ void stage_rc(int b, int& R, int& C) { const int st = b / 1024, sb = b % 1024, swz = sb ^ (((sb >> 9) & 1) << 5); R = (st >> 1) * 16 + swz / 64; C = (st & 1) * 32 + (swz % 64) / 2; }
__host__ __device__ __forceinline__ int perm32(int rho) { const int n = rho >> 4, i = rho & 15; return 8 * (i >> 2) + 4 * n + (i & 3); }

struct Unit { int pm, pn; };
struct Gemm { const bf16_t* A; const bf16_t* Bt; int M, N, K, lda, gap, ts, ldb = 0; };

struct StaticOrder {
    int nM, nN, nwg, G, c, rev = 0;
    __host__ __device__ void init(int M_, int N_, int G_, int c_) { nM = M_ / BM; nN = N_ / BM; nwg = nM * nN; G = G_; c = c_; }
    __host__ __device__ bool next(int i, Unit& u) const {
        const int rounds = nwg / G; const bool flip = rev && rounds * G == nwg;
        if (flip && i >= rounds) return false;
        const long L = (long)(flip ? rounds - 1 - i : i) * G + c; if (L >= nwg) return false;
        int wgid = (int)L; { const int q = nwg / NXCD, r = nwg % NXCD, xcd = wgid % NXCD, off = wgid / NXCD; wgid = (xcd < r ? xcd * (q + 1) : r * (q + 1) + (xcd - r) * q) + off; }
        const int nig = WGM * nN, gid = wgid / nig, fm = gid * WGM, gsz = (nM - fm) < WGM ? (nM - fm) : WGM;
        u.pm = fm + ((wgid % nig) % gsz); u.pn = (wgid % nig) / gsz; return true;
    }
    __device__ __forceinline__ void a_ready(const Unit&) const {}
    __device__ __forceinline__ void done(const Unit&) const {}
};

struct SplitTiles {
    int G, c, n;
    __host__ __device__ bool next(int i, Unit& u) const { const int L = i * G + c; if (L >= n) return false; u.pm = L & 31; u.pn = L >> 5; return true; }
    __device__ __forceinline__ void a_ready(const Unit&) const {}
    __device__ __forceinline__ void done(const Unit&) const {}
};

template <int MODE> struct Epi {
    static constexpr bool PERM = true, AFTER_DRAIN = false;
    bf16_t* O; int ldc; const float* b0; const float* b1;
    __device__ __forceinline__ void operator()(const f32x4 (&acc)[2][2][4][2], const Unit& u, int wr, int wc, int, int) const {
        int ln_ = threadIdx.x; asm volatile("" : "+v"(ln_));
        const int fr = ln_ & 15, fq = (ln_ >> 4) & 3;
        if constexpr (MODE == 4 || MODE == 6) {
            const int row0 = u.pm * BM + wr * 64 + fr;
            const int kv = u.pm >> 4, col0 = wc * 32 + 8 * fq; float* H = (float*)O + (MODE == 6 ? (size_t)u.pn * 8192 * 128 : (size_t)0);
#pragma unroll
            for (int ai = 0; ai < 2; ++ai)
#pragma unroll
                for (int m = 0; m < 4; ++m) {
                    float o[8];
#pragma unroll
                    for (int n = 0; n < 2; ++n)
#pragma unroll
                        for (int j = 0; j < 4; ++j) {
                            if constexpr (MODE == 6) o[n * 4 + j] = kv ? acc[ai][1][m][n][j] : acc[ai][0][m][n][j];
                            else { const float hh = (kv ? acc[ai][1][m][n][j] : acc[ai][0][m][n][j]) + b0[kv * 128 + col0 + n * 4 + j];
                                const float uu = 0.7978845608028654f * (hh + 0.044715f * hh * hh * hh); const float e2 = __expf(2.0f * uu); o[n * 4 + j] = 0.5f * hh * (2.0f - 2.0f * __builtin_amdgcn_rcpf(e2 + 1.0f)); } }
                    float* hp = H + (size_t)(row0 + ai * HALF + m * 16) * 128 + col0;
                    *(f32x4*)hp = (f32x4){o[0], o[1], o[2], o[3]}; *(f32x4*)(hp + 4) = (f32x4){o[4], o[5], o[6], o[7]};
                }
        } else if constexpr (MODE == 1) {
            const int row0 = u.pm * BM + wr * 64 + fr;
            const int col0 = u.pn * HALF + wc * 32 + 8 * fq;
#pragma unroll
            for (int ai = 0; ai < 2; ++ai)
#pragma unroll
                for (int m = 0; m < 4; ++m) {
                    float o[8];
#pragma unroll
                    for (int n = 0; n < 2; ++n)
#pragma unroll
                        for (int j = 0; j < 4; ++j) { const float g = acc[ai][0][m][n][j], up = acc[ai][1][m][n][j]; o[n * 4 + j] = g * __builtin_amdgcn_rcpf(1.0f + __expf(-g)) * up; }
                    u32x4 w; w.x = cvt_pk_bf16(o[0], o[1]); w.y = cvt_pk_bf16(o[2], o[3]); w.z = cvt_pk_bf16(o[4], o[5]); w.w = cvt_pk_bf16(o[6], o[7]);
                    *(u32x4*)(O + (size_t)(row0 + ai * HALF + m * 16) * ldc + col0) = w;
                }
        } else {
            const int row0 = u.pm * BM + wr * 64 + fr;
            const int col0 = u.pn * BM + wc * 32 + 8 * fq;
#pragma unroll
            for (int ai = 0; ai < 2; ++ai)
#pragma unroll
                for (int m = 0; m < 4; ++m) {
                    bf16_t* rowp = O + (size_t)(row0 + ai * HALF + m * 16) * ldc + col0;
#pragma unroll
                    for (int bj = 0; bj < 2; ++bj) {
                        float o[8];
#pragma unroll
                        for (int n = 0; n < 2; ++n)
#pragma unroll
                            for (int j = 0; j < 4; ++j) o[n * 4 + j] = acc[ai][bj][m][n][j];
                        if constexpr (MODE == 2 || MODE == 5) {
                            if (u.pn == (MODE == 2 ? 12 : 0)) {
                                if (bj == 1) {
#pragma unroll
                                    for (int j = 0; j < 8; ++j) o[j] = sigmoidf_(o[j]);
                                } else if (wc < 2) {
#pragma unroll
                                    for (int j = 0; j < 8; ++j) { const float e2 = __expf(2.0f * o[j]); o[j] = 1.0f - 2.0f * __builtin_amdgcn_rcpf(e2 + 1.0f); }
                                }
                            }
                        }
                        if constexpr (MODE == 3) {
                            const int cc = (u.pn & 3) * BM + bj * HALF + wc * 32 + 8 * fq;
                            if (u.pn < 4) {
#pragma unroll
                                for (int j = 0; j < 8; ++j) o[j] = 0.60653065971f * sigmoidf_(o[j] + b0[cc + j]);
                            } else if (u.pn < 8) {
#pragma unroll
                                for (int j = 0; j < 8; ++j) o[j] = sigmoidf_(o[j] + b1[cc + j]);
                            }
                        }
                        u32x4 w; w.x = cvt_pk_bf16(o[0], o[1]); w.y = cvt_pk_bf16(o[2], o[3]); w.z = cvt_pk_bf16(o[4], o[5]); w.w = cvt_pk_bf16(o[6], o[7]);
                        *(u32x4*)(rowp + bj * HALF) = w;
                    }
                }
        }
    }
};

template <class EpiT, class Sched, bool CMPA = false, bool ALIGN_EPI = true, bool SP2 = true>
__device__ __forceinline__ void gemm_phase(PG8_LAS unsigned char* lds, const Gemm g, const Sched& S, const EpiT& E) {
    const int tid = threadIdx.x, wid = __builtin_amdgcn_readfirstlane(tid >> 6), lane = tid & 63, wr = wid >> 2, wc = wid & 3, fr = lane & 15, fq = lane >> 4;
    const int K = g.K, nt = K / BK, lda = g.lda, ts = g.ts, ldb = g.ldb ? g.ldb : g.K;
    unsigned voffA[2], voffB[2];
#pragma unroll
    for (int i = 0; i < 2; ++i) { int R, C; stage_rc(tid * 16 + i * 8192, R, C); const int Rb = EpiT::PERM ? ((R & ~31) + perm32(R & 31)) : R;
        voffA[i] = CMPA ? (unsigned)((R >> 1) * 16 * lda + (R & 1) * 64 + C) * 2u : (unsigned)(R * lda + C) * 2u; voffB[i] = (unsigned)(Rb * ldb + C) * 2u; }
    const size_t kstep = (size_t)(BK * 2), kstepA = CMPA ? (size_t)lda * 2 : kstep;
    const size_t hstepA = CMPA ? (size_t)64 * 16 * lda * 2 : (size_t)HALF * lda * 2, hstepB = (size_t)HALF * ldb * 2;
    const size_t tstepB = 2 * hstepB, rowA = (size_t)lda * 2;
    const unsigned ldsw = (unsigned)wid * 1024u;
    const int aoff = lds_byte(wr * 64 + fr, fq * 8), boff = lds_byte(wc * 32 + fr, fq * 8);
#define PG8_BBASE(pn) (CMPA ? (const char*)g.Bt + (size_t)(pn) * ((size_t)nt * kstep) : (const char*)g.Bt + (size_t)(pn) * tstepB)
#define PG8_ASLICE(pn) (CMPA ? (size_t)(pn) * ((size_t)nt * kstepA) : (size_t)0)
#define PG8_ABASE(pm) (CMPA ? (const char*)g.A + ((size_t)((pm) & 15) * 128 * 16 * lda + (size_t)((pm) >> 4) * 128) * 2 : (const char*)g.A + ((size_t)(pm) * BM + ((g.gap && (pm) >= 64) ? 1 : 0)) * rowA)
#define PG8_KOFF(t) (CMPA ? (ptrdiff_t)(t) * (ptrdiff_t)kstepA : (((t) < ts) ? (ptrdiff_t)(t) * (ptrdiff_t)kstep : (ptrdiff_t)((t) - ts) * (ptrdiff_t)kstep - (ptrdiff_t)rowA))
#define PG8_SA(b, h) (((b) * 2 + (h)) * HTB)
#define PG8_SB(b, h) ((4 + (b) * 2 + (h)) * HTB)
#define PG8_STAGE(bufoff, gbase, voff) do { _Pragma("unroll") for (int _i = 0; _i < 2; ++_i) \
        __builtin_amdgcn_global_load_lds((const unsigned*)((const char*)(gbase) + (voff)[_i]), (PG8_LAS unsigned*)(lds + (bufoff) + ldsw + _i * 8192), 16, 0, 0); } while (0)
#define PG8_LDA(dst, b, h) do { _Pragma("unroll") for (int m = 0; m < 4; ++m) _Pragma("unroll") for (int k = 0; k < 2; ++k) dst[m][k] = *(const PG8_LAS bf16x8*)(lds + PG8_SA(b, h) + aoff + m * 2048 + k * 1024); } while (0)
#define PG8_LDB(dst, b, h) do { _Pragma("unroll") for (int n = 0; n < 2; ++n) _Pragma("unroll") for (int k = 0; k < 2; ++k) dst[n][k] = *(const PG8_LAS bf16x8*)(lds + PG8_SB(b, h) + boff + n * 2048 + k * 1024); } while (0)
#define PG8_MMA(ai, bj, At, Bt) do { __builtin_amdgcn_s_setprio(1); _Pragma("unroll") for (int m = 0; m < 4; ++m) _Pragma("unroll") for (int n = 0; n < 2; ++n) _Pragma("unroll") for (int k = 0; k < 2; ++k) \
        acc[ai][bj][m][n] = __builtin_amdgcn_mfma_f32_16x16x32_bf16(Bt[n][k], At[m][k], acc[ai][bj][m][n], 0, 0, 0); __builtin_amdgcn_s_setprio(0); } while (0)
#define PG8_WAIT_V(n) asm volatile("s_waitcnt vmcnt(" #n ")" ::: "memory")
#define PG8_WAIT_L(n) asm volatile("s_waitcnt lgkmcnt(" #n ")" ::: "memory")
#define PG8_BAR __builtin_amdgcn_s_barrier()
#define PG8_SCHED __builtin_amdgcn_sched_barrier(0)
    Unit cur, nxt; int ui = 0;
    if (!S.next(0, cur)) return;
    f32x4 acc[2][2][4][2];
#pragma unroll
    for (int a = 0; a < 2; ++a)
#pragma unroll
        for (int b = 0; b < 2; ++b)
#pragma unroll
            for (int m = 0; m < 4; ++m)
#pragma unroll
                for (int n = 0; n < 2; ++n) acc[a][b][m][n] = (f32x4){0.f, 0.f, 0.f, 0.f};
    bf16x8 At[4][2], B0[2][2], B1[2][2];
    const char* cA = PG8_ABASE(cur.pm) + PG8_ASLICE(cur.pn); const char* cB = PG8_BBASE(cur.pn);
    S.a_ready(cur);
    static_assert(SP2, "only the SP2 loop is kept");
    PG8_STAGE(PG8_SB(0, 0), cB, voffB); PG8_STAGE(PG8_SB(0, 1), cB + hstepB, voffB); PG8_STAGE(PG8_SA(0, 0), cA, voffA); PG8_STAGE(PG8_SA(0, 1), cA + hstepA, voffA);
    if (wr == 1) PG8_BAR;
    PG8_WAIT_V(2); PG8_BAR;
    PG8_STAGE(PG8_SB(1, 0), cB + kstep, voffB); PG8_STAGE(PG8_SA(1, 0), cA + kstepA, voffA); PG8_STAGE(PG8_SB(1, 1), cB + hstepB + kstep, voffB);
    PG8_WAIT_V(6); PG8_BAR;
    for (;;) {
        const bool has_next = S.next(ui + 1, nxt);
        const char* nA = has_next ? PG8_ABASE(nxt.pm) + PG8_ASLICE(nxt.pn) : cA; const char* nB = has_next ? PG8_BBASE(nxt.pn) : cB;
        for (int t = 0; t < nt; t += 2) {
            const bool last = (t == nt - 2);
            const char* a1 = cA + PG8_KOFF(t + 1);
            const char* a2 = last ? nA : cA + PG8_KOFF(t + 2); const char* b2 = last ? nB : cB + (size_t)(t + 2) * kstep;
            const char* a3 = a2 + kstepA; const char* b3 = b2 + kstep;
            if (last && has_next) S.a_ready(nxt);
            PG8_LDB(B0, 0, 0); PG8_LDB(B1, 0, 1); PG8_SCHED; PG8_LDA(At, 0, 0); PG8_STAGE(PG8_SA(1, 1), a1 + hstepA, voffA);
            PG8_WAIT_V(8); PG8_WAIT_L(0); PG8_BAR; PG8_MMA(0, 0, At, B0); PG8_MMA(0, 1, At, B1); PG8_BAR; PG8_SCHED;
            PG8_LDA(At, 0, 1); PG8_STAGE(PG8_SB(0, 0), b2, voffB); PG8_STAGE(PG8_SB(0, 1), b2 + hstepB, voffB); PG8_STAGE(PG8_SA(0, 0), a2, voffA);
            PG8_WAIT_V(8); PG8_WAIT_L(0); PG8_BAR; PG8_MMA(1, 0, At, B0); PG8_MMA(1, 1, At, B1); PG8_BAR; PG8_SCHED;
            PG8_LDB(B0, 1, 0); PG8_LDB(B1, 1, 1); PG8_SCHED; PG8_LDA(At, 1, 0); PG8_STAGE(PG8_SA(0, 1), a2 + hstepA, voffA);
            PG8_WAIT_V(8); PG8_WAIT_L(0); PG8_BAR; PG8_MMA(0, 0, At, B0); PG8_MMA(0, 1, At, B1); PG8_BAR; PG8_SCHED;
            PG8_LDA(At, 1, 1); PG8_STAGE(PG8_SB(1, 0), b3, voffB); PG8_STAGE(PG8_SB(1, 1), b3 + hstepB, voffB); PG8_STAGE(PG8_SA(1, 0), a3, voffA);
            PG8_WAIT_V(8); PG8_WAIT_L(0); PG8_BAR; PG8_MMA(1, 0, At, B0); PG8_MMA(1, 1, At, B1); PG8_BAR; PG8_SCHED;
        }
        if constexpr (ALIGN_EPI) { if (wr == 0) PG8_BAR; }
        E(acc, cur, wr, wc, fr, fq); S.done(cur);
        if (!has_next) break;
#pragma unroll
        for (int a = 0; a < 2; ++a)
#pragma unroll
            for (int b = 0; b < 2; ++b)
#pragma unroll
                for (int m = 0; m < 4; ++m)
#pragma unroll
                    for (int n = 0; n < 2; ++n) acc[a][b][m][n] = (f32x4){0.f, 0.f, 0.f, 0.f};
        cur = nxt; cA = nA; cB = nB; ++ui;
        if constexpr (ALIGN_EPI) { if (wr == 1) PG8_BAR; }
    }
    PG8_WAIT_V(0);
    if constexpr (!ALIGN_EPI) { if (wr == 0) PG8_BAR; }
    PG8_BAR;
#undef PG8_BBASE
#undef PG8_ASLICE
#undef PG8_ABASE
#undef PG8_KOFF
#undef PG8_SA
#undef PG8_SB
#undef PG8_STAGE
#undef PG8_LDA
#undef PG8_LDB
#undef PG8_MMA
#undef PG8_WAIT_V
#undef PG8_WAIT_L
#undef PG8_BAR
#undef PG8_SCHED
}
}

#define XB_TMO      128
#define XB_XCNT(j)  (256  + 64 * (j))
#define XB_XSUB(j)  (1280 + 64 * (j))
#define XB_XGEN(j)  (2304 + 64 * (j))
#define XB_TOP      3328
#define XB_TOPGEN   3392
#define XCD_BAR_WORDS 3456
#define XB_SPIN_CAP (1u << 24)

__device__ __forceinline__ unsigned xb_ld(unsigned* p)              { return __hip_atomic_load(p, __ATOMIC_RELAXED, __HIP_MEMORY_SCOPE_AGENT); }
__device__ __forceinline__ unsigned xb_add(unsigned* p, unsigned v) { return __hip_atomic_fetch_add(p, v, __ATOMIC_RELAXED, __HIP_MEMORY_SCOPE_AGENT); }
__device__ __forceinline__ unsigned xb_xcc_id() { return (unsigned)__builtin_amdgcn_s_getreg((3 << 11) | 20) & 0xFu; }
#define XB_SPIN(cond, bar) do { unsigned _sp = 0; while (cond) { __builtin_amdgcn_s_sleep(1); \
    if ((++_sp & 255u) == 0u) { if (xb_ld(&(bar)[XB_TMO])) break; if (_sp > XB_SPIN_CAP) { atomicAdd(&(bar)[XB_TMO], 1u); break; } } } } while (0)

struct XcdBarrier { unsigned* bar; unsigned x; volatile LAS unsigned* st; };

__device__ __forceinline__ XcdBarrier xcd_barrier_post(unsigned* bar, volatile LAS unsigned* st) {
    XcdBarrier b; b.bar = bar; b.x = xb_xcc_id(); b.st = st;
    if (threadIdx.x == 0) (void)xb_add(&bar[XB_XCNT(b.x)], 1u);
    return b;
}
__device__ __forceinline__ void xcd_barrier_complete(unsigned* bar, unsigned x, unsigned& nloc, unsigned& nx) {
    const unsigned G = gridDim.x * gridDim.y * gridDim.z;
    unsigned sum, cnt, mine, sp = 0u;
    for (;;) {
        sum = 0u; cnt = 0u; mine = 0u;
#pragma unroll
        for (unsigned j = 0; j < 16; ++j) { const unsigned c = xb_ld(&bar[XB_XCNT(j)]); sum += c; cnt += (c > 0u) ? 1u : 0u; mine = (j == x) ? c : mine; }
        if (sum == G) break;
        __builtin_amdgcn_s_sleep(1);
        if ((++sp & 255u) == 0u) { if (xb_ld(&bar[XB_TMO])) break; if (sp > XB_SPIN_CAP) { atomicAdd(&bar[XB_TMO], 1u); break; } }
    }
    nloc = mine > 0u ? mine : 1u; nx = cnt > 0u ? cnt : 1u;
}
__device__ __forceinline__ void xcd_barrier(const XcdBarrier& b) {
    asm volatile("s_waitcnt vmcnt(0)" ::: "memory");
    __syncthreads();
    if (threadIdx.x == 0) {
        unsigned* bar = b.bar;
        __builtin_amdgcn_s_waitcnt(0);
        unsigned nloc = b.st[0], nx = b.st[1];
        if (nloc == 0u) { xcd_barrier_complete(bar, b.x, nloc, nx); b.st[0] = nloc; b.st[1] = nx; }
        const unsigned old = xb_add(&bar[XB_XSUB(b.x)], 1u);
        const unsigned gen = old / nloc;
        if (old + 1u == (gen + 1u) * nloc) {
            __builtin_amdgcn_fence(__ATOMIC_RELEASE, "agent");
            asm volatile("s_waitcnt vmcnt(0)" ::: "memory");
            const unsigned og = xb_add(&bar[XB_TOP], 1u);
            const unsigned tg = og / nx;
            if (og + 1u == (tg + 1u) * nx) xb_add(&bar[XB_TOPGEN], 1u);
            else XB_SPIN(xb_ld(&bar[XB_TOPGEN]) == tg, bar);
            __builtin_amdgcn_fence(__ATOMIC_ACQUIRE, "agent");
            xb_add(&bar[XB_XGEN(b.x)], 1u);
            asm volatile("s_waitcnt vmcnt(0)" ::: "memory");
        } else {
            XB_SPIN(xb_ld(&bar[XB_XGEN(b.x)]) == gen, bar);
            __builtin_amdgcn_fence(__ATOMIC_ACQUIRE, "agent");
            asm volatile("s_waitcnt vmcnt(0)" ::: "memory");
        }
    }
    __syncthreads();
}

struct Args { const float* in[53]; float* out; unsigned char* ws; int ph_lo, ph_hi; };

enum { I_X = 0, I_L0F1 = 1, I_L0_MIX_PRE = 6, I_L0_MIX_POST = 7, I_W_IN = 8, I_PE_K = 9, I_W1_K = 10, I_W2_K = 11, I_PE_V = 12, I_W1_V = 13, I_W2_V = 14,
       I_CONV_W = 15, I_CONV_B = 16, I_W_OUT = 17, I_L0F2 = 18, I_L1F1 = 23, I_L1_MIX_PRE = 28, I_L1_MIX_POST = 29, I_MU = 30, I_W_R = 31, I_W_K = 32, I_W_V = 33, I_W_O = 34,
       I_W0 = 35, I_DEC1 = 36, I_DEC2 = 37, I_A0 = 38, I_A1 = 39, I_A2 = 40, I_G1 = 41, I_G2 = 42, I_K_K = 43, I_K_A = 44, I_R_K = 45, I_LNX_G = 46, I_LNX_B = 47, I_L1F2 = 48 };

template <class RM, class SC> __device__ __forceinline__ void convert_t(bf16* dst, int dstK, int koff, const float* src, int Ksrc, int ncol, RM rowmap, SC scale, int gtid, int gsize, LAS unsigned char* lds, int rot = 0) {
    const int lane = gtid & 63, nwv = gsize >> 6, gwv = ((gtid >> 6) + nwv - rot % nwv) % nwv;
    LAS float* scr = (LAS float*)(lds + ((gtid >> 6) & 7) * 8704);
    const int nblk = (ncol + 31) >> 5, nitems = (Ksrc >> 6) * nblk;
    for (int it = gwv; it < nitems; it += nwv) {
        const int kb = it / nblk, nb = it - kb * nblk, k0 = kb * 64, n0 = nb * 32;
        const int nn = n0 + (lane & 31); const bool nok = nn < ncol;
        float v[32];
        const float* sp = src + (size_t)(k0 + (lane >> 5)) * ncol + (nok ? nn : 0);
#pragma unroll
        for (int i = 0; i < 32; ++i) v[i] = sp[(size_t)(2 * i) * ncol];
#pragma unroll
        for (int i = 0; i < 32; ++i) { const int kk = 2 * i + (lane >> 5); scr[kk * 33 + (lane & 31)] = nok ? v[i] * scale(k0 + kk) : 0.f; }
        const int cch = lane & 7;
#pragma unroll
        for (int j = 0; j < 4; ++j) { const int n = (lane >> 3) + 8 * j; const LAS float* s = scr + (8 * cch) * 33 + n;
            u32x4 o; o.x = cvt_pk_bf16(s[0 * 33], s[1 * 33]); o.y = cvt_pk_bf16(s[2 * 33], s[3 * 33]); o.z = cvt_pk_bf16(s[4 * 33], s[5 * 33]); o.w = cvt_pk_bf16(s[6 * 33], s[7 * 33]);
            if (n0 + n < ncol) *(u32x4*)(dst + (size_t)rowmap(n0 + n) * dstK + koff + k0 + 8 * cch) = o; }
    }
}
__device__ __forceinline__ void zero_rows(bf16* dst, size_t nelem, int gtid, int gsize) {
    for (size_t i = (size_t)gtid * 8; i < nelem; i += (size_t)gsize * 8) *(u32x4*)(dst + i) = (u32x4){0u, 0u, 0u, 0u};
}
__device__ __forceinline__ void convert_ffn(const Args& a, int base, int gtid, int gsize, LAS unsigned char* lds) {
    const float* wg = a.in[base + 2]; const float* wu = a.in[base + 3]; const float* wd = a.in[base + 4];
    unsigned char* W = a.ws + WS_W;
    auto one = [](int) { return 1.0f; };
    convert_t((bf16*)(W + W_GU), D, 0, wg, D, FF, [](int n) { return (n >> 7) * 256 + (n & 127); }, one, gtid, gsize, lds, 0);
    convert_t((bf16*)(W + W_GU), D, 0, wu, D, FF, [](int n) { return (n >> 7) * 256 + 128 + (n & 127); }, one, gtid, gsize, lds, 1408);
    convert_t((bf16*)(W + W_DN), FF, 0, wd, FF, D, [](int n) { return n; }, one, gtid, gsize, lds, 2816);
}
__device__ __forceinline__ void convert_mix0(const Args& a, int gtid, int gsize, LAS unsigned char* lds) {
    const float* win = a.in[I_W_IN]; const float* wout = a.in[I_W_OUT];
    unsigned char* W = a.ws + WS_W;
    auto one = [](int) { return 1.0f; };
    convert_t((bf16*)(W + W_IN), D, 0, win, D, 2840, [](int n) { return n < 512 ? n : (n < 536 ? n - 512 + 2816 : n - 24); }, one, gtid, gsize, lds);
    zero_rows((bf16*)(W + W_IN) + (size_t)2840 * D, (size_t)(PROJ_LD - 2840) * D, gtid, gsize);
    convert_t((bf16*)(W + W_OUT), D, 0, wout, D, D, [](int n) { return n; }, one, gtid, gsize, lds);
    convert_t((bf16*)(W + W_CMP), 2048, 0, a.in[I_W1_K], 2048, 128, [](int n) { return n; }, one, gtid, gsize, lds);
    convert_t((bf16*)(W + W_CMP), 2048, 0, a.in[I_W1_V], 2048, 128, [](int n) { return n + 128; }, one, gtid, gsize, lds);
    { const int gw_ = gtid >> 6, ln = gtid & 63; if (gw_ < 256) { const int kv = gw_ >> 7, n = gw_ & 127; const float* pe = a.in[kv ? I_PE_V : I_PE_K]; const float* w1 = a.in[kv ? I_W1_V : I_W1_K];
        float s = 0.f; for (int kk = ln; kk < 2048; kk += 64) s += pe[kk] * w1[(size_t)kk * 128 + n]; s = wave_sum(s); if (ln == 0) ((float*)(a.ws + WS_PEB))[gw_] = s; } }
}
__device__ __forceinline__ void convert_mix1(const Args& a, int gtid, int gsize, LAS unsigned char* lds) {
    const float* mu = a.in[I_MU];
    unsigned char* W = a.ws + WS_W;
    bf16* Wlo = (bf16*)(W + W_LORA); bf16* Wl2 = (bf16*)(W + W_L2);
    auto one = [](int) { return 1.0f; };
    convert_t((bf16*)(W + W_R), D, 0, a.in[I_W_R], D, D, [](int n) { return n; }, one, gtid, gsize, lds, 0);
    convert_t((bf16*)(W + W_K), D, 0, a.in[I_W_K], D, D, [](int n) { return n; }, one, gtid, gsize, lds, 512);
    convert_t((bf16*)(W + W_V), D, 0, a.in[I_W_V], D, D, [](int n) { return n; }, one, gtid, gsize, lds, 1024);
#define CONV_LORA(srcp, ncol, rowoff, mi) \
    convert_t(Wlo, 2 * D, 0, srcp, D, ncol, [](int n) { return n + (rowoff); }, [=](int k) { return 1.0f - mu[(mi) * 1024 + k]; }, gtid, gsize, lds, 1536); \
    convert_t(Wlo, 2 * D, D, srcp, D, ncol, [](int n) { return n + (rowoff); }, [=](int k) { return mu[(mi) * 1024 + k]; }, gtid, gsize, lds, 1700);
    CONV_LORA(a.in[I_DEC1], 64, 0, 1)
    CONV_LORA(a.in[I_A1], 64, 64, 4)
    CONV_LORA(a.in[I_G1], 128, 128, 5)
#undef CONV_LORA
    zero_rows(Wl2, (size_t)EAG_LD * 256, gtid, gsize);
    convert_t((bf16*)(W + W_O), D, 0, a.in[I_W_O], D, D, [](int n) { return n; }, one, gtid, gsize, lds);
}
__device__ __forceinline__ void convert_mix1_l2(const Args& a, int gtid, int gsize, LAS unsigned char* lds) {
    unsigned char* W = a.ws + WS_W; bf16* Wl2 = (bf16*)(W + W_L2);
    auto one = [](int) { return 1.0f; };
    convert_t(Wl2, 256, 0, a.in[I_DEC2], 64, 1024, [](int n) { return n; }, one, gtid, gsize, lds);
    convert_t(Wl2, 256, 64, a.in[I_A2], 64, 1024, [](int n) { return n + 1024; }, one, gtid, gsize, lds);
    convert_t(Wl2, 256, 128, a.in[I_G2], 128, 1024, [](int n) { return n + 2048; }, one, gtid, gsize, lds);
}

template <bool HAS_A, bool TWO, bool WRITE_X, bool HAS_XN>
__device__ __forceinline__ void row_pass(const float* xin, float* xout, const bf16* da, const float* ga, float ca, const bf16* db, const float* gb, float cb, const float* gpre, bf16* xn, int gw, int nw, int lane) {
    f32x4 gA[4], gB[4], gP[4];
#pragma unroll
    for (int j = 0; j < 4; ++j) { if constexpr (HAS_A) gA[j] = *(const f32x4*)(ga + lane * 4 + 256 * j); if constexpr (TWO) gB[j] = *(const f32x4*)(gb + lane * 4 + 256 * j);
        if constexpr (HAS_XN) gP[j] = *(const f32x4*)(gpre + lane * 4 + 256 * j); }
    for (int row = gw; row < M; row += nw) {
        f32x4 x[4];
#pragma unroll
        for (int j = 0; j < 4; ++j) x[j] = *(const f32x4*)(xin + (size_t)row * D + lane * 4 + 256 * j);
        if constexpr (HAS_A) {
            f32x4 d[4]; float ss = 0.f;
#pragma unroll
            for (int j = 0; j < 4; ++j) { const u32x2 w = *(const u32x2*)(da + (size_t)row * D + lane * 4 + 256 * j); d[j] = (f32x4){bflo(w.x), bfhi(w.x), bflo(w.y), bfhi(w.y)};
                ss += (d[j].x * d[j].x + d[j].y * d[j].y) + (d[j].z * d[j].z + d[j].w * d[j].w); }
            const float rstd = ca * rsqrtf(wave_sum(ss) * (1.0f / D) + EPS);
#pragma unroll
            for (int j = 0; j < 4; ++j) x[j] = x[j] + d[j] * gA[j] * rstd;
        }
        if constexpr (TWO) {
            f32x4 d[4]; float ss = 0.f;
#pragma unroll
            for (int j = 0; j < 4; ++j) { const u32x2 w = *(const u32x2*)(db + (size_t)row * D + lane * 4 + 256 * j); d[j] = (f32x4){bflo(w.x), bfhi(w.x), bflo(w.y), bfhi(w.y)};
                ss += (d[j].x * d[j].x + d[j].y * d[j].y) + (d[j].z * d[j].z + d[j].w * d[j].w); }
            const float rstd = cb * rsqrtf(wave_sum(ss) * (1.0f / D) + EPS);
#pragma unroll
            for (int j = 0; j < 4; ++j) x[j] = x[j] + d[j] * gB[j] * rstd;
        }
        if constexpr (WRITE_X) {
#pragma unroll
            for (int j = 0; j < 4; ++j) *(f32x4*)(xout + (size_t)row * D + lane * 4 + 256 * j) = x[j];
        }
        if constexpr (HAS_XN) {
            float ss = 0.f;
#pragma unroll
            for (int j = 0; j < 4; ++j) ss += (x[j].x * x[j].x + x[j].y * x[j].y) + (x[j].z * x[j].z + x[j].w * x[j].w);
            const float rstd = rsqrtf(wave_sum(ss) * (1.0f / D) + EPS);
            const size_t prow = (size_t)row + (row >= SEQ ? 2 : 1);
#pragma unroll
            for (int j = 0; j < 4; ++j) { const f32x4 y = x[j] * gP[j] * rstd;
                u32x2 w; w.x = cvt_pk_bf16(y.x, y.y); w.y = cvt_pk_bf16(y.z, y.w); *(u32x2*)(xn + prow * D + lane * 4 + 256 * j) = w; }
        }
    }
    if constexpr (HAS_XN) { if (blockIdx.x == 0) { const int t = threadIdx.x; if (t < 256) { u32x4 z = (u32x4){0u, 0u, 0u, 0u}; const size_t prow = (t < 128) ? 0 : (size_t)SEQ + 1; *(u32x4*)(xn + prow * D + (t & 127) * 8) = z; } } }
}

__device__ __forceinline__ void rwkv_mix_phase(const Args& a, int gtid, int gsize) {
    const bf16* xn = (const bf16*)(a.ws + WS_XN); const float* mu = a.in[I_MU];
    bf16* xr = (bf16*)(a.ws + WS_XR); bf16* xk = (bf16*)(a.ws + WS_XK); bf16* xv = (bf16*)(a.ws + WS_XV);
    const int c8 = gtid & 127, tl = gtid >> 7, nl = gsize >> 7, run = (M + nl - 1) / nl;
    float mr[8], mk[8], mv[8];
    { const float* m = mu + c8 * 8;
#pragma unroll
      for (int j = 0; j < 8; ++j) { mr[j] = m[j]; mk[j] = m[2 * 1024 + j]; mv[j] = m[3 * 1024 + j]; } }
    const int t_beg = tl * run, t_end = (t_beg + run < M) ? t_beg + run : M;
    u32x4 pw = (u32x4){0u, 0u, 0u, 0u};
    if (t_beg < t_end) { const size_t prow0 = (size_t)t_beg + (t_beg >= SEQ ? 2 : 1); pw = *(const u32x4*)(xn + (prow0 - 1) * D + c8 * 8); }
    for (int tok = t_beg; tok < t_end; ++tok) {
        const size_t prow = (size_t)tok + (tok >= SEQ ? 2 : 1);
        if ((tok & (SEQ - 1)) == 0) pw = (u32x4){0u, 0u, 0u, 0u};
        const u32x4 hw = *(const u32x4*)(xn + prow * D + c8 * 8);
        const float h[8] = {bflo(hw.x), bfhi(hw.x), bflo(hw.y), bfhi(hw.y), bflo(hw.z), bfhi(hw.z), bflo(hw.w), bfhi(hw.w)};
        const float p[8] = {bflo(pw.x), bfhi(pw.x), bflo(pw.y), bfhi(pw.y), bflo(pw.z), bfhi(pw.z), bflo(pw.w), bfhi(pw.w)};
#define MIX_ONE(mm, dstp) do { float o[8]; \
            _Pragma("unroll") for (int j = 0; j < 8; ++j) o[j] = h[j] + (p[j] - h[j]) * mm[j]; \
            u32x4 w; w.x = cvt_pk_bf16(o[0], o[1]); w.y = cvt_pk_bf16(o[2], o[3]); w.z = cvt_pk_bf16(o[4], o[5]); w.w = cvt_pk_bf16(o[6], o[7]); \
            *(u32x4*)((dstp) + (size_t)tok * D + c8 * 8) = w; } while (0)
        MIX_ONE(mr, xr); MIX_ONE(mk, xk); MIX_ONE(mv, xv);
#undef MIX_ONE
        pw = hw;
    }
}

constexpr int CMP_SPLIT = 8;
__device__ __forceinline__ void compress_stage2(const Args& a, int gw, int nw, int lane) {
    const float* part = (const float*)(a.ws + WS_XN); const float* peb = (const float*)(a.ws + WS_PEB);
    for (int m = gw; m < 8192; m += nw) {
        const int kv = m >> 12, mm = m & 4095, g = mm & 1, i = (mm >> 1) & 1023, b = mm >> 11;
        if (i >= NCMP) continue;
        float h0 = peb[kv * 128 + lane], h1 = peb[kv * 128 + 64 + lane];
#pragma unroll
        for (int s = 0; s < CMP_SPLIT; ++s) { const float* p = part + ((size_t)s * 8192 + m) * 128; h0 += p[lane]; h1 += p[64 + lane]; }
        { const float u0 = 0.7978845608028654f * (h0 + 0.044715f * h0 * h0 * h0), u1 = 0.7978845608028654f * (h1 + 0.044715f * h1 * h1 * h1);
          h0 = 0.5f * h0 * (2.0f - 2.0f * __builtin_amdgcn_rcpf(__expf(2.0f * u0) + 1.0f)); h1 = 0.5f * h1 * (2.0f - 2.0f * __builtin_amdgcn_rcpf(__expf(2.0f * u1) + 1.0f)); }
        const float* w2 = a.in[kv ? I_W2_V : I_W2_K];
        float o0 = 0.f, o1 = 0.f;
#pragma unroll
        for (int n = 0; n < 64; ++n) { o0 = fmaf(__int_as_float(__builtin_amdgcn_readlane(__float_as_int(h0), n)), w2[n * 64 + lane], o0); o1 = fmaf(__int_as_float(__builtin_amdgcn_readlane(__float_as_int(h1), n)), w2[(64 + n) * 64 + lane], o1); }
        bf16* dst = (bf16*)(a.ws + (kv ? WS_VC : WS_KC)); dst[((size_t)(b * NCMP + i) * 2 + g) * 64 + lane] = f2bf(o0 + o1);
    }
}

typedef float f32x16 __attribute__((ext_vector_type(16)));
typedef short s16x4 __attribute__((ext_vector_type(4)));
constexpr int NK_KS = 144, NK_VS = 144;
constexpr int NL_K = 0, NL_V = 2 * 128 * NK_KS, NL_IMP = NL_V + 2 * 128 * NK_VS, NL_SELM = NL_IMP + 64 * 264 * 4, NL_UN = NL_SELM + 64 * 8 * 4, NL_ULIST = NL_UN + 72 * 4, NL_END = NL_ULIST + 260 * 4;
static_assert(NL_END <= LDS_CTL_OFF, "NSA LDS map");
constexpr float LOG2E = 1.4426950408889634f;

struct SmState { float m, l; f32x16 o0, o1; };
struct TileSrc { const bf16* k; const bf16* v; int stride; int nvalid; };

__device__ __forceinline__ void tile_load(const TileSrc& s, int tid, u32x4& kr, u32x4& vr) {
    const int row = tid >> 3, chk = tid & 7;
    if (row < s.nvalid) { kr = *(const u32x4*)(s.k + (size_t)row * s.stride + chk * 8); if (s.v) vr = *(const u32x4*)(s.v + (size_t)row * s.stride + chk * 8); }
    else { kr = (u32x4){0u, 0u, 0u, 0u}; vr = (u32x4){0u, 0u, 0u, 0u}; }
}
__device__ __forceinline__ void tile_store(LAS unsigned char* kb, LAS unsigned char* vb, int tid, const u32x4& kr, const u32x4& vr) {
    const int row = tid >> 3, chk = tid & 7;
    *(LAS u32x4*)(kb + row * NK_KS + chk * 16) = kr; *(LAS u32x4*)(vb + row * NK_VS + chk * 16) = vr;
    if (chk == 0) *(LAS u32x4*)(kb + row * NK_KS + 128) = (u32x4){cvt_pk_bf16((float)row, 0.f), 0u, 0u, 0u};
}
__device__ __forceinline__ void qk64(const LAS unsigned char* kb, int lane, const bf16x8 (&qf)[4], unsigned qx0, int lo, int hi, bool allvalid, f32x16& a0, f32x16& a1) {
#pragma unroll
    for (int e = 0; e < 16; ++e) { a0[e] = 0.f; a1[e] = 0.f; }
    const int c32 = lane & 31, h = lane >> 5;
    const LAS unsigned char* kp = kb + c32 * NK_KS + h * 16;
    __builtin_amdgcn_s_setprio(1);
#pragma unroll
    for (int ks = 0; ks < 4; ++ks) { const bf16x8 k0 = *(const LAS bf16x8*)(kp + ks * 32), k1 = *(const LAS bf16x8*)(kp + 32 * NK_KS + ks * 32);
        a0 = __builtin_amdgcn_mfma_f32_32x32x16_bf16(k0, qf[ks], a0, 0, 0, 0); a1 = __builtin_amdgcn_mfma_f32_32x32x16_bf16(k1, qf[ks], a1, 0, 0, 0); }
    { const bf16x8 k0 = *(const LAS bf16x8*)(kb + c32 * NK_KS + 128), k1 = *(const LAS bf16x8*)(kb + (32 + c32) * NK_KS + 128);
      union { u32x4 u; bf16x8 b; } qx; qx.u = (u32x4){(lane < 32) ? qx0 : 0u, 0u, 0u, 0u};
      a0 = __builtin_amdgcn_mfma_f32_32x32x16_bf16(k0, qx.b, a0, 0, 0, 0); a1 = __builtin_amdgcn_mfma_f32_32x32x16_bf16(k1, qx.b, a1, 0, 0, 0); }
    __builtin_amdgcn_s_setprio(0);
    if (!allvalid) {
        if (hi < lo) { lo = 1000; hi = 1000; }
        const unsigned span = (unsigned)(hi - lo); const int l0 = lo - 4 * h, l1 = lo - 4 * h - 32;
#pragma unroll
        for (int e = 0; e < 16; ++e) { const int ce = (e & 3) + 8 * (e >> 2);
            a0[e] = ((unsigned)(ce - l0) <= span) ? a0[e] : -INFINITY; a1[e] = ((unsigned)(ce - l1) <= span) ? a1[e] : -INFINITY; }
    }
}
__device__ __forceinline__ void tile64(const LAS unsigned char* kb, const LAS unsigned char* vb, int lane, const bf16x8 (&qf)[4], unsigned qx0, int lo, int hi, bool allvalid, float C1, float tc2, SmState& st) {
    f32x16 a0, a1;
    qk64(kb, lane, qf, qx0, lo, hi, allvalid, a0, a1);
    float tmax = fmaxf(a0[0], a1[0]);
#pragma unroll
    for (int e = 1; e < 16; ++e) tmax = fmaxf(tmax, fmaxf(a0[e], a1[e]));
    tmax = xor32_max(fmaf(tmax, C1, tc2));
    const float mn = fmaxf(st.m, tmax);
    if (!__all(mn == st.m)) { const float al = __builtin_amdgcn_exp2f(st.m - mn); st.l *= al; st.m = mn;
#pragma unroll
        for (int e = 0; e < 16; ++e) { st.o0[e] *= al; st.o1[e] *= al; } }
    float ps = 0.f; const float off = tc2 - st.m;
#pragma unroll
    for (int e = 0; e < 16; ++e) { a0[e] = __builtin_amdgcn_exp2f(fmaf(a0[e], C1, off)); a1[e] = __builtin_amdgcn_exp2f(fmaf(a1[e], C1, off)); ps += a0[e] + a1[e]; }
    st.l += ps;
    const int i16 = lane & 15, g4 = lane >> 4;
    const LAS unsigned char* vp = vb + (4 * (g4 >> 1) + (i16 >> 2)) * NK_VS + (16 * (g4 & 1) + 4 * (i16 & 3)) * 2;
    __builtin_amdgcn_s_setprio(1);
#pragma unroll
    for (int hf = 0; hf < 2; ++hf)
#pragma unroll
        for (int sk = 0; sk < 2; ++sk) {
            const f32x16& pp = hf ? a1 : a0;
            bf16x8 pf; { union { u32x4 u; bf16x8 b; } cv; cv.u.x = cvt_pk_bf16(pp[8 * sk + 0], pp[8 * sk + 1]); cv.u.y = cvt_pk_bf16(pp[8 * sk + 2], pp[8 * sk + 3]); cv.u.z = cvt_pk_bf16(pp[8 * sk + 4], pp[8 * sk + 5]); cv.u.w = cvt_pk_bf16(pp[8 * sk + 6], pp[8 * sk + 7]); pf = cv.b; }
#pragma unroll
            for (int dt = 0; dt < 2; ++dt) {
                const s16x4 v0 = __builtin_amdgcn_ds_read_tr16_b64_v4i16((LAS s16x4*)(vp + (32 * hf + 16 * sk) * NK_VS + dt * 64));
                const s16x4 v1 = __builtin_amdgcn_ds_read_tr16_b64_v4i16((LAS s16x4*)(vp + (32 * hf + 16 * sk + 8) * NK_VS + dt * 64));
                const bf16x8 vf = (bf16x8){v0.x, v0.y, v0.z, v0.w, v1.x, v1.y, v1.z, v1.w};
                if (dt == 0) st.o0 = __builtin_amdgcn_mfma_f32_32x32x16_bf16(vf, pf, st.o0, 0, 0, 0);
                else st.o1 = __builtin_amdgcn_mfma_f32_32x32x16_bf16(vf, pf, st.o1, 0, 0, 0);
            }
        }
    __builtin_amdgcn_s_setprio(0);
}
__device__ __forceinline__ int imp_idx(int token, int j) { return token * 264 + (j >> 5) * 33 + (j & 31); }

#ifndef NSA_DUP
#define NSA_DUP 0
#endif
#define NSA_REP(bit) for (int rep_ = 0; rep_ < ((NSA_DUP >> (bit)) & 1) + 1; ++rep_)
__device__ __forceinline__ void nsa_mfma_phase(const Args& a, LAS unsigned char* lds) {
    const int tid0 = threadIdx.x, wave = __builtin_amdgcn_readfirstlane(tid0 >> 6);
    const bf16* proj = (const bf16*)(a.ws + WS_BIG);
    const bf16* KC = (const bf16*)(a.ws + WS_KC); const bf16* VC = (const bf16*)(a.ws + WS_VC);
    bf16* att = (bf16*)(a.ws + WS_ATT);
    LAS float* IMP = (LAS float*)(lds + NL_IMP); LAS unsigned* SELM = (LAS unsigned*)(lds + NL_SELM); LAS unsigned* UN = (LAS unsigned*)(lds + NL_UN); LAS int* ULIST = (LAS int*)(lds + NL_ULIST);
    const int G = gridDim.x;
    for (int ui = 0; ; ++ui) {
        const int u = ui * G + blockIdx.x; if (u >= NB * 2 * (SEQ / 64)) break;
        int tid = tid0; asm volatile("" : "+v"(tid));
        const int lane = tid & 63, h = lane >> 5, c32 = lane & 31, tl = c32 >> 2, r = c32 & 3;
        const int bg = u >> 8, tsw = ((u & 7) << 5) | ((u & 255) >> 3), tile = (bg & 1) ? 255 - tsw : tsw, b = bg >> 1, g = bg & 1;
        const int t0 = tile * 64, tokl = wave * 8 + tl, t = t0 + tokl;
        const size_t tok = (size_t)b * SEQ + t;
        const float slope = exp2f(-(float)(g * 4 + r + 1)), sl2 = slope * LOG2E, C1 = 0.125f * LOG2E;
        const unsigned qx_one = cvt_pk_bf16(8.0f * slope, 0.f), qx_cmp = cvt_pk_bf16(128.0f * slope, 0.f);
        bf16x8 qf[4];
#pragma unroll
        for (int ks = 0; ks < 4; ++ks) qf[ks] = *(const bf16x8*)(proj + tok * PROJ_LD + PC_Q + (g * 4 + r) * 64 + ks * 16 + h * 8);
        f32x16 out0, out1;
#pragma unroll
        for (int e = 0; e < 16; ++e) { out0[e] = 0.f; out1[e] = 0.f; }
        SmState st;
        u32x4 kr, vr, kr2, vr2;
#define NSA_STATE_INIT() do { st.m = -1e30f; st.l = 0.f; _Pragma("unroll") for (int e = 0; e < 16; ++e) { st.o0[e] = 0.f; st.o1[e] = 0.f; } } while (0)
#define NSA_STATE_FOLD(gi) do { const float lt = xor32_sum(st.l); const float gt_ = sigmoidf_(bf2f(proj[((size_t)b * SEQ + t) * PROJ_LD + PC_G + (g * 4 + r) * 3 + (gi)])); const float sc_ = gt_ / fmaxf(lt, 1e-30f); _Pragma("unroll") for (int e = 0; e < 16; ++e) { out0[e] += st.o0[e] * sc_; out1[e] += st.o1[e] * sc_; } } while (0)
#define NSA_KB(i) (lds + NL_K + ((((i) >> 1) & 1) * 128 + ((i) & 1) * 64) * NK_KS)
#define NSA_VB(i) (lds + NL_V + ((((i) >> 1) & 1) * 128 + ((i) & 1) * 64) * NK_VS)
#define NSA_PIPE(N, SRC, ...) do { const int n_ = (N); \
        tile_load(SRC(0), tid, kr, vr); tile_store(NSA_KB(0), NSA_VB(0), tid, kr, vr); \
        if (1 < n_) { tile_load(SRC(1), tid, kr, vr); tile_store(NSA_KB(1), NSA_VB(1), tid, kr, vr); } \
        __syncthreads(); \
        if (2 < n_) tile_load(SRC(2), tid, kr, vr); \
        if (3 < n_) tile_load(SRC(3), tid, kr2, vr2); \
        for (int ip_ = 0; 2 * ip_ < n_; ++ip_) { \
            { const int i = 2 * ip_; __VA_ARGS__ } \
            if (2 * ip_ + 1 < n_) { const int i = 2 * ip_ + 1; __VA_ARGS__ } \
            if (2 * ip_ + 2 < n_) tile_store(NSA_KB(2 * ip_ + 2), NSA_VB(2 * ip_ + 2), tid, kr, vr); \
            if (2 * ip_ + 3 < n_) tile_store(NSA_KB(2 * ip_ + 3), NSA_VB(2 * ip_ + 3), tid, kr2, vr2); \
            __syncthreads(); \
            if (2 * ip_ + 4 < n_) tile_load(SRC(2 * ip_ + 4), tid, kr, vr); \
            if (2 * ip_ + 5 < n_) tile_load(SRC(2 * ip_ + 5), tid, kr2, vr2); \
        } } while (0)
        const int ntc = (4 * tile + 3 + 63) >> 6;
        auto cmp_src = [&](int i) { const int n0 = 64 * (ntc - 1 - i); TileSrc s; s.k = KC + ((size_t)(b * NCMP + n0) * 2 + g) * 64; s.v = VC + ((size_t)(b * NCMP + n0) * 2 + g) * 64; s.stride = 128; s.nvalid = NCMP - n0; return s; };
        float m_cmp, invl_cmp;
        NSA_REP(0) {
            NSA_STATE_INIT();
            __syncthreads();
            NSA_PIPE(ntc, cmp_src, { const int n0 = 64 * (ntc - 1 - i); const int hi = (t - 31 - 16 * n0) >> 4; const bool allv = __all(hi >= 63);
                tile64(NSA_KB(i), NSA_VB(i), lane, qf, qx_cmp, 0, hi, allv, C1, sl2 * (float)(16 * n0 + 31 - t), st); });
            const float lt = xor32_sum(st.l);
            m_cmp = st.m; invl_cmp = 1.0f / fmaxf(lt, 1e-30f);
        }
        NSA_STATE_FOLD(0);
        if (tile >= 16) {
            NSA_REP(1) {
            auto cmpk_src = [&](int i) { TileSrc s = cmp_src(i); s.v = nullptr; return s; };
            NSA_PIPE(ntc, cmpk_src, { const int n0 = 64 * (ntc - 1 - i); const int hi = (t - 31 - 16 * n0) >> 4;
                  f32x16 a0, a1; qk64(NSA_KB(i), lane, qf, qx_cmp, 0, hi, false, a0, a1);
                  const float off2 = sl2 * (float)(16 * n0 + 31 - t) - m_cmp;
                  float mv[8], hv[8];
                  _Pragma("unroll") for (int hf = 0; hf < 2; ++hf)
                    _Pragma("unroll") for (int gq = 0; gq < 4; ++gq) {
                        const f32x16& s = hf ? a1 : a0;
                        const float p0 = __builtin_amdgcn_exp2f(fmaf(s[4 * gq], C1, off2)) * invl_cmp, p1 = __builtin_amdgcn_exp2f(fmaf(s[4 * gq + 1], C1, off2)) * invl_cmp,
                                    p2 = __builtin_amdgcn_exp2f(fmaf(s[4 * gq + 2], C1, off2)) * invl_cmp, p3 = __builtin_amdgcn_exp2f(fmaf(s[4 * gq + 3], C1, off2)) * invl_cmp;
                        float mainv = ((p0 + p1) + p2) + 0.5f * p3, halfv = 0.5f * p3;
                        mainv += dpp_mov<0xB1>(mainv); mainv += dpp_mov<0x4E>(mainv); halfv += dpp_mov<0xB1>(halfv); halfv += dpp_mov<0x4E>(halfv);
                        mv[4 * hf + gq] = mainv; hv[4 * hf + gq] = halfv; }
                  _Pragma("unroll") for (int q = 0; q < 8; ++q) {
                        auto rr = __builtin_amdgcn_permlane32_swap(__float_as_uint(q ? hv[q - 1] : 0.f), __float_as_uint(hv[q]), false, false);
                        const float tot = mv[q] + __uint_as_float(h ? rr[0] : rr[1]);
                        const int j = (n0 >> 2) + 2 * q + h;
                        if (r == 0 && j < NSLC) IMP[imp_idx(tokl, j)] = tot; }
                  if (i > 0 && h == 1 && r == 0) { const int jn = (n0 >> 2) + 16; if (jn < NSLC) IMP[imp_idx(tokl, jn)] += hv[7]; } });
            }
            NSA_REP(2) {
                const int ttl = lane >> 3, sl = lane & 7, tk = wave * 8 + ttl;
                float cand[32];
#pragma unroll
                for (int i = 0; i < 32; ++i) { const int j = 32 * sl + i; const float v = IMP[tk * 264 + sl * 33 + i]; const bool forced = (j == 0) || (j == tile) || (j == tile - 1); cand[i] = (j <= tile && !forced) ? v : -1.0f; }
                float top[13];
#pragma unroll
                for (int q = 0; q < 13; ++q) top[q] = -1.0f;
#pragma unroll
                for (int i = 0; i < 32; ++i) { const float x = cand[i];
#pragma unroll
                    for (int q = 12; q >= 1; --q) top[q] = __builtin_amdgcn_fmed3f(top[q - 1], top[q], x);
                    top[0] = fmaxf(top[0], x); }
#define NSA_MERGE(CTRL) do { float oth[13]; _Pragma("unroll") for (int q = 0; q < 13; ++q) oth[q] = dpp_mov<CTRL>(top[q]); \
                    _Pragma("unroll") for (int i = 0; i < 13; ++i) { const float x = oth[i]; _Pragma("unroll") for (int q = 12; q >= 1; --q) top[q] = __builtin_amdgcn_fmed3f(top[q - 1], top[q], x); top[0] = fmaxf(top[0], x); } } while (0)
                NSA_MERGE(0xB1); NSA_MERGE(0x4E); NSA_MERGE(0x141);
#undef NSA_MERGE
                const float T = top[12];
                unsigned bgt = 0u, beq = 0u, bforced = 0u;
#pragma unroll
                for (int i = 0; i < 32; ++i) { const int j = 32 * sl + i; if (cand[i] > T) bgt |= 1u << i; if (cand[i] == T) beq |= 1u << i; if ((j == 0) || (j == tile) || (j == tile - 1)) bforced |= 1u << i; }
                int cgt = __popc(bgt); cgt += dpp_movi<0xB1>(cgt); cgt += dpp_movi<0x4E>(cgt); cgt += dpp_movi<0x141>(cgt);
                const int need_eq = 13 - cgt;
                int ce_inc = __popc(beq);
#pragma unroll
                for (int d = 1; d < 8; d <<= 1) { const int y = __shfl_up(ce_inc, d); if (sl >= d) ce_inc += y; }
                const int before = ce_inc - __popc(beq);
                int ntake = need_eq - before; ntake = ntake < 0 ? 0 : ntake;
                unsigned keep = 0u, mm = beq;
                for (int q = 0; q < ntake && mm; ++q) { const unsigned low = mm & (0u - mm); keep |= low; mm ^= low; }
                const unsigned mask = bgt | keep | bforced;
                SELM[tk * 8 + sl] = mask;
                unsigned um = mask; um |= __shfl_xor(um, 8); um |= __shfl_xor(um, 16); um |= __shfl_xor(um, 32);
                if (lane < 8) UN[wave * 8 + lane] = um;
            }
        } else {
            if (tid < 64 * 8) { const unsigned mask = ((tid & 7) == 0) ? ((1u << (tile + 1)) - 1u) : 0u; SELM[tid] = mask; if (tid < 64) UN[tid] = ((tid & 7) == 0) ? mask : 0u; }
        }
        __syncthreads();
        if (tid < 256) {
            unsigned um[8]; int above = 0, total = 0;
#pragma unroll
            for (int d = 0; d < 8; ++d) { unsigned x = 0u;
#pragma unroll
                for (int w = 0; w < 8; ++w) x |= UN[w * 8 + d];
                um[d] = x; total += __popc(x); }
            const int dj = tid >> 5, bj = tid & 31; unsigned mine = 0u;
#pragma unroll
            for (int d = 0; d < 8; ++d) { if (d > dj) above += __popc(um[d]); if (d == dj) mine = um[d]; }
            above += __popc(bj == 31 ? 0u : (mine >> (bj + 1)));
            if ((mine >> bj) & 1u) ULIST[1 + above] = tid;
            if (tid == 0) ULIST[0] = total;
        }
        __syncthreads();
        {
            const int nu = __builtin_amdgcn_readfirstlane(ULIST[0]);
            auto slc_src = [&](int i) { const int j = ULIST[1 + i]; TileSrc s; s.k = proj + ((size_t)b * SEQ + 64 * j) * PROJ_LD + PC_KS + g * 64; s.v = proj + ((size_t)b * SEQ + 64 * j) * PROJ_LD + PC_VS + g * 64; s.stride = PROJ_LD; s.nvalid = 64; return s; };
            NSA_REP(3) {
            NSA_STATE_INIT();
            NSA_PIPE(nu, slc_src, { const int j = __builtin_amdgcn_readfirstlane(ULIST[1 + i]);
                const bool sel = (SELM[tokl * 8 + (j >> 5)] >> (j & 31)) & 1u;
                if (__any(sel)) { const int hi = sel ? (t - 64 * j) : -1; const bool allv = __all(hi >= 63);
                    tile64(NSA_KB(i), NSA_VB(i), lane, qf, qx_one, 0, hi, allv, C1, sl2 * (float)(64 * j - t), st); } });
            }
            NSA_STATE_FOLD(1);
        }
        {
            const int nwt = tile + 1 < 9 ? tile + 1 : 9;
            auto win_src = [&](int i) { const int j = tile - i; TileSrc s; s.k = proj + ((size_t)b * SEQ + 64 * j) * PROJ_LD + PC_KW + g * 64; s.v = proj + ((size_t)b * SEQ + 64 * j) * PROJ_LD + PC_VW + g * 64; s.stride = PROJ_LD; s.nvalid = 64; return s; };
            NSA_REP(4) {
            NSA_STATE_INIT();
            NSA_PIPE(nwt, win_src, { const int j = tile - i; const int hi = t - 64 * j, lo = t - 511 - 64 * j; const bool allv = __all(hi >= 63 && lo <= 0);
                tile64(NSA_KB(i), NSA_VB(i), lane, qf, qx_one, lo, hi, allv, C1, sl2 * (float)(64 * j - t), st); });
            }
            NSA_STATE_FOLD(2);
        }
#pragma unroll
        for (int dt = 0; dt < 2; ++dt)
#pragma unroll
            for (int gq = 0; gq < 4; ++gq) {
                const f32x16& o = dt ? out1 : out0;
                u32x2 w; w.x = cvt_pk_bf16(o[4 * gq], o[4 * gq + 1]); w.y = cvt_pk_bf16(o[4 * gq + 2], o[4 * gq + 3]);
                *(u32x2*)(att + tok * D + (g * 4 + r) * 64 + 32 * dt + 8 * gq + 4 * h) = w;
            }
#undef NSA_STATE_INIT
#undef NSA_STATE_FOLD
#undef NSA_KB
#undef NSA_VB
#undef NSA_PIPE
    }
    NSA_REP(5) {
        const float* cw = a.in[I_CONV_W]; const float* cbias = a.in[I_CONV_B];
        const int gt = blockIdx.x * 512 + tid0, gs = gridDim.x * 512;
        const int c0 = (gt & 63) * 8, tl = gt >> 6;
        constexpr int run = M / (256 * 8);
        if (gs == 256 * 512) {
        const f32x4 w0a = *(const f32x4*)(cw + c0), w0b = *(const f32x4*)(cw + c0 + 4), w1a = *(const f32x4*)(cw + 512 + c0), w1b = *(const f32x4*)(cw + 512 + c0 + 4),
                    w2a = *(const f32x4*)(cw + 1024 + c0), w2b = *(const f32x4*)(cw + 1024 + c0 + 4), bsa = *(const f32x4*)(cbias + c0), bsb = *(const f32x4*)(cbias + c0 + 4);
        const int t_beg = tl * run;
        const f32x4 zero4 = (f32x4){0.f, 0.f, 0.f, 0.f};
        f32x4 z0a = zero4, z0b = zero4, z1a = zero4, z1b = zero4;
#define CONV_U(S_, A, B) do { const u32x4 s_ = (S_); A = (f32x4){bflo(s_.x), bfhi(s_.x), bflo(s_.y), bfhi(s_.y)}; B = (f32x4){bflo(s_.z), bfhi(s_.z), bflo(s_.w), bfhi(s_.w)}; } while (0)
#define CONV_Z(A, B, tokn_) do { const bf16* p_ = proj + (size_t)(tokn_) * PROJ_LD; const u32x4 cc = *(const u32x4*)(p_ + PC_CC + c0), cu = *(const u32x4*)(p_ + PC_CU + c0); \
            f32x4 ca_, cb_, ua_, ub_; CONV_U(cc, ca_, cb_); CONV_U(cu, ua_, ub_); A = ca_ * ua_; B = cb_ * ub_; } while (0)
        if (t_beg < M) { const int tt = t_beg & (SEQ - 1); if (tt >= 2) CONV_Z(z0a, z0b, t_beg - 2); if (tt >= 1) CONV_Z(z1a, z1b, t_beg - 1); }
        for (int k = 0; k < run; ++k) {
            const int tokn = t_beg + k; if (tokn >= M) continue;
            if ((tokn & (SEQ - 1)) == 0) { z0a = zero4; z0b = zero4; z1a = zero4; z1b = zero4; }
            f32x4 z2a, z2b; CONV_Z(z2a, z2b, tokn);
            const u32x4 cbv = *(const u32x4*)(proj + (size_t)tokn * PROJ_LD + PC_CB + c0);
            f32x4 ga_, gb_; CONV_U(cbv, ga_, gb_);
            const f32x4 oa = ga_ * (bsa + w2a * z2a + w1a * z1a + w0a * z0a), ob = gb_ * (bsb + w2b * z2b + w1b * z1b + w0b * z0b);
            z0a = z1a; z0b = z1b; z1a = z2a; z1b = z2b;
            u32x4 w; w.x = cvt_pk_bf16(oa.x, oa.y); w.y = cvt_pk_bf16(oa.z, oa.w); w.z = cvt_pk_bf16(ob.x, ob.y); w.w = cvt_pk_bf16(ob.z, ob.w);
            *(u32x4*)(att + (size_t)tokn * D + 512 + c0) = w;
        }
#undef CONV_Z
#undef CONV_U
        } else {
        for (int idx = gt; idx < M * 64; idx += gs) {
            const int c0 = (idx & 63) * 8; const int tokn = idx >> 6, tt = tokn & (SEQ - 1);
            const bf16* p = proj + (size_t)tokn * PROJ_LD;
            float z[3][8];
#pragma unroll
            for (int k = 0; k < 3; ++k) {
                if (tt >= 2 - k) { const u32x4 cc = *(const u32x4*)(p + PC_CC + c0 - (2 - k) * PROJ_LD), cu = *(const u32x4*)(p + PC_CU + c0 - (2 - k) * PROJ_LD);
                    z[k][0] = bflo(cc.x) * bflo(cu.x); z[k][1] = bfhi(cc.x) * bfhi(cu.x); z[k][2] = bflo(cc.y) * bflo(cu.y); z[k][3] = bfhi(cc.y) * bfhi(cu.y);
                    z[k][4] = bflo(cc.z) * bflo(cu.z); z[k][5] = bfhi(cc.z) * bfhi(cu.z); z[k][6] = bflo(cc.w) * bflo(cu.w); z[k][7] = bfhi(cc.w) * bfhi(cu.w); }
                else {
#pragma unroll
                    for (int j = 0; j < 8; ++j) z[k][j] = 0.f; }
            }
            const u32x4 cbv = *(const u32x4*)(p + PC_CB + c0);
            const float cbf[8] = {bflo(cbv.x), bfhi(cbv.x), bflo(cbv.y), bfhi(cbv.y), bflo(cbv.z), bfhi(cbv.z), bflo(cbv.w), bfhi(cbv.w)};
            float o[8];
#pragma unroll
            for (int j = 0; j < 8; ++j) { float y = cbias[c0 + j] + cw[2 * 512 + c0 + j] * z[2][j]; y += cw[512 + c0 + j] * z[1][j]; y += cw[c0 + j] * z[0][j]; o[j] = cbf[j] * y; }
            u32x4 w; w.x = cvt_pk_bf16(o[0], o[1]); w.y = cvt_pk_bf16(o[2], o[3]); w.z = cvt_pk_bf16(o[4], o[5]); w.w = cvt_pk_bf16(o[6], o[7]);
            *(u32x4*)(att + (size_t)tokn * D + 512 + c0) = w;
        }
        }
    }
}

constexpr int SC_NCH = 64, SC_L = SEQ / SC_NCH, SC_NT = NB * 16 * SC_NCH;
constexpr int SM_L = 16;
constexpr int SM_RS = 144, SM_TS = 48;
constexpr int SM_AK = 0, SM_BH = 2304, SM_KH = 4608, SM_RH = 6912, SM_VV = 9216, SM_GAB = 11520, SM_GAK = 12672, SM_HRB = 13440, SM_HRK = 14208, SM_TT = 14976,
              SM_CL = 15744, SM_SS = 16000, SM_RK = 16064, SM_WAVE = 16128, SM_T1 = 0, SM_T2 = 16 * 65 * 4;
static_assert(2 * 16 * 65 * 4 <= SM_GAB, "MFMA scan LDS overlay");
static_assert(8 * SM_WAVE <= LDS_CTL_OFF, "MFMA scan LDS");
__device__ __forceinline__ bf16x8 sm_acc_hi(const f32x16& x, int ks) {
    union { u32x4 u; bf16x8 b; } c; c.u = (u32x4){cvt_pk_bf16(x[8 * ks], x[8 * ks + 1]), cvt_pk_bf16(x[8 * ks + 2], x[8 * ks + 3]), cvt_pk_bf16(x[8 * ks + 4], x[8 * ks + 5]), cvt_pk_bf16(x[8 * ks + 6], x[8 * ks + 7])}; return c.b; }
__device__ __forceinline__ bf16x8 sm_a_perm(const LAS unsigned char* tile, int rs, int row, int k0, int h) {
    const u32x2 lo = *(const LAS u32x2*)(tile + row * rs + (k0 + 4 * h) * 2), hi = *(const LAS u32x2*)(tile + row * rs + (k0 + 8 + 4 * h) * 2);
    union { u32x4 u; bf16x8 b; } c; c.u = (u32x4){lo.x, lo.y, hi.x, hi.y}; return c.b; }
__device__ __forceinline__ bf16x8 sm_nat(const LAS unsigned char* tile, int rs, int row, int k0, int h) { return *(const LAS bf16x8*)(tile + row * rs + (k0 + 8 * h) * 2); }
__device__ __forceinline__ bf16x8 sm_tr(const LAS unsigned char* tile, int col0, int lane) {
    const int i16 = lane & 15, g4 = lane >> 4;
    const LAS unsigned char* p = tile + (4 * (g4 >> 1) + (i16 >> 2)) * SM_RS + (col0 + 16 * (g4 & 1) + 4 * (i16 & 3)) * 2;
    const s16x4 v0 = __builtin_amdgcn_ds_read_tr16_b64_v4i16((LAS s16x4*)p), v1 = __builtin_amdgcn_ds_read_tr16_b64_v4i16((LAS s16x4*)(p + 8 * SM_RS));
    return (bf16x8){v0.x, v0.y, v0.z, v0.w, v1.x, v1.y, v1.z, v1.w};
}
#define SM_MFMA(a, b, c) __builtin_amdgcn_mfma_f32_32x32x16_bf16(a, b, c, 0, 0, 0)

__device__ __forceinline__ void scan_a_mfma_task(const Args& a, int task, int lane_in, LAS unsigned char* L) {
    int lane = lane_in; asm volatile("" : "+v"(lane));
    bf16* rkv = (bf16*)(a.ws + WS_BIG); const bf16* eag = (const bf16*)(a.ws + WS_EAG);
    float* pq = (float*)(a.ws + WS_PQ); float* rks = (float*)(a.ws + WS_RKS);
    const int c = task % SC_NCH, bh = task / SC_NCH, b = bh >> 4, hd = bh & 15, hb = hd * 64;
    LAS float* GAB = (LAS float*)(L + SM_GAB); LAS float* CL = (LAS float*)(L + SM_CL); LAS float* T1 = (LAS float*)(L + SM_T1); LAS float* T2 = (LAS float*)(L + SM_T2);
    LAS float* SS = (LAS float*)(L + SM_SS); LAS float* RK = (LAS float*)(L + SM_RK);
    f32x16 ZT[2][4];
#pragma unroll
    for (int jt = 0; jt < 2; ++jt)
#pragma unroll
        for (int zt = 0; zt < 4; ++zt)
#pragma unroll
            for (int e = 0; e < 16; ++e) { const int j = 32 * jt + (e & 3) + 8 * (e >> 2) + 4 * (lane >> 5), z = 32 * zt + (lane & 31); ZT[jt][zt][e] = (zt < 2 && j == z) ? 1.f : 0.f; }
    const size_t tokb = (size_t)b * SEQ + (size_t)c * SC_L;
#pragma unroll 1
    for (int mc = 0; mc < SC_L / SM_L; ++mc) {
        asm volatile("" : "+v"(lane));
        const int h = lane >> 5, c32 = lane & 31, t16 = c32 & 15, ch = hb + lane;
        const size_t tok0 = tokb + (size_t)mc * SM_L;
        {
            int ch_o = ch; asm volatile("" : "+v"(ch_o));
            const float kk_c = a.in[I_K_K][ch_o], ka_c = a.in[I_K_A][ch_o], rk_c = a.in[I_R_K][ch_o];
            unsigned rk_[SM_L], ea_[SM_L];
            {
                const int lr = lane >> 3, lc = lane & 7;
                const u32x4* pr = (const u32x4*)(rkv + (tok0 + lr) * RKV_LD + hb) + lc; const u32x4* pe = (const u32x4*)(eag + (tok0 + lr) * EAG_LD + hb) + lc;
                u32x4 gr[2], gk[2], gv[2], ge[2], ga[2];
#pragma unroll
                for (int i = 0; i < 2; ++i) { gr[i] = pr[i * RKV_LD]; gk[i] = pr[i * RKV_LD + 128]; gv[i] = pr[i * RKV_LD + 256]; ge[i] = pe[i * EAG_LD]; ga[i] = pe[i * EAG_LD + 128]; }
#pragma unroll
                for (int i = 0; i < 2; ++i) { LAS unsigned char* w = L + (lr + 8 * i) * SM_RS + lc * 16;
                    *(LAS u32x4*)(w + SM_AK) = gr[i]; *(LAS u32x4*)(w + SM_BH) = gk[i]; *(LAS u32x4*)(w + SM_VV) = gv[i]; *(LAS u32x4*)(w + SM_KH) = ge[i]; *(LAS u32x4*)(w + SM_RH) = ga[i]; }
#pragma unroll
                for (int s = 0; s < SM_L; ++s) { const LAS unsigned char* q = L + s * SM_RS + lane * 2;
                    const unsigned r = *(const LAS unsigned short*)(q + SM_AK), k = *(const LAS unsigned short*)(q + SM_BH), e = *(const LAS unsigned short*)(q + SM_KH), al = *(const LAS unsigned short*)(q + SM_RH);
                    rk_[s] = r | (k << 16); ea_[s] = al | (e << 16); }
            }
#pragma unroll
            for (int s = 0; s < SM_L; ++s) { const float k = bfhi(rk_[s]), kkr = k * kk_c, al = bflo(ea_[s]); T1[s * 65 + lane] = kkr * kkr; T2[s * 65 + lane] = bflo(rk_[s]) * (k * (1.0f + (al - 1.0f) * ka_c)) * rk_c; }
            { const int st = lane >> 2, pt = lane & 3; float s1 = 0.f, s2 = 0.f;
#pragma unroll
              for (int q = 0; q < 16; ++q) { s1 += T1[st * 65 + pt * 16 + q]; s2 += T2[st * 65 + pt * 16 + q]; }
              s1 += dpp_mov<0xB1>(s1); s1 += dpp_mov<0x4E>(s1); s2 += dpp_mov<0xB1>(s2); s2 += dpp_mov<0x4E>(s2);
              if (pt == 0) { SS[st] = s1; RK[st] = s2; } }
            if (lane < SM_L) rks[(tok0 + lane) * 16 + hd] = RK[lane];
            float cum = 0.f, cprev = 1.f;
#pragma unroll
            for (int s = 0; s < SM_L; ++s) {
                const float k = bfhi(rk_[s]), al = bflo(ea_[s]), r = bflo(rk_[s]);
                const float kk = k * kk_c * rsqrtf(fmaxf(SS[s], 1e-12f)), kp = k * (1.0f + (al - 1.0f) * ka_c);
                cum += bfhi(ea_[s]); const float ct = __expf(-cum), ict = __expf(cum);
                const float akv = kk * cprev, bhv = kk * al * ict, khv = kp * ict, rhv = r * ct;
                *(LAS bf16*)(L + SM_AK + s * SM_RS + lane * 2) = f2bf(akv); *(LAS bf16*)(L + SM_BH + s * SM_RS + lane * 2) = f2bf(bhv);
                *(LAS bf16*)(L + SM_KH + s * SM_RS + lane * 2) = f2bf(khv); *(LAS bf16*)(L + SM_RH + s * SM_RS + lane * 2) = f2bf(rhv);
                cprev = ct;
            }
            CL[lane] = cprev;
        }
        __builtin_amdgcn_sched_barrier(0);
        {
            f32x16 gab, gak, hrb, hrk;
#pragma unroll
            for (int e = 0; e < 16; ++e) { gab[e] = 0.f; gak[e] = 0.f; hrb[e] = 0.f; hrk[e] = 0.f; }
#pragma unroll
            for (int ks = 0; ks < 4; ++ks) {
                const bf16x8 fa = sm_nat(L + SM_AK, SM_RS, t16, 16 * ks, h), fr = sm_nat(L + SM_RH, SM_RS, t16, 16 * ks, h), fb = sm_nat(L + SM_BH, SM_RS, t16, 16 * ks, h), fk = sm_nat(L + SM_KH, SM_RS, t16, 16 * ks, h);
                gab = SM_MFMA(fa, fb, gab); gak = SM_MFMA(fa, fk, gak); hrb = SM_MFMA(fr, fb, hrb); hrk = SM_MFMA(fr, fk, hrk);
            }
            if (c32 < 16) {
#pragma unroll
                for (int e = 0; e < 8; ++e) { const int t = (e & 3) + 8 * (e >> 2) + 4 * h, s = c32;
                    GAB[t * 17 + s] = (s < t) ? gab[e] : 0.f;
                    *(LAS bf16*)(L + SM_GAK + t * SM_TS + s * 2) = f2bf((s < t) ? gak[e] : 0.f);
                    *(LAS bf16*)(L + SM_HRB + t * SM_TS + s * 2) = f2bf((s <= t) ? hrb[e] : 0.f);
                    *(LAS bf16*)(L + SM_HRK + t * SM_TS + s * 2) = f2bf((s <= t) ? hrk[e] : 0.f); }
            }
        }
        __builtin_amdgcn_sched_barrier(0);
        if (lane < 16) {
            float tc[16];
#pragma unroll
            for (int t = 0; t < 16; ++t) { float v = (t == lane) ? 1.f : 0.f;
#pragma unroll
                for (int s = 0; s < t; ++s) v -= GAB[t * 17 + s] * tc[s];
                tc[t] = v; *(LAS bf16*)(L + SM_TT + t * SM_TS + lane * 2) = f2bf(v); }
        }
        __builtin_amdgcn_sched_barrier(0);
#pragma unroll
        for (int zt = 0; zt < 4; ++zt) {
            f32x16 x, o;
#pragma unroll
            for (int e = 0; e < 16; ++e) { x[e] = 0.f; o[e] = 0.f; }
#pragma unroll
            for (int jt = 0; jt < 2; ++jt)
#pragma unroll
                for (int ks = 0; ks < 2; ++ks) {
                    const bf16x8 fa = sm_a_perm(L + SM_AK, SM_RS, t16, 32 * jt + 16 * ks, h), fr = sm_a_perm(L + SM_RH, SM_RS, t16, 32 * jt + 16 * ks, h);
                    const bf16x8 zh = sm_acc_hi(ZT[jt][zt], ks);
                    x = SM_MFMA(fa, zh, x); o = SM_MFMA(fr, zh, o);
                }
            if (zt >= 2) { const bf16x8 fv = sm_tr(L + SM_VV, 32 * (zt - 2), lane);
                x = SM_MFMA(sm_a_perm(L + SM_GAK, SM_TS, t16, 0, h), fv, x); o = SM_MFMA(sm_a_perm(L + SM_HRK, SM_TS, t16, 0, h), fv, o); }
            f32x16 sa;
#pragma unroll
            for (int e = 0; e < 16; ++e) sa[e] = 0.f;
            { const bf16x8 xh = sm_acc_hi(x, 0); const bf16x8 ft = sm_a_perm(L + SM_TT, SM_TS, t16, 0, h); sa = SM_MFMA(ft, xh, sa); }
#pragma unroll
            for (int e = 0; e < 16; ++e) sa[e] = -sa[e];
            const bf16x8 sh = sm_acc_hi(sa, 0);
            { const bf16x8 fh = sm_a_perm(L + SM_HRB, SM_TS, t16, 0, h); o = SM_MFMA(fh, sh, o); }
#pragma unroll
            for (int e = 0; e < 8; ++e) { const int t = (e & 3) + 8 * (e >> 2) + 4 * h;
                rkv[(tok0 + t) * RKV_LD + (zt < 2 ? hb + 32 * zt : 1024 + hb + 32 * (zt - 2)) + c32] = f2bf(o[e]); }
#pragma unroll
            for (int jt = 0; jt < 2; ++jt) {
                const bf16x8 fb = sm_tr(L + SM_BH, 32 * jt, lane);
                ZT[jt][zt] = SM_MFMA(fb, sh, ZT[jt][zt]);
                if (zt >= 2) ZT[jt][zt] = SM_MFMA(sm_tr(L + SM_KH, 32 * jt, lane), sm_tr(L + SM_VV, 32 * (zt - 2), lane), ZT[jt][zt]);
#pragma unroll
                for (int g = 0; g < 4; ++g) { const f32x4 c4 = *(const LAS f32x4*)(CL + 32 * jt + 8 * g + 4 * h);
                    ZT[jt][zt][4 * g] *= c4.x; ZT[jt][zt][4 * g + 1] *= c4.y; ZT[jt][zt][4 * g + 2] *= c4.z; ZT[jt][zt][4 * g + 3] *= c4.w; }

            }
            __builtin_amdgcn_sched_barrier(0);
        }
    }
    if (c < SC_NCH - 1) {
        float* dst = pq + ((size_t)(bh * (SC_NCH - 1) + c) * 2) * 4096;
#pragma unroll
        for (int jt = 0; jt < 2; ++jt)
#pragma unroll
            for (int zt = 0; zt < 4; ++zt)
#pragma unroll
                for (int g = 0; g < 4; ++g) { const int z = 32 * zt + (lane & 31), j0 = 32 * jt + 8 * g + 4 * (lane >> 5);
                    *(f32x4*)(dst + (size_t)z * 64 + j0) = (f32x4){ZT[jt][zt][4 * g], ZT[jt][zt][4 * g + 1], ZT[jt][zt][4 * g + 2], ZT[jt][zt][4 * g + 3]}; }
    }
}
__device__ __forceinline__ void scan_pass_a_mfma(const Args& a, LAS unsigned char* lds) {
    const int tid = threadIdx.x, wave = __builtin_amdgcn_readfirstlane(tid >> 6), lane = tid & 63, G = gridDim.x;
    for (int task = wave * G + blockIdx.x; task < SC_NT; task += 8 * G)
    {   unsigned z = 0u; asm volatile("" : "+v"(z));
        scan_a_mfma_task(a, task, (int)__builtin_amdgcn_mbcnt_hi(~0u, __builtin_amdgcn_mbcnt_lo(~0u, z)), lds + wave * SM_WAVE); }
}
#define PB_WAIT(n) asm volatile("s_waitcnt vmcnt(" #n ")" ::: "memory")
__device__ __forceinline__ void scan_pass_b(const Args& a, LAS unsigned char* lds) {
    const int tid = threadIdx.x, wave = __builtin_amdgcn_readfirstlane(tid >> 6), lane = tid & 63;
    LAS float* Pl = (LAS float*)lds;
    LAS float* Ql = Pl + 4 * 4096;
    float* pq = (float*)(a.ws + WS_PQ);
    for (int u = blockIdx.x; u < NB * 16 * 8; u += gridDim.x) {
        const int xcd = u & 7, idx = u >> 3, bh = (xcd * 4 + (idx >> 3)) & (NB * 16 - 1), row = (idx & 7) * 8 + wave;
        float* pc = pq + ((size_t)(bh * (SC_NCH - 1)) * 2) * 4096;
        float cur = 0.f;
        __syncthreads();
#define PB_ISSUE(cc) do { const int c_ = (cc) < SC_NCH - 1 ? (cc) : SC_NCH - 2; const float* g_ = pc + (size_t)c_ * 2 * 4096; LAS float* d_ = Pl + ((cc) & 3) * 4096 + wave * 256; \
            __builtin_amdgcn_global_load_lds((const unsigned*)(g_ + tid * 4), (LAS unsigned*)d_, 16, 0, 0); __builtin_amdgcn_global_load_lds((const unsigned*)(g_ + 2048 + tid * 4), (LAS unsigned*)(d_ + 2048), 16, 0, 0); \
            __builtin_amdgcn_global_load_lds((const unsigned*)(g_ + 4096 + row * 64 + lane), (LAS unsigned*)(Ql + ((cc) & 3) * 512 + wave * 64), 4, 0, 0); } while (0)
        PB_ISSUE(0); PB_ISSUE(1); PB_ISSUE(2);
        for (int c = 0; c < SC_NCH - 1; ++c) {
            if (c >= 3) PB_WAIT(9); else PB_WAIT(6);
            __builtin_amdgcn_s_barrier(); asm volatile("" ::: "memory");
            PB_ISSUE(c + 3);
            const LAS float* P = Pl + (c & 3) * 4096 + lane;
            float a0 = Ql[(c & 3) * 512 + wave * 64 + lane], a1 = 0.f, a2 = 0.f, a3 = 0.f;
#pragma unroll
            for (int k = 0; k < 64; k += 4) {
#define PB_BC(kk) __int_as_float(__builtin_amdgcn_readlane(__float_as_int(cur), (kk)))
                a0 = fmaf(PB_BC(k), P[k * 64], a0); a1 = fmaf(PB_BC(k + 1), P[(k + 1) * 64], a1); a2 = fmaf(PB_BC(k + 2), P[(k + 2) * 64], a2); a3 = fmaf(PB_BC(k + 3), P[(k + 3) * 64], a3);
            }
            cur = (a0 + a1) + (a2 + a3);
            pc[(size_t)c * 2 * 4096 + 4096 + row * 64 + lane] = cur;
        }
        PB_WAIT(0);
    }
}
__device__ __forceinline__ void pc_seg_load(const bf16* half_base, u32x2 (&out)[2][4]) {
#pragma unroll
    for (int gq = 0; gq < 4; ++gq) { const u32x4 L = ((const u32x4*)half_base)[gq];
        auto s0 = __builtin_amdgcn_permlane32_swap(L.x, L.z, false, false); auto s1 = __builtin_amdgcn_permlane32_swap(L.y, L.w, false, false);
        out[0][gq] = (u32x2){s0[0], s1[0]}; out[1][gq] = (u32x2){s0[1], s1[1]}; }
}
__device__ __forceinline__ void pc_seg_store(bf16* half_base, const u32x2 (&in)[2][4]) {
#pragma unroll
    for (int gq = 0; gq < 4; ++gq) {
        auto s0 = __builtin_amdgcn_permlane32_swap(in[0][gq].x, in[1][gq].x, false, false); auto s1 = __builtin_amdgcn_permlane32_swap(in[0][gq].y, in[1][gq].y, false, false);
        ((u32x4*)half_base)[gq] = (u32x4){s0[0], s1[0], s0[1], s1[1]}; }
}
constexpr int SCC_SS = 144;
__device__ __forceinline__ void scan_pass_c(const Args& a, LAS unsigned char* lds) {
    const int tid = threadIdx.x, wave = __builtin_amdgcn_readfirstlane(tid >> 6), lane = tid & 63, h32 = lane >> 5, c32 = lane & 31;
    bf16* rkv = (bf16*)(a.ws + WS_BIG); const bf16* eag = (const bf16*)(a.ws + WS_EAG);
    const float* pq = (const float*)(a.ws + WS_PQ); const float* rks = (const float*)(a.ws + WS_RKS);
    LAS unsigned char* SH = lds; LAS unsigned char* SL = lds + 64 * SCC_SS;
    for (int u = blockIdx.x; u < SC_NT; u += gridDim.x) {
        const int c = u % SC_NCH, bh = u / SC_NCH, b = bh >> 4, h = bh & 15, hb = h * 64;
        __syncthreads();
        if (c > 0) { const float* sp = pq + ((size_t)(bh * (SC_NCH - 1) + c - 1) * 2 + 1) * 4096 + tid * 8;
            const f32x4 x0 = *(const f32x4*)sp, x1 = *(const f32x4*)(sp + 4);
            const float xs[8] = {x0.x, x0.y, x0.z, x0.w, x1.x, x1.y, x1.z, x1.w};
            unsigned hi[4], lo[4];
#pragma unroll
            for (int q = 0; q < 4; ++q) { hi[q] = cvt_pk_bf16(xs[2 * q], xs[2 * q + 1]); lo[q] = cvt_pk_bf16(xs[2 * q] - bflo(hi[q]), xs[2 * q + 1] - bfhi(hi[q])); }
            *(LAS u32x4*)(SH + (tid >> 3) * SCC_SS + (tid & 7) * 16) = (u32x4){hi[0], hi[1], hi[2], hi[3]};
            *(LAS u32x4*)(SL + (tid >> 3) * SCC_SS + (tid & 7) * 16) = (u32x4){lo[0], lo[1], lo[2], lo[3]}; }
        __syncthreads();
        const size_t tok = (size_t)b * SEQ + (size_t)c * SC_L + wave * 32 + c32;
        f32x16 acc0, acc1;
#pragma unroll
        for (int e = 0; e < 16; ++e) { acc0[e] = 0.f; acc1[e] = 0.f; }
        if (c > 0) {
#pragma unroll
            for (int ks = 0; ks < 4; ++ks) {
                const bf16x8 pf = *(const bf16x8*)(rkv + tok * RKV_LD + hb + ks * 16 + h32 * 8);
                const bf16x8 a0h = *(const LAS bf16x8*)(SH + c32 * SCC_SS + h32 * 16 + ks * 32), a0l = *(const LAS bf16x8*)(SL + c32 * SCC_SS + h32 * 16 + ks * 32);
                const bf16x8 a1h = *(const LAS bf16x8*)(SH + (32 + c32) * SCC_SS + h32 * 16 + ks * 32), a1l = *(const LAS bf16x8*)(SL + (32 + c32) * SCC_SS + h32 * 16 + ks * 32);
                acc0 = __builtin_amdgcn_mfma_f32_32x32x16_bf16(a0h, pf, acc0, 0, 0, 0); acc0 = __builtin_amdgcn_mfma_f32_32x32x16_bf16(a0l, pf, acc0, 0, 0, 0);
                acc1 = __builtin_amdgcn_mfma_f32_32x32x16_bf16(a1h, pf, acc1, 0, 0, 0); acc1 = __builtin_amdgcn_mfma_f32_32x32x16_bf16(a1l, pf, acc1, 0, 0, 0);
            }
        }
        u32x2 yqw[2][4], vw[2][4], gw2[2][4];
        pc_seg_load(rkv + tok * RKV_LD + 1024 + hb + 32 * h32, yqw); pc_seg_load(rkv + tok * RKV_LD + 2048 + hb + 32 * h32, vw); pc_seg_load(eag + tok * EAG_LD + 2048 + hb + 32 * h32, gw2);
        float y[32]; float sum = 0.f;
#pragma unroll
        for (int it = 0; it < 2; ++it)
#pragma unroll
            for (int gq = 0; gq < 4; ++gq) {
                const u32x2 w = yqw[it][gq];
                const float q4[4] = {bflo(w.x), bfhi(w.x), bflo(w.y), bfhi(w.y)};
#pragma unroll
                for (int j = 0; j < 4; ++j) { const float v = (it ? acc1[4 * gq + j] : acc0[4 * gq + j]) + q4[j]; y[it * 16 + gq * 4 + j] = v; sum += v; }
            }
        const float mean = xor32_sum(sum) * (1.0f / 64.0f); float qs = 0.f;
#pragma unroll
        for (int e = 0; e < 32; ++e) { const float d = y[e] - mean; qs += d * d; }
        const float rstd = rsqrtf(xor32_sum(qs) * (1.0f / 64.0f) + 64e-5f);
        const float rkc = rks[tok * 16 + h];
        u32x2 ow[2][4];
#pragma unroll
        for (int it = 0; it < 2; ++it)
#pragma unroll
            for (int gq = 0; gq < 4; ++gq) {
                const int i0 = 32 * it + 8 * gq + 4 * h32;
                const f32x4 lg = *(const f32x4*)(a.in[I_LNX_G] + hb + i0), lb = *(const f32x4*)(a.in[I_LNX_B] + hb + i0);
                const float v4[4] = {bflo(vw[it][gq].x), bfhi(vw[it][gq].x), bflo(vw[it][gq].y), bfhi(vw[it][gq].y)}, g4[4] = {bflo(gw2[it][gq].x), bfhi(gw2[it][gq].x), bflo(gw2[it][gq].y), bfhi(gw2[it][gq].y)};
                const float l4[4] = {lg.x, lg.y, lg.z, lg.w}, b4[4] = {lb.x, lb.y, lb.z, lb.w};
                float o[4];
#pragma unroll
                for (int j = 0; j < 4; ++j) o[j] = ((y[it * 16 + gq * 4 + j] - mean) * rstd * l4[j] + b4[j] + rkc * v4[j]) * g4[j];
                ow[it][gq] = (u32x2){cvt_pk_bf16(o[0], o[1]), cvt_pk_bf16(o[2], o[3])};
            }
        pc_seg_store(rkv + tok * RKV_LD + hb + 32 * h32, ow);
    }
}

constexpr int N_PHASES = 27;
__global__ void __launch_bounds__(512, 2) mk_fwd(Args args) {
    extern __shared__ __attribute__((aligned(16))) unsigned char lds_raw[];
    LAS unsigned char* lds = (LAS unsigned char*)lds_raw;
    const int tid = threadIdx.x;
    const int G = gridDim.x, nw = G * 8, gsize = G * 512;
#define TIDO() ({ int t_ = threadIdx.x; asm volatile("" : "+v"(t_)); t_; })
#define lane (TIDO() & 63)
#define gw ((int)blockIdx.x * 8 + (TIDO() >> 6))
#define gtid ((int)blockIdx.x * 512 + TIDO())
    unsigned char* ws = args.ws;
    volatile LAS unsigned* lctl = (volatile LAS unsigned*)(lds + LDS_CTL_OFF);
    if (tid < 16) lctl[tid] = 0u;
    __syncthreads();
    const int lo = args.ph_lo, hi = args.ph_hi;
    XcdBarrier bar; bar.bar = (unsigned*)(ws + WS_CTL) + CW_BAR; bar.x = 0; bar.st = nullptr;
    if (hi - lo > 1) bar = xcd_barrier_post((unsigned*)(ws + WS_CTL) + CW_BAR, lctl + 8);
#define IN(k) (lo <= (k) && (k) < hi)
#ifndef PROBE_DUP
#define PROBE_DUP 0u
#endif
#define RUN(k, ...) do { if (IN(k)) { __VA_ARGS__; if ((PROBE_DUP >> (k)) & 1u) { xcd_barrier(bar); __VA_ARGS__; } } if (IN(k) && IN((k) + 1)) xcd_barrier(bar); } while (0)
    float* X = args.out;
    bf16* XNp = (bf16*)(ws + WS_XN);
    const pg8::bf16_t* XNa = (const pg8::bf16_t*)(ws + WS_XN) + D;
    bf16* DD = (bf16*)(ws + WS_DD);
    pg8::bf16_t* BIG = (pg8::bf16_t*)(ws + WS_BIG);
    pg8::bf16_t* YY = (pg8::bf16_t*)(ws + WS_Y);
    const unsigned char* Wb = ws + WS_W;
    const int bx = (int)blockIdx.x;

#define GEMM_CALL(MODE, Aptr, Woff, N_, K_, lda_, gap_, ts_, Optr, ldc_, b0_, b1_) do { pg8::Gemm g{Aptr, (const pg8::bf16_t*)(Wb + (Woff)), M, N_, K_, lda_, gap_, ts_}; pg8::StaticOrder S; S.init(M, N_, G, bx); \
        pg8::Epi<MODE> E{Optr, ldc_, b0_, b1_}; pg8::gemm_phase(lds, g, S, E); } while (0)
#define FFN_G1(k) RUN(k, GEMM_CALL(1, XNa, W_GU, 2 * FF, D, D, 1, D / 64, BIG, FF, nullptr, nullptr))
#define FFN_G2(k, outp) RUN(k, do { pg8::Gemm g{BIG, (const pg8::bf16_t*)(Wb + W_DN), M, D, FF, FF, 0, FF / 64}; pg8::StaticOrder S; S.init(M, D, G, bx); S.rev = 1; \
        pg8::Epi<0> E{(pg8::bf16_t*)(outp), D, nullptr, nullptr}; pg8::gemm_phase(lds, g, S, E); } while (0))
    bf16* DY = (bf16*)(ws + WS_Y);
    const pg8::bf16_t* ATT = (const pg8::bf16_t*)(ws + WS_ATT);

    RUN(0, row_pass<false, false, false, true>(args.in[I_X], nullptr, nullptr, nullptr, 0.f, nullptr, nullptr, 0.f, args.in[I_L0F1 + 0], XNp, gw, nw, lane); convert_ffn(args, I_L0F1, gtid, gsize, lds));
    FFN_G1(1); FFN_G2(2, DY);
    RUN(3, row_pass<true, false, false, true>(args.in[I_X], nullptr, DY, args.in[I_L0F1 + 1], 0.5f, nullptr, nullptr, 0.f, args.in[I_L0_MIX_PRE], XNp, gw, nw, lane); convert_mix0(args, gtid, gsize, lds));
    RUN(4, GEMM_CALL(0, XNa, W_IN, PROJ_LD, D, D, 1, D / 64, BIG, PROJ_LD, nullptr, nullptr));
    RUN(5, do {
        pg8::Gemm g{BIG + PC_KC, (const pg8::bf16_t*)(Wb + W_CMP), 8192, 256, 2048 / CMP_SPLIT, PROJ_LD, 0, 32, 2048}; pg8::SplitTiles S{G, bx, CMP_SPLIT * 32};
        pg8::Epi<6> E{(pg8::bf16_t*)(ws + WS_XN), 128, nullptr, nullptr}; pg8::gemm_phase<pg8::Epi<6>, pg8::SplitTiles, true>(lds, g, S, E); } while (0));
    RUN(6, compress_stage2(args, gw, nw, lane));
    RUN(7, nsa_mfma_phase(args, lds));
    RUN(8, GEMM_CALL(0, ATT, W_OUT, D, D, D, 0, D / 64, (pg8::bf16_t*)DD, D, nullptr, nullptr));
    RUN(9, row_pass<true, true, true, true>(args.in[I_X], X, DY, args.in[I_L0F1 + 1], 0.5f, DD, args.in[I_L0_MIX_POST], 1.0f, args.in[I_L0F2 + 0], XNp, gw, nw, lane); convert_ffn(args, I_L0F2, gtid, gsize, lds));
    FFN_G1(10); FFN_G2(11, DD);
    RUN(12, row_pass<true, false, false, true>(X, nullptr, DD, args.in[I_L0F2 + 1], 0.5f, nullptr, nullptr, 0.f, args.in[I_L1F1 + 0], XNp, gw, nw, lane); convert_ffn(args, I_L1F1, gtid, gsize, lds));
    FFN_G1(13); FFN_G2(14, DY);
    RUN(15, row_pass<true, true, true, true>(X, X, DD, args.in[I_L0F2 + 1], 0.5f, DY, args.in[I_L1F1 + 1], 0.5f, args.in[I_L1_MIX_PRE], XNp, gw, nw, lane); convert_mix1(args, gtid, gsize, lds));
    RUN(16, rwkv_mix_phase(args, gtid, gsize));
    RUN(17, GEMM_CALL(0, (const pg8::bf16_t*)(ws + WS_XR), W_R, D, D, D, 0, D / 64, BIG, RKV_LD, nullptr, nullptr);
            GEMM_CALL(0, (const pg8::bf16_t*)(ws + WS_XK), W_K, D, D, D, 0, D / 64, BIG + 1024, RKV_LD, nullptr, nullptr);
            GEMM_CALL(0, (const pg8::bf16_t*)(ws + WS_XV), W_V, D, D, D, 0, D / 64, BIG + 2048, RKV_LD, nullptr, nullptr);
            GEMM_CALL(5, XNa, W_LORA, 256, 2 * D, D, 1, D / 64, BIG + 3072, RKV_LD, nullptr, nullptr);
            convert_mix1_l2(args, gtid, gsize, lds));
    RUN(18, do { pg8::Gemm g{BIG + 3072, (const pg8::bf16_t*)(Wb + W_L2), M, 2048, 128, RKV_LD, 0, 2, 256}; pg8::StaticOrder S; S.init(M, 2048, G, bx);
                 pg8::Epi<3> E{(pg8::bf16_t*)(ws + WS_EAG), EAG_LD, args.in[I_W0], args.in[I_A0]}; pg8::gemm_phase(lds, g, S, E); } while (0);
            do { pg8::Gemm g{BIG + 3072 + 128, (const pg8::bf16_t*)(Wb + W_L2) + (size_t)2048 * 256 + 128, M, 1024, 128, RKV_LD, 0, 2, 256}; pg8::StaticOrder S; S.init(M, 1024, G, bx);
                 pg8::Epi<0> E{(pg8::bf16_t*)(ws + WS_EAG) + 2048, EAG_LD, nullptr, nullptr}; pg8::gemm_phase(lds, g, S, E); } while (0));
    RUN(19, scan_pass_a_mfma(args, lds));
    RUN(20, scan_pass_b(args, lds));
    RUN(21, scan_pass_c(args, lds));
    RUN(22, GEMM_CALL(0, BIG, W_O, D, D, RKV_LD, 0, D / 64, (pg8::bf16_t*)DD, D, nullptr, nullptr));
    RUN(23, row_pass<true, false, false, true>(X, nullptr, DD, args.in[I_L1_MIX_POST], 1.0f, nullptr, nullptr, 0.f, args.in[I_L1F2 + 0], XNp, gw, nw, lane); convert_ffn(args, I_L1F2, gtid, gsize, lds));
    FFN_G1(24); FFN_G2(25, DY);
    RUN(26, row_pass<true, true, true, false>(X, X, DD, args.in[I_L1_MIX_POST], 1.0f, DY, args.in[I_L1F2 + 1], 0.5f, nullptr, nullptr, gw, nw, lane));
#undef IN
#undef RUN
#undef lane
#undef gw
#undef gtid
#undef TIDO
}

extern "C" void kernel_launch(void* const* d_in, const int* in_sizes, int n_in, void* d_out, int out_size, void* d_ws, size_t ws_size, hipStream_t stream) {
    static int grid = 0;
    if (grid == 0) {
        if (n_in != 53 || out_size != M * D || ws_size < WS_END) { fprintf(stderr, "kernel_launch: unexpected shapes (n_in %d, out %d, ws %zu)\n", n_in, out_size, ws_size); grid = -1; return; }
        int dev = 0, cus = 0;
        if (hipGetDevice(&dev) != hipSuccess || hipDeviceGetAttribute(&cus, hipDeviceAttributeMultiprocessorCount, dev) != hipSuccess) { grid = -1; return; }
        if (hipFuncSetAttribute((const void*)mk_fwd, hipFuncAttributeMaxDynamicSharedMemorySize, LDS_BYTES) != hipSuccess) { fprintf(stderr, "kernel_launch: hipFuncSetAttribute failed\n"); grid = -1; return; }
        int per_cu = 0;
        if (hipOccupancyMaxActiveBlocksPerMultiprocessor(&per_cu, (const void*)mk_fwd, 512, LDS_BYTES) != hipSuccess || per_cu < 1) { fprintf(stderr, "kernel_launch: occupancy query says %d\n", per_cu); }
        (void)hipGetLastError();
        grid = cus;
    }
    if (grid < 0) return;
    (void)hipMemsetAsync((char*)d_ws + WS_CTL, 0, CTL_ZERO_BYTES, stream);
    Args a{};
    for (int i = 0; i < 53; ++i) a.in[i] = (const float*)d_in[i];
    a.out = (float*)d_out; a.ws = (unsigned char*)d_ws;
#if MK_ONE_LAUNCH
    a.ph_lo = 0; a.ph_hi = N_PHASES;
    hipLaunchKernelGGL(mk_fwd, dim3(grid), dim3(512), LDS_BYTES, stream, a);
#else
    for (int p = 0; p < N_PHASES; ++p) { a.ph_lo = p; a.ph_hi = p + 1; hipLaunchKernelGGL(mk_fwd, dim3(grid), dim3(512), LDS_BYTES, stream, a); }
#endif
}
```

```cpp
#include <hip/hip_runtime.h>
#include <cstdio>
#include <cstdint>

#ifndef MK_ONE_LAUNCH
#define MK_ONE_LAUNCH 1
#endif

#define LAS __attribute__((address_space(3)))
typedef unsigned short bf16;
typedef short bf16x8 __attribute__((ext_vector_type(8)));
typedef float f32x4 __attribute__((ext_vector_type(4)));
typedef float f32x2 __attribute__((ext_vector_type(2)));
typedef unsigned u32x4 __attribute__((ext_vector_type(4)));
typedef unsigned u32x2 __attribute__((ext_vector_type(2)));

constexpr int NB = 2, SEQ = 16384, M = NB * SEQ, D = 1024, FF = 2816;
constexpr int NCMP = 1023, NSLC = 256;
constexpr int PROJ_LD = 3072;
constexpr int PC_Q = 0, PC_KC = 512, PC_VC = 640, PC_KS = 768, PC_VS = 896, PC_KW = 1024, PC_VW = 1152, PC_CB = 1280, PC_CC = 1792, PC_CU = 2304, PC_G = 2816;
constexpr int RKV_LD = 3328;
constexpr int EAG_LD = 3072;
constexpr float EPS = 1e-6f;

constexpr size_t MiB = 1u << 20;
constexpr size_t WS_CTL = 0, CTL_ZERO_BYTES = 1 * MiB;
constexpr size_t WS_KC = 1 * MiB, WS_VC = 2 * MiB;
constexpr size_t WS_W = 8 * MiB;
constexpr size_t WS_BIG = 28 * MiB;
constexpr size_t WS_EAG = 236 * MiB;
constexpr size_t WS_XN = 236 * MiB;
constexpr size_t WS_DD = 302 * MiB;
constexpr size_t WS_ATT = 236 * MiB;
constexpr size_t WS_Y = 428 * MiB;
constexpr size_t WS_PQ = 428 * MiB;
constexpr size_t WS_XR = 302 * MiB, WS_XK = 366 * MiB, WS_XV = 430 * MiB;
constexpr size_t WS_RKS = 494 * MiB;
constexpr size_t WS_END = 496 * MiB;
constexpr size_t W_GU = 0, W_DN = 11 * MiB;
constexpr size_t W_IN = 0, W_OUT = 6 * MiB, W_CMP = 8 * MiB;
constexpr size_t WS_PEB = 1 * MiB + 768 * 1024;
constexpr size_t W_R = 0, W_K = 2 * MiB, W_V = 4 * MiB, W_LORA = 6 * MiB, W_L2 = 13 * MiB, W_O = 15 * MiB;

constexpr int CW_BAR = 4096;

constexpr int LDS_CTL_OFF = 147456;
constexpr int LDS_BYTES = 147456 + 256;

__device__ __forceinline__ float bf2f(bf16 b) { return __uint_as_float(((unsigned)b) << 16); }
__device__ __forceinline__ float bflo(unsigned u) { return __uint_as_float(u << 16); }
__device__ __forceinline__ float bfhi(unsigned u) { return __uint_as_float(u & 0xffff0000u); }
typedef __bf16 nbf16x2 __attribute__((ext_vector_type(2)));
typedef float nf32x2 __attribute__((ext_vector_type(2)));
__device__ __forceinline__ unsigned cvt_pk_bf16(float lo, float hi) { const nf32x2 v = {lo, hi}; return __builtin_bit_cast(unsigned, __builtin_convertvector(v, nbf16x2)); }
__device__ __forceinline__ bf16 f2bf(float f) { return (bf16)(cvt_pk_bf16(f, 0.f) & 0xffffu); }
__device__ __forceinline__ float wave_sum(float v) {
#pragma unroll
    for (int o = 1; o < 64; o <<= 1) v += __shfl_xor(v, o);
    return v;
}
template <int CTRL, int ROWMASK> __device__ __forceinline__ float dpp_add(float x) { const int t = __builtin_amdgcn_update_dpp(0, __float_as_int(x), CTRL, ROWMASK, 0xF, false); return x + __int_as_float(t); }
__device__ __forceinline__ float wave_sum_dpp(float v) {
    v = dpp_add<0xB1, 0xF>(v); v = dpp_add<0x4E, 0xF>(v); v = dpp_add<0x124, 0xF>(v); v = dpp_add<0x128, 0xF>(v);
    v = dpp_add<0x142, 0xA>(v); v = dpp_add<0x143, 0xC>(v);
    return __int_as_float(__builtin_amdgcn_readlane(__float_as_int(v), 63));
}
template <int CTRL> __device__ __forceinline__ float dpp_mov(float x) { return __int_as_float(__builtin_amdgcn_mov_dpp(__float_as_int(x), CTRL, 0xf, 0xf, true)); }
template <int CTRL> __device__ __forceinline__ int dpp_movi(int x) { return __builtin_amdgcn_mov_dpp(x, CTRL, 0xf, 0xf, true); }
__device__ __forceinline__ float xor32_max(float x) { auto rr = __builtin_amdgcn_permlane32_swap(__float_as_uint(x), __float_as_uint(x), false, false); return fmaxf(__uint_as_float(rr[0]), __uint_as_float(rr[1])); }
__device__ __forceinline__ float xor32_sum(float x) { auto rr = __builtin_amdgcn_permlane32_swap(__float_as_uint(x), __float_as_uint(x), false, false); return __uint_as_float(rr[0]) + __uint_as_float(rr[1]); }
__device__ __forceinline__ float red8(float v) { v += dpp_mov<0xB1>(v); v += dpp_mov<0x4E>(v); v += dpp_mov<0x141>(v); return v; }
__device__ __forceinline__ float wave_max(float v) {
#pragma unroll
    for (int o = 1; o < 64; o <<= 1) v = fmaxf(v, __shfl_xor(v, o));
    return v;
}
__device__ __forceinline__ float sigmoidf_(float x) { return __builtin_amdgcn_rcpf(1.0f + __expf(-x)); }

namespace pg8 {
#define PG8_LAS __attribute__((address_space(3)))
typedef unsigned short bf16_t;
constexpr int BM = 256, BK = 64, HALF = 128, HTB = HALF * BK * 2, STAGE_BYTES = 8 * HTB, NXCD = 8, WGM = 8;

__host__ __device__ __forceinline__ int lds_byte(int r, int c) { const int st = (r >> 4) * 2 + (c >> 5), rr = r & 15, cc = c & 31, ob = rr * 64 + cc * 2; return st * 1024 + (ob ^ (((ob >> 9) & 1) << 5)); }
__host__ __device__ __forceinline__ void stage_rc(int b, int& R, int& C) { const int st = b / 1024, sb = b % 1024, swz = sb ^ (((sb >> 9) & 1) << 5); R = (st >> 1) * 16 + swz / 64; C = (st & 1) * 32 + (swz % 64) / 2; }
__host__ __device__ __forceinline__ int perm32(int rho) { const int n = rho >> 4, i = rho & 15; return 8 * (i >> 2) + 4 * n + (i & 3); }

struct Unit { int pm, pn; };
struct Gemm { const bf16_t* A; const bf16_t* Bt; int M, N, K, lda, gap, ts, ldb = 0; };

struct StaticOrder {
    int nM, nN, nwg, G, c, rev = 0;
    __host__ __device__ void init(int M_, int N_, int G_, int c_) { nM = M_ / BM; nN = N_ / BM; nwg = nM * nN; G = G_; c = c_; }
    __host__ __device__ bool next(int i, Unit& u) const {
        const int rounds = nwg / G; const bool flip = rev && rounds * G == nwg;
        if (flip && i >= rounds) return false;
        const long L = (long)(flip ? rounds - 1 - i : i) * G + c; if (L >= nwg) return false;
        int wgid = (int)L; { const int q = nwg / NXCD, r = nwg % NXCD, xcd = wgid % NXCD, off = wgid / NXCD; wgid = (xcd < r ? xcd * (q + 1) : r * (q + 1) + (xcd - r) * q) + off; }
        const int nig = WGM * nN, gid = wgid / nig, fm = gid * WGM, gsz = (nM - fm) < WGM ? (nM - fm) : WGM;
        u.pm = fm + ((wgid % nig) % gsz); u.pn = (wgid % nig) / gsz; return true;
    }
    __device__ __forceinline__ void a_ready(const Unit&) const {}
    __device__ __forceinline__ void done(const Unit&) const {}
};

struct SplitTiles {
    int G, c, n;
    __host__ __device__ bool next(int i, Unit& u) const { const int L = i * G + c; if (L >= n) return false; u.pm = L & 31; u.pn = L >> 5; return true; }
    __device__ __forceinline__ void a_ready(const Unit&) const {}
    __device__ __forceinline__ void done(const Unit&) const {}
};

template <int MODE> struct Epi {
    static constexpr bool PERM = true, AFTER_DRAIN = false;
    bf16_t* O; int ldc; const float* b0; const float* b1;
    __device__ __forceinline__ void operator()(const f32x4 (&acc)[2][2][4][2], const Unit& u, int wr, int wc, int, int) const {
        int ln_ = threadIdx.x; asm volatile("" : "+v"(ln_));
        const int fr = ln_ & 15, fq = (ln_ >> 4) & 3;
        if constexpr (MODE == 4 || MODE == 6) {
            const int row0 = u.pm * BM + wr * 64 + fr;
            const int kv = u.pm >> 4, col0 = wc * 32 + 8 * fq; float* H = (float*)O + (MODE == 6 ? (size_t)u.pn * 8192 * 128 : (size_t)0);
#pragma unroll
            for (int ai = 0; ai < 2; ++ai)
#pragma unroll
                for (int m = 0; m < 4; ++m) {
                    float o[8];
#pragma unroll
                    for (int n = 0; n < 2; ++n)
#pragma unroll
                        for (int j = 0; j < 4; ++j) {
                            if constexpr (MODE == 6) o[n * 4 + j] = kv ? acc[ai][1][m][n][j] : acc[ai][0][m][n][j];
                            else { const float hh = (kv ? acc[ai][1][m][n][j] : acc[ai][0][m][n][j]) + b0[kv * 128 + col0 + n * 4 + j];
                                const float uu = 0.7978845608028654f * (hh + 0.044715f * hh * hh * hh); const float e2 = __expf(2.0f * uu); o[n * 4 + j] = 0.5f * hh * (2.0f - 2.0f * __builtin_amdgcn_rcpf(e2 + 1.0f)); } }
                    float* hp = H + (size_t)(row0 + ai * HALF + m * 16) * 128 + col0;
                    *(f32x4*)hp = (f32x4){o[0], o[1], o[2], o[3]}; *(f32x4*)(hp + 4) = (f32x4){o[4], o[5], o[6], o[7]};
                }
        } else if constexpr (MODE == 1) {
            const int row0 = u.pm * BM + wr * 64 + fr;
            const int col0 = u.pn * HALF + wc * 32 + 8 * fq;
#pragma unroll
            for (int ai = 0; ai < 2; ++ai)
#pragma unroll
                for (int m = 0; m < 4; ++m) {
                    float o[8];
#pragma unroll
                    for (int n = 0; n < 2; ++n)
#pragma unroll
                        for (int j = 0; j < 4; ++j) { const float g = acc[ai][0][m][n][j], up = acc[ai][1][m][n][j]; o[n * 4 + j] = g * __builtin_amdgcn_rcpf(1.0f + __expf(-g)) * up; }
                    u32x4 w; w.x = cvt_pk_bf16(o[0], o[1]); w.y = cvt_pk_bf16(o[2], o[3]); w.z = cvt_pk_bf16(o[4], o[5]); w.w = cvt_pk_bf16(o[6], o[7]);
                    *(u32x4*)(O + (size_t)(row0 + ai * HALF + m * 16) * ldc + col0) = w;
                }
        } else {
            const int row0 = u.pm * BM + wr * 64 + fr;
            const int col0 = u.pn * BM + wc * 32 + 8 * fq;
#pragma unroll
            for (int ai = 0; ai < 2; ++ai)
#pragma unroll
                for (int m = 0; m < 4; ++m) {
                    bf16_t* rowp = O + (size_t)(row0 + ai * HALF + m * 16) * ldc + col0;
#pragma unroll
                    for (int bj = 0; bj < 2; ++bj) {
                        float o[8];
#pragma unroll
                        for (int n = 0; n < 2; ++n)
#pragma unroll
                            for (int j = 0; j < 4; ++j) o[n * 4 + j] = acc[ai][bj][m][n][j];
                        if constexpr (MODE == 2 || MODE == 5) {
                            if (u.pn == (MODE == 2 ? 12 : 0)) {
                                if (bj == 1) {
#pragma unroll
                                    for (int j = 0; j < 8; ++j) o[j] = sigmoidf_(o[j]);
                                } else if (wc < 2) {
#pragma unroll
                                    for (int j = 0; j < 8; ++j) { const float e2 = __expf(2.0f * o[j]); o[j] = 1.0f - 2.0f * __builtin_amdgcn_rcpf(e2 + 1.0f); }
                                }
                            }
                        }
                        if constexpr (MODE == 3) {
                            const int cc = (u.pn & 3) * BM + bj * HALF + wc * 32 + 8 * fq;
                            if (u.pn < 4) {
#pragma unroll
                                for (int j = 0; j < 8; ++j) o[j] = 0.60653065971f * sigmoidf_(o[j] + b0[cc + j]);
                            } else if (u.pn < 8) {
#pragma unroll
                                for (int j = 0; j < 8; ++j) o[j] = sigmoidf_(o[j] + b1[cc + j]);
                            }
                        }
                        u32x4 w; w.x = cvt_pk_bf16(o[0], o[1]); w.y = cvt_pk_bf16(o[2], o[3]); w.z = cvt_pk_bf16(o[4], o[5]); w.w = cvt_pk_bf16(o[6], o[7]);
                        *(u32x4*)(rowp + bj * HALF) = w;
                    }
                }
        }
    }
};

template <class EpiT, class Sched, bool CMPA = false, bool ALIGN_EPI = true, bool SP2 = true>
__device__ __forceinline__ void gemm_phase(PG8_LAS unsigned char* lds, const Gemm g, const Sched& S, const EpiT& E) {
    const int tid = threadIdx.x, wid = __builtin_amdgcn_readfirstlane(tid >> 6), lane = tid & 63, wr = wid >> 2, wc = wid & 3, fr = lane & 15, fq = lane >> 4;
    const int K = g.K, nt = K / BK, lda = g.lda, ts = g.ts, ldb = g.ldb ? g.ldb : g.K;
    unsigned voffA[2], voffB[2];
#pragma unroll
    for (int i = 0; i < 2; ++i) { int R, C; stage_rc(tid * 16 + i * 8192, R, C); const int Rb = EpiT::PERM ? ((R & ~31) + perm32(R & 31)) : R;
        voffA[i] = CMPA ? (unsigned)((R >> 1) * 16 * lda + (R & 1) * 64 + C) * 2u : (unsigned)(R * lda + C) * 2u; voffB[i] = (unsigned)(Rb * ldb + C) * 2u; }
    const size_t kstep = (size_t)(BK * 2), kstepA = CMPA ? (size_t)lda * 2 : kstep;
    const size_t hstepA = CMPA ? (size_t)64 * 16 * lda * 2 : (size_t)HALF * lda * 2, hstepB = (size_t)HALF * ldb * 2;
    const size_t tstepB = 2 * hstepB, rowA = (size_t)lda * 2;
    const unsigned ldsw = (unsigned)wid * 1024u;
    const int aoff = lds_byte(wr * 64 + fr, fq * 8), boff = lds_byte(wc * 32 + fr, fq * 8);
#define PG8_BBASE(pn) (CMPA ? (const char*)g.Bt + (size_t)(pn) * ((size_t)nt * kstep) : (const char*)g.Bt + (size_t)(pn) * tstepB)
#define PG8_ASLICE(pn) (CMPA ? (size_t)(pn) * ((size_t)nt * kstepA) : (size_t)0)
#define PG8_ABASE(pm) (CMPA ? (const char*)g.A + ((size_t)((pm) & 15) * 128 * 16 * lda + (size_t)((pm) >> 4) * 128) * 2 : (const char*)g.A + ((size_t)(pm) * BM + ((g.gap && (pm) >= 64) ? 1 : 0)) * rowA)
#define PG8_KOFF(t) (CMPA ? (ptrdiff_t)(t) * (ptrdiff_t)kstepA : (((t) < ts) ? (ptrdiff_t)(t) * (ptrdiff_t)kstep : (ptrdiff_t)((t) - ts) * (ptrdiff_t)kstep - (ptrdiff_t)rowA))
#define PG8_SA(b, h) (((b) * 2 + (h)) * HTB)
#define PG8_SB(b, h) ((4 + (b) * 2 + (h)) * HTB)
#define PG8_STAGE(bufoff, gbase, voff) do { _Pragma("unroll") for (int _i = 0; _i < 2; ++_i) \
        __builtin_amdgcn_global_load_lds((const unsigned*)((const char*)(gbase) + (voff)[_i]), (PG8_LAS unsigned*)(lds + (bufoff) + ldsw + _i * 8192), 16, 0, 0); } while (0)
#define PG8_LDA(dst, b, h) do { _Pragma("unroll") for (int m = 0; m < 4; ++m) _Pragma("unroll") for (int k = 0; k < 2; ++k) dst[m][k] = *(const PG8_LAS bf16x8*)(lds + PG8_SA(b, h) + aoff + m * 2048 + k * 1024); } while (0)
#define PG8_LDB(dst, b, h) do { _Pragma("unroll") for (int n = 0; n < 2; ++n) _Pragma("unroll") for (int k = 0; k < 2; ++k) dst[n][k] = *(const PG8_LAS bf16x8*)(lds + PG8_SB(b, h) + boff + n * 2048 + k * 1024); } while (0)
#define PG8_MMA(ai, bj, At, Bt) do { __builtin_amdgcn_s_setprio(1); _Pragma("unroll") for (int m = 0; m < 4; ++m) _Pragma("unroll") for (int n = 0; n < 2; ++n) _Pragma("unroll") for (int k = 0; k < 2; ++k) \
        acc[ai][bj][m][n] = __builtin_amdgcn_mfma_f32_16x16x32_bf16(Bt[n][k], At[m][k], acc[ai][bj][m][n], 0, 0, 0); __builtin_amdgcn_s_setprio(0); } while (0)
#define PG8_WAIT_V(n) asm volatile("s_waitcnt vmcnt(" #n ")" ::: "memory")
#define PG8_WAIT_L(n) asm volatile("s_waitcnt lgkmcnt(" #n ")" ::: "memory")
#define PG8_BAR __builtin_amdgcn_s_barrier()
#define PG8_SCHED __builtin_amdgcn_sched_barrier(0)
    Unit cur, nxt; int ui = 0;
    if (!S.next(0, cur)) return;
    f32x4 acc[2][2][4][2];
#pragma unroll
    for (int a = 0; a < 2; ++a)
#pragma unroll
        for (int b = 0; b < 2; ++b)
#pragma unroll
            for (int m = 0; m < 4; ++m)
#pragma unroll
                for (int n = 0; n < 2; ++n) acc[a][b][m][n] = (f32x4){0.f, 0.f, 0.f, 0.f};
    bf16x8 At[4][2], B0[2][2], B1[2][2];
    const char* cA = PG8_ABASE(cur.pm) + PG8_ASLICE(cur.pn); const char* cB = PG8_BBASE(cur.pn);
    S.a_ready(cur);
    static_assert(SP2, "only the SP2 loop is kept");
    PG8_STAGE(PG8_SB(0, 0), cB, voffB); PG8_STAGE(PG8_SB(0, 1), cB + hstepB, voffB); PG8_STAGE(PG8_SA(0, 0), cA, voffA); PG8_STAGE(PG8_SA(0, 1), cA + hstepA, voffA);
    if (wr == 1) PG8_BAR;
    PG8_WAIT_V(2); PG8_BAR;
    PG8_STAGE(PG8_SB(1, 0), cB + kstep, voffB); PG8_STAGE(PG8_SA(1, 0), cA + kstepA, voffA); PG8_STAGE(PG8_SB(1, 1), cB + hstepB + kstep, voffB);
    PG8_WAIT_V(6); PG8_BAR;
    for (;;) {
        const bool has_next = S.next(ui + 1, nxt);
        const char* nA = has_next ? PG8_ABASE(nxt.pm) + PG8_ASLICE(nxt.pn) : cA; const char* nB = has_next ? PG8_BBASE(nxt.pn) : cB;
        for (int t = 0; t < nt; t += 2) {
            const bool last = (t == nt - 2);
            const char* a1 = cA + PG8_KOFF(t + 1);
            const char* a2 = last ? nA : cA + PG8_KOFF(t + 2); const char* b2 = last ? nB : cB + (size_t)(t + 2) * kstep;
            const char* a3 = a2 + kstepA; const char* b3 = b2 + kstep;
            if (last && has_next) S.a_ready(nxt);
            PG8_LDB(B0, 0, 0); PG8_LDB(B1, 0, 1); PG8_SCHED; PG8_LDA(At, 0, 0); PG8_STAGE(PG8_SA(1, 1), a1 + hstepA, voffA);
            PG8_WAIT_V(8); PG8_WAIT_L(0); PG8_BAR; PG8_MMA(0, 0, At, B0); PG8_MMA(0, 1, At, B1); PG8_BAR; PG8_SCHED;
            PG8_LDA(At, 0, 1); PG8_STAGE(PG8_SB(0, 0), b2, voffB); PG8_STAGE(PG8_SB(0, 1), b2 + hstepB, voffB); PG8_STAGE(PG8_SA(0, 0), a2, voffA);
            PG8_WAIT_V(8); PG8_WAIT_L(0); PG8_BAR; PG8_MMA(1, 0, At, B0); PG8_MMA(1, 1, At, B1); PG8_BAR; PG8_SCHED;
            PG8_LDB(B0, 1, 0); PG8_LDB(B1, 1, 1); PG8_SCHED; PG8_LDA(At, 1, 0); PG8_STAGE(PG8_SA(0, 1), a2 + hstepA, voffA);
            PG8_WAIT_V(8); PG8_WAIT_L(0); PG8_BAR; PG8_MMA(0, 0, At, B0); PG8_MMA(0, 1, At, B1); PG8_BAR; PG8_SCHED;
            PG8_LDA(At, 1, 1); PG8_STAGE(PG8_SB(1, 0), b3, voffB); PG8_STAGE(PG8_SB(1, 1), b3 + hstepB, voffB); PG8_STAGE(PG8_SA(1, 0), a3, voffA);
            PG8_WAIT_V(8); PG8_WAIT_L(0); PG8_BAR; PG8_MMA(1, 0, At, B0); PG8_MMA(1, 1, At, B1); PG8_BAR; PG8_SCHED;
        }
        if constexpr (ALIGN_EPI) { if (wr == 0) PG8_BAR; }
        E(acc, cur, wr, wc, fr, fq); S.done(cur);
        if (!has_next) break;
#pragma unroll
        for (int a = 0; a < 2; ++a)
#pragma unroll
            for (int b = 0; b < 2; ++b)
#pragma unroll
                for (int m = 0; m < 4; ++m)
#pragma unroll
                    for (int n = 0; n < 2; ++n) acc[a][b][m][n] = (f32x4){0.f, 0.f, 0.f, 0.f};
        cur = nxt; cA = nA; cB = nB; ++ui;
        if constexpr (ALIGN_EPI) { if (wr == 1) PG8_BAR; }
    }
    PG8_WAIT_V(0);
    if constexpr (!ALIGN_EPI) { if (wr == 0) PG8_BAR; }
    PG8_BAR;
#undef PG8_BBASE
#undef PG8_ASLICE
#undef PG8_ABASE
#undef PG8_KOFF
#undef PG8_SA
#undef PG8_SB
#undef PG8_STAGE
#undef PG8_LDA
#undef PG8_LDB
#undef PG8_MMA
#undef PG8_WAIT_V
#undef PG8_WAIT_L
#undef PG8_BAR
#undef PG8_SCHED
}
}

#define XB_TMO      128
#define XB_XCNT(j)  (256  + 64 * (j))
#define XB_XSUB(j)  (1280 + 64 * (j))
#define XB_XGEN(j)  (2304 + 64 * (j))
#define XB_TOP      3328
#define XB_TOPGEN   3392
#define XCD_BAR_WORDS 3456
#define XB_SPIN_CAP (1u << 24)

__device__ __forceinline__ unsigned xb_ld(unsigned* p)              { return __hip_atomic_load(p, __ATOMIC_RELAXED, __HIP_MEMORY_SCOPE_AGENT); }
__device__ __forceinline__ unsigned xb_add(unsigned* p, unsigned v) { return __hip_atomic_fetch_add(p, v, __ATOMIC_RELAXED, __HIP_MEMORY_SCOPE_AGENT); }
__device__ __forceinline__ unsigned xb_xcc_id() { return (unsigned)__builtin_amdgcn_s_getreg((3 << 11) | 20) & 0xFu; }
#define XB_SPIN(cond, bar) do { unsigned _sp = 0; while (cond) { __builtin_amdgcn_s_sleep(1); \
    if ((++_sp & 255u) == 0u) { if (xb_ld(&(bar)[XB_TMO])) break; if (_sp > XB_SPIN_CAP) { atomicAdd(&(bar)[XB_TMO], 1u); break; } } } } while (0)

struct XcdBarrier { unsigned* bar; unsigned x; volatile LAS unsigned* st; };

__device__ __forceinline__ XcdBarrier xcd_barrier_post(unsigned* bar, volatile LAS unsigned* st) {
    XcdBarrier b; b.bar = bar; b.x = xb_xcc_id(); b.st = st;
    if (threadIdx.x == 0) (void)xb_add(&bar[XB_XCNT(b.x)], 1u);
    return b;
}
__device__ __forceinline__ void xcd_barrier_complete(unsigned* bar, unsigned x, unsigned& nloc, unsigned& nx) {
    const unsigned G = gridDim.x * gridDim.y * gridDim.z;
    unsigned sum, cnt, mine, sp = 0u;
    for (;;) {
        sum = 0u; cnt = 0u; mine = 0u;
#pragma unroll
        for (unsigned j = 0; j < 16; ++j) { const unsigned c = xb_ld(&bar[XB_XCNT(j)]); sum += c; cnt += (c > 0u) ? 1u : 0u; mine = (j == x) ? c : mine; }
        if (sum == G) break;
        __builtin_amdgcn_s_sleep(1);
        if ((++sp & 255u) == 0u) { if (xb_ld(&bar[XB_TMO])) break; if (sp > XB_SPIN_CAP) { atomicAdd(&bar[XB_TMO], 1u); break; } }
    }
    nloc = mine > 0u ? mine : 1u; nx = cnt > 0u ? cnt : 1u;
}
__device__ __forceinline__ void xcd_barrier(const XcdBarrier& b) {
    asm volatile("s_waitcnt vmcnt(0)" ::: "memory");
    __syncthreads();
    if (threadIdx.x == 0) {
        unsigned* bar = b.bar;
        __builtin_amdgcn_s_waitcnt(0);
        unsigned nloc = b.st[0], nx = b.st[1];
        if (nloc == 0u) { xcd_barrier_complete(bar, b.x, nloc, nx); b.st[0] = nloc; b.st[1] = nx; }
        const unsigned old = xb_add(&bar[XB_XSUB(b.x)], 1u);
        const unsigned gen = old / nloc;
        if (old + 1u == (gen + 1u) * nloc) {
            __builtin_amdgcn_fence(__ATOMIC_RELEASE, "agent");
            asm volatile("s_waitcnt vmcnt(0)" ::: "memory");
            const unsigned og = xb_add(&bar[XB_TOP], 1u);
            const unsigned tg = og / nx;
            if (og + 1u == (tg + 1u) * nx) xb_add(&bar[XB_TOPGEN], 1u);
            else XB_SPIN(xb_ld(&bar[XB_TOPGEN]) == tg, bar);
            __builtin_amdgcn_fence(__ATOMIC_ACQUIRE, "agent");
            xb_add(&bar[XB_XGEN(b.x)], 1u);
            asm volatile("s_waitcnt vmcnt(0)" ::: "memory");
        } else {
            XB_SPIN(xb_ld(&bar[XB_XGEN(b.x)]) == gen, bar);
            __builtin_amdgcn_fence(__ATOMIC_ACQUIRE, "agent");
            asm volatile("s_waitcnt vmcnt(0)" ::: "memory");
        }
    }
    __syncthreads();
}

struct Args { const float* in[53]; float* out; unsigned char* ws; int ph_lo, ph_hi; };

enum { I_X = 0, I_L0F1 = 1, I_L0_MIX_PRE = 6, I_L0_MIX_POST = 7, I_W_IN = 8, I_PE_K = 9, I_W1_K = 10, I_W2_K = 11, I_PE_V = 12, I_W1_V = 13, I_W2_V = 14,
       I_CONV_W = 15, I_CONV_B = 16, I_W_OUT = 17, I_L0F2 = 18, I_L1F1 = 23, I_L1_MIX_PRE = 28, I_L1_MIX_POST = 29, I_MU = 30, I_W_R = 31, I_W_K = 32, I_W_V = 33, I_W_O = 34,
       I_W0 = 35, I_DEC1 = 36, I_DEC2 = 37, I_A0 = 38, I_A1 = 39, I_A2 = 40, I_G1 = 41, I_G2 = 42, I_K_K = 43, I_K_A = 44, I_R_K = 45, I_LNX_G = 46, I_LNX_B = 47, I_L1F2 = 48 };

template <class RM, class SC> __device__ __forceinline__ void convert_t(bf16* dst, int dstK, int koff, const float* src, int Ksrc, int ncol, RM rowmap, SC scale, int gtid, int gsize, LAS unsigned char* lds, int rot = 0) {
    const int lane = gtid & 63, nwv = gsize >> 6, gwv = ((gtid >> 6) + nwv - rot % nwv) % nwv;
    LAS float* scr = (LAS float*)(lds + ((gtid >> 6) & 7) * 8704);
    const int nblk = (ncol + 31) >> 5, nitems = (Ksrc >> 6) * nblk;
    for (int it = gwv; it < nitems; it += nwv) {
        const int kb = it / nblk, nb = it - kb * nblk, k0 = kb * 64, n0 = nb * 32;
        const int nn = n0 + (lane & 31); const bool nok = nn < ncol;
        float v[32];
        const float* sp = src + (size_t)(k0 + (lane >> 5)) * ncol + (nok ? nn : 0);
#pragma unroll
        for (int i = 0; i < 32; ++i) v[i] = sp[(size_t)(2 * i) * ncol];
#pragma unroll
        for (int i = 0; i < 32; ++i) { const int kk = 2 * i + (lane >> 5); scr[kk * 33 + (lane & 31)] = nok ? v[i] * scale(k0 + kk) : 0.f; }
        const int cch = lane & 7;
#pragma unroll
        for (int j = 0; j < 4; ++j) { const int n = (lane >> 3) + 8 * j; const LAS float* s = scr + (8 * cch) * 33 + n;
            u32x4 o; o.x = cvt_pk_bf16(s[0 * 33], s[1 * 33]); o.y = cvt_pk_bf16(s[2 * 33], s[3 * 33]); o.z = cvt_pk_bf16(s[4 * 33], s[5 * 33]); o.w = cvt_pk_bf16(s[6 * 33], s[7 * 33]);
            if (n0 + n < ncol) *(u32x4*)(dst + (size_t)rowmap(n0 + n) * dstK + koff + k0 + 8 * cch) = o; }
    }
}
__device__ __forceinline__ void zero_rows(bf16* dst, size_t nelem, int gtid, int gsize) {
    for (size_t i = (size_t)gtid * 8; i < nelem; i += (size_t)gsize * 8) *(u32x4*)(dst + i) = (u32x4){0u, 0u, 0u, 0u};
}
__device__ __forceinline__ void convert_ffn(const Args& a, int base, int gtid, int gsize, LAS unsigned char* lds) {
    const float* wg = a.in[base + 2]; const float* wu = a.in[base + 3]; const float* wd = a.in[base + 4];
    unsigned char* W = a.ws + WS_W;
    auto one = [](int) { return 1.0f; };
    convert_t((bf16*)(W + W_GU), D, 0, wg, D, FF, [](int n) { return (n >> 7) * 256 + (n & 127); }, one, gtid, gsize, lds, 0);
    convert_t((bf16*)(W + W_GU), D, 0, wu, D, FF, [](int n) { return (n >> 7) * 256 + 128 + (n & 127); }, one, gtid, gsize, lds, 1408);
    convert_t((bf16*)(W + W_DN), FF, 0, wd, FF, D, [](int n) { return n; }, one, gtid, gsize, lds, 2816);
}
__device__ __forceinline__ void convert_mix0(const Args& a, int gtid, int gsize, LAS unsigned char* lds) {
    const float* win = a.in[I_W_IN]; const float* wout = a.in[I_W_OUT];
    unsigned char* W = a.ws + WS_W;
    auto one = [](int) { return 1.0f; };
    convert_t((bf16*)(W + W_IN), D, 0, win, D, 2840, [](int n) { return n < 512 ? n : (n < 536 ? n - 512 + 2816 : n - 24); }, one, gtid, gsize, lds);
    zero_rows((bf16*)(W + W_IN) + (size_t)2840 * D, (size_t)(PROJ_LD - 2840) * D, gtid, gsize);
    convert_t((bf16*)(W + W_OUT), D, 0, wout, D, D, [](int n) { return n; }, one, gtid, gsize, lds);
    convert_t((bf16*)(W + W_CMP), 2048, 0, a.in[I_W1_K], 2048, 128, [](int n) { return n; }, one, gtid, gsize, lds);
    convert_t((bf16*)(W + W_CMP), 2048, 0, a.in[I_W1_V], 2048, 128, [](int n) { return n + 128; }, one, gtid, gsize, lds);
    { const int gw_ = gtid >> 6, ln = gtid & 63; if (gw_ < 256) { const int kv = gw_ >> 7, n = gw_ & 127; const float* pe = a.in[kv ? I_PE_V : I_PE_K]; const float* w1 = a.in[kv ? I_W1_V : I_W1_K];
        float s = 0.f; for (int kk = ln; kk < 2048; kk += 64) s += pe[kk] * w1[(size_t)kk * 128 + n]; s = wave_sum(s); if (ln == 0) ((float*)(a.ws + WS_PEB))[gw_] = s; } }
}
__device__ __forceinline__ void convert_mix1(const Args& a, int gtid, int gsize, LAS unsigned char* lds) {
    const float* mu = a.in[I_MU];
    unsigned char* W = a.ws + WS_W;
    bf16* Wlo = (bf16*)(W + W_LORA); bf16* Wl2 = (bf16*)(W + W_L2);
    auto one = [](int) { return 1.0f; };
    convert_t((bf16*)(W + W_R), D, 0, a.in[I_W_R], D, D, [](int n) { return n; }, one, gtid, gsize, lds, 0);
    convert_t((bf16*)(W + W_K), D, 0, a.in[I_W_K], D, D, [](int n) { return n; }, one, gtid, gsize, lds, 512);
    convert_t((bf16*)(W + W_V), D, 0, a.in[I_W_V], D, D, [](int n) { return n; }, one, gtid, gsize, lds, 1024);
#define CONV_LORA(srcp, ncol, rowoff, mi) \
    convert_t(Wlo, 2 * D, 0, srcp, D, ncol, [](int n) { return n + (rowoff); }, [=](int k) { return 1.0f - mu[(mi) * 1024 + k]; }, gtid, gsize, lds, 1536); \
    convert_t(Wlo, 2 * D, D, srcp, D, ncol, [](int n) { return n + (rowoff); }, [=](int k) { return mu[(mi) * 1024 + k]; }, gtid, gsize, lds, 1700);
    CONV_LORA(a.in[I_DEC1], 64, 0, 1)
    CONV_LORA(a.in[I_A1], 64, 64, 4)
    CONV_LORA(a.in[I_G1], 128, 128, 5)
#undef CONV_LORA
    zero_rows(Wl2, (size_t)EAG_LD * 256, gtid, gsize);
    convert_t((bf16*)(W + W_O), D, 0, a.in[I_W_O], D, D, [](int n) { return n; }, one, gtid, gsize, lds);
}
__device__ __forceinline__ void convert_mix1_l2(const Args& a, int gtid, int gsize, LAS unsigned char* lds) {
    unsigned char* W = a.ws + WS_W; bf16* Wl2 = (bf16*)(W + W_L2);
    auto one = [](int) { return 1.0f; };
    convert_t(Wl2, 256, 0, a.in[I_DEC2], 64, 1024, [](int n) { return n; }, one, gtid, gsize, lds);
    convert_t(Wl2, 256, 64, a.in[I_A2], 64, 1024, [](int n) { return n + 1024; }, one, gtid, gsize, lds);
    convert_t(Wl2, 256, 128, a.in[I_G2], 128, 1024, [](int n) { return n + 2048; }, one, gtid, gsize, lds);
}

template <bool HAS_A, bool TWO, bool WRITE_X, bool HAS_XN>
__device__ __forceinline__ void row_pass(const float* xin, float* xout, const bf16* da, const float* ga, float ca, const bf16* db, const float* gb, float cb, const float* gpre, bf16* xn, int gw, int nw, int lane) {
    f32x4 gA[4], gB[4], gP[4];
#pragma unroll
    for (int j = 0; j < 4; ++j) { if constexpr (HAS_A) gA[j] = *(const f32x4*)(ga + lane * 4 + 256 * j); if constexpr (TWO) gB[j] = *(const f32x4*)(gb + lane * 4 + 256 * j);
        if constexpr (HAS_XN) gP[j] = *(const f32x4*)(gpre + lane * 4 + 256 * j); }
    const bool al = (nw == 2048); const int bxw = gw >> 3;
    const int rbase = al ? (((bxw & 7) * 32 + (bxw >> 3)) * 128 + (gw & 7) * 16) : gw, rstep = al ? 1 : nw;
    for (int k = 0, row = rbase; al ? (k < 16) : (row < M); ++k, row += rstep) {
        f32x4 x[4];
#pragma unroll
        for (int j = 0; j < 4; ++j) x[j] = *(const f32x4*)(xin + (size_t)row * D + lane * 4 + 256 * j);
        if constexpr (HAS_A) {
            f32x4 d[4]; float ss = 0.f;
#pragma unroll
            for (int j = 0; j < 4; ++j) { const u32x2 w = *(const u32x2*)(da + (size_t)row * D + lane * 4 + 256 * j); d[j] = (f32x4){bflo(w.x), bfhi(w.x), bflo(w.y), bfhi(w.y)};
                ss += (d[j].x * d[j].x + d[j].y * d[j].y) + (d[j].z * d[j].z + d[j].w * d[j].w); }
            const float rstd = ca * rsqrtf(wave_sum(ss) * (1.0f / D) + EPS);
#pragma unroll
            for (int j = 0; j < 4; ++j) x[j] = x[j] + d[j] * gA[j] * rstd;
        }
        if constexpr (TWO) {
            f32x4 d[4]; float ss = 0.f;
#pragma unroll
            for (int j = 0; j < 4; ++j) { const u32x2 w = *(const u32x2*)(db + (size_t)row * D + lane * 4 + 256 * j); d[j] = (f32x4){bflo(w.x), bfhi(w.x), bflo(w.y), bfhi(w.y)};
                ss += (d[j].x * d[j].x + d[j].y * d[j].y) + (d[j].z * d[j].z + d[j].w * d[j].w); }
            const float rstd = cb * rsqrtf(wave_sum(ss) * (1.0f / D) + EPS);
#pragma unroll
            for (int j = 0; j < 4; ++j) x[j] = x[j] + d[j] * gB[j] * rstd;
        }
        if constexpr (WRITE_X) {
#pragma unroll
            for (int j = 0; j < 4; ++j) *(f32x4*)(xout + (size_t)row * D + lane * 4 + 256 * j) = x[j];
        }
        if constexpr (HAS_XN) {
            float ss = 0.f;
#pragma unroll
            for (int j = 0; j < 4; ++j) ss += (x[j].x * x[j].x + x[j].y * x[j].y) + (x[j].z * x[j].z + x[j].w * x[j].w);
            const float rstd = rsqrtf(wave_sum(ss) * (1.0f / D) + EPS);
            const size_t prow = (size_t)row + (row >= SEQ ? 2 : 1);
#pragma unroll
            for (int j = 0; j < 4; ++j) { const f32x4 y = x[j] * gP[j] * rstd;
                u32x2 w; w.x = cvt_pk_bf16(y.x, y.y); w.y = cvt_pk_bf16(y.z, y.w); *(u32x2*)(xn + prow * D + lane * 4 + 256 * j) = w; }
        }
    }
    if constexpr (HAS_XN) { if (blockIdx.x == 0) { const int t = threadIdx.x; if (t < 256) { u32x4 z = (u32x4){0u, 0u, 0u, 0u}; const size_t prow = (t < 128) ? 0 : (size_t)SEQ + 1; *(u32x4*)(xn + prow * D + (t & 127) * 8) = z; } } }
}

__device__ __forceinline__ void rwkv_mix_phase(const Args& a, int gtid, int gsize) {
    const bf16* xn = (const bf16*)(a.ws + WS_XN); const float* mu = a.in[I_MU];
    bf16* xr = (bf16*)(a.ws + WS_XR); bf16* xk = (bf16*)(a.ws + WS_XK); bf16* xv = (bf16*)(a.ws + WS_XV);
    const int c8 = gtid & 127, tl = gtid >> 7, nl = gsize >> 7, run = (M + nl - 1) / nl;
    float mr[8], mk[8], mv[8];
    { const float* m = mu + c8 * 8;
#pragma unroll
      for (int j = 0; j < 8; ++j) { mr[j] = m[j]; mk[j] = m[2 * 1024 + j]; mv[j] = m[3 * 1024 + j]; } }
    int t_beg = tl * run;
    if (gsize == 256 * 512) { const int bxw = gtid >> 9; t_beg = ((bxw & 7) * 32 + (bxw >> 3)) * 128 + ((gtid >> 7) & 3) * 32; }
    const int t_end = (t_beg + run < M) ? t_beg + run : M;
    u32x4 pw = (u32x4){0u, 0u, 0u, 0u};
    if (t_beg < t_end) { const size_t prow0 = (size_t)t_beg + (t_beg >= SEQ ? 2 : 1); pw = *(const u32x4*)(xn + (prow0 - 1) * D + c8 * 8); }
    for (int tok = t_beg; tok < t_end; ++tok) {
        const size_t prow = (size_t)tok + (tok >= SEQ ? 2 : 1);
        if ((tok & (SEQ - 1)) == 0) pw = (u32x4){0u, 0u, 0u, 0u};
        const u32x4 hw = *(const u32x4*)(xn + prow * D + c8 * 8);
        const float h[8] = {bflo(hw.x), bfhi(hw.x), bflo(hw.y), bfhi(hw.y), bflo(hw.z), bfhi(hw.z), bflo(hw.w), bfhi(hw.w)};
        const float p[8] = {bflo(pw.x), bfhi(pw.x), bflo(pw.y), bfhi(pw.y), bflo(pw.z), bfhi(pw.z), bflo(pw.w), bfhi(pw.w)};
#define MIX_ONE(mm, dstp) do { float o[8]; \
            _Pragma("unroll") for (int j = 0; j < 8; ++j) o[j] = h[j] + (p[j] - h[j]) * mm[j]; \
            u32x4 w; w.x = cvt_pk_bf16(o[0], o[1]); w.y = cvt_pk_bf16(o[2], o[3]); w.z = cvt_pk_bf16(o[4], o[5]); w.w = cvt_pk_bf16(o[6], o[7]); \
            *(u32x4*)((dstp) + (size_t)tok * D + c8 * 8) = w; } while (0)
        MIX_ONE(mr, xr); MIX_ONE(mk, xk); MIX_ONE(mv, xv);
#undef MIX_ONE
        pw = hw;
    }
}

constexpr int CMP_SPLIT = 8;
__device__ __forceinline__ void compress_stage2(const Args& a, int gw, int nw, int lane) {
    const float* part = (const float*)(a.ws + WS_XN); const float* peb = (const float*)(a.ws + WS_PEB);
    for (int m = gw; m < 8192; m += nw) {
        const int kv = m >> 12, mm = m & 4095, g = mm & 1, i = (mm >> 1) & 1023, b = mm >> 11;
        if (i >= NCMP) continue;
        float h0 = peb[kv * 128 + lane], h1 = peb[kv * 128 + 64 + lane];
#pragma unroll
        for (int s = 0; s < CMP_SPLIT; ++s) { const float* p = part + ((size_t)s * 8192 + m) * 128; h0 += p[lane]; h1 += p[64 + lane]; }
        { const float u0 = 0.7978845608028654f * (h0 + 0.044715f * h0 * h0 * h0), u1 = 0.7978845608028654f * (h1 + 0.044715f * h1 * h1 * h1);
          h0 = 0.5f * h0 * (2.0f - 2.0f * __builtin_amdgcn_rcpf(__expf(2.0f * u0) + 1.0f)); h1 = 0.5f * h1 * (2.0f - 2.0f * __builtin_amdgcn_rcpf(__expf(2.0f * u1) + 1.0f)); }
        const float* w2 = a.in[kv ? I_W2_V : I_W2_K];
        float o0 = 0.f, o1 = 0.f;
#pragma unroll
        for (int n = 0; n < 64; ++n) { o0 = fmaf(__int_as_float(__builtin_amdgcn_readlane(__float_as_int(h0), n)), w2[n * 64 + lane], o0); o1 = fmaf(__int_as_float(__builtin_amdgcn_readlane(__float_as_int(h1), n)), w2[(64 + n) * 64 + lane], o1); }
        bf16* dst = (bf16*)(a.ws + (kv ? WS_VC : WS_KC)); dst[((size_t)(b * NCMP + i) * 2 + g) * 64 + lane] = f2bf(o0 + o1);
    }
}

typedef float f32x16 __attribute__((ext_vector_type(16)));
typedef short s16x4 __attribute__((ext_vector_type(4)));
constexpr int NK_KS = 144, NK_VS = 144;
constexpr int NL_K = 0, NL_V = 2 * 128 * NK_KS, NL_IMP = NL_V + 2 * 128 * NK_VS, NL_SELM = NL_IMP + 64 * 264 * 4, NL_UN = NL_SELM + 64 * 8 * 4, NL_ULIST = NL_UN + 72 * 4, NL_END = NL_ULIST + 260 * 4;
static_assert(NL_END <= LDS_CTL_OFF, "NSA LDS map");
constexpr float LOG2E = 1.4426950408889634f;

struct SmState { float m, l; f32x16 o0, o1; };
struct TileSrc { const bf16* k; const bf16* v; int stride; int nvalid; };

__device__ __forceinline__ void tile_load(const TileSrc& s, int tid, u32x4& kr, u32x4& vr) {
    const int row = tid >> 3, chk = tid & 7;
    if (row < s.nvalid) { kr = *(const u32x4*)(s.k + (size_t)row * s.stride + chk * 8); if (s.v) vr = *(const u32x4*)(s.v + (size_t)row * s.stride + chk * 8); }
    else { kr = (u32x4){0u, 0u, 0u, 0u}; vr = (u32x4){0u, 0u, 0u, 0u}; }
}
__device__ __forceinline__ void tile_store(LAS unsigned char* kb, LAS unsigned char* vb, int tid, const u32x4& kr, const u32x4& vr) {
    const int row = tid >> 3, chk = tid & 7;
    *(LAS u32x4*)(kb + row * NK_KS + chk * 16) = kr; *(LAS u32x4*)(vb + row * NK_VS + chk * 16) = vr;
    if (chk == 0) *(LAS u32x4*)(kb + row * NK_KS + 128) = (u32x4){cvt_pk_bf16((float)row, 0.f), 0u, 0u, 0u};
}
__device__ __forceinline__ void qk64(const LAS unsigned char* kb, int lane, const bf16x8 (&qf)[4], unsigned qx0, int lo, int hi, bool allvalid, f32x16& a0, f32x16& a1) {
#pragma unroll
    for (int e = 0; e < 16; ++e) { a0[e] = 0.f; a1[e] = 0.f; }
    const int c32 = lane & 31, h = lane >> 5;
    const LAS unsigned char* kp = kb + c32 * NK_KS + h * 16;
#pragma unroll
    for (int ks = 0; ks < 4; ++ks) { const bf16x8 k0 = *(const LAS bf16x8*)(kp + ks * 32), k1 = *(const LAS bf16x8*)(kp + 32 * NK_KS + ks * 32);
        a0 = __builtin_amdgcn_mfma_f32_32x32x16_bf16(k0, qf[ks], a0, 0, 0, 0); a1 = __builtin_amdgcn_mfma_f32_32x32x16_bf16(k1, qf[ks], a1, 0, 0, 0); }
    { const bf16x8 k0 = *(const LAS bf16x8*)(kb + c32 * NK_KS + 128), k1 = *(const LAS bf16x8*)(kb + (32 + c32) * NK_KS + 128);
      union { u32x4 u; bf16x8 b; } qx; qx.u = (u32x4){(lane < 32) ? qx0 : 0u, 0u, 0u, 0u};
      a0 = __builtin_amdgcn_mfma_f32_32x32x16_bf16(k0, qx.b, a0, 0, 0, 0); a1 = __builtin_amdgcn_mfma_f32_32x32x16_bf16(k1, qx.b, a1, 0, 0, 0); }
    if (!allvalid) {
        if (hi < lo) { lo = 1000; hi = 1000; }
        const unsigned span = (unsigned)(hi - lo); const int l0 = lo - 4 * h, l1 = lo - 4 * h - 32;
#pragma unroll
        for (int e = 0; e < 16; ++e) { const int ce = (e & 3) + 8 * (e >> 2);
            a0[e] = ((unsigned)(ce - l0) <= span) ? a0[e] : -INFINITY; a1[e] = ((unsigned)(ce - l1) <= span) ? a1[e] : -INFINITY; }
    }
}
__device__ __forceinline__ void tile64(const LAS unsigned char* kb, const LAS unsigned char* vb, int lane, const bf16x8 (&qf)[4], unsigned qx0, int lo, int hi, bool allvalid, float C1, float tc2, SmState& st) {
    f32x16 a0, a1;
    qk64(kb, lane, qf, qx0, lo, hi, allvalid, a0, a1);
    float tmax = fmaxf(a0[0], a1[0]);
#pragma unroll
    for (int e = 1; e < 16; ++e) tmax = fmaxf(tmax, fmaxf(a0[e], a1[e]));
    tmax = xor32_max(fmaf(tmax, C1, tc2));
    const float mn = fmaxf(st.m, tmax);
    if (!__all(mn == st.m)) { const float al = __builtin_amdgcn_exp2f(st.m - mn); st.l *= al; st.m = mn;
#pragma unroll
        for (int e = 0; e < 16; ++e) { st.o0[e] *= al; st.o1[e] *= al; } }
    float ps = 0.f; const float off = tc2 - st.m;
#pragma unroll
    for (int e = 0; e < 16; ++e) { a0[e] = __builtin_amdgcn_exp2f(fmaf(a0[e], C1, off)); a1[e] = __builtin_amdgcn_exp2f(fmaf(a1[e], C1, off)); ps += a0[e] + a1[e]; }
    st.l += ps;
    const int i16 = lane & 15, g4 = lane >> 4;
    const LAS unsigned char* vp = vb + (4 * (g4 >> 1) + (i16 >> 2)) * NK_VS + (16 * (g4 & 1) + 4 * (i16 & 3)) * 2;
#pragma unroll
    for (int hf = 0; hf < 2; ++hf)
#pragma unroll
        for (int sk = 0; sk < 2; ++sk) {
            const f32x16& pp = hf ? a1 : a0;
            bf16x8 pf; { union { u32x4 u; bf16x8 b; } cv; cv.u.x = cvt_pk_bf16(pp[8 * sk + 0], pp[8 * sk + 1]); cv.u.y = cvt_pk_bf16(pp[8 * sk + 2], pp[8 * sk + 3]); cv.u.z = cvt_pk_bf16(pp[8 * sk + 4], pp[8 * sk + 5]); cv.u.w = cvt_pk_bf16(pp[8 * sk + 6], pp[8 * sk + 7]); pf = cv.b; }
#pragma unroll
            for (int dt = 0; dt < 2; ++dt) {
                const s16x4 v0 = __builtin_amdgcn_ds_read_tr16_b64_v4i16((LAS s16x4*)(vp + (32 * hf + 16 * sk) * NK_VS + dt * 64));
                const s16x4 v1 = __builtin_amdgcn_ds_read_tr16_b64_v4i16((LAS s16x4*)(vp + (32 * hf + 16 * sk + 8) * NK_VS + dt * 64));
                const bf16x8 vf = (bf16x8){v0.x, v0.y, v0.z, v0.w, v1.x, v1.y, v1.z, v1.w};
                if (dt == 0) st.o0 = __builtin_amdgcn_mfma_f32_32x32x16_bf16(vf, pf, st.o0, 0, 0, 0);
                else st.o1 = __builtin_amdgcn_mfma_f32_32x32x16_bf16(vf, pf, st.o1, 0, 0, 0);
            }
        }
}
__device__ __forceinline__ int imp_idx(int token, int j) { return token * 264 + (j >> 5) * 33 + (j & 31); }

#ifndef NSA_DUP
#define NSA_DUP 0
#endif
#define NSA_REP(bit) for (int rep_ = 0; rep_ < ((NSA_DUP >> (bit)) & 1) + 1; ++rep_)
__device__ __forceinline__ void nsa_mfma_phase(const Args& a, LAS unsigned char* lds) {
    const int tid0 = threadIdx.x, wave = __builtin_amdgcn_readfirstlane(tid0 >> 6);
    const bf16* proj = (const bf16*)(a.ws + WS_BIG);
    const bf16* KC = (const bf16*)(a.ws + WS_KC); const bf16* VC = (const bf16*)(a.ws + WS_VC);
    bf16* att = (bf16*)(a.ws + WS_ATT);
    LAS float* IMP = (LAS float*)(lds + NL_IMP); LAS unsigned* SELM = (LAS unsigned*)(lds + NL_SELM); LAS unsigned* UN = (LAS unsigned*)(lds + NL_UN); LAS int* ULIST = (LAS int*)(lds + NL_ULIST);
    const int G = gridDim.x;
    for (int ui = 0; ; ++ui) {
        const int u = ui * G + blockIdx.x; if (u >= NB * 2 * (SEQ / 64)) break;
        int tid = tid0; asm volatile("" : "+v"(tid));
        const int lane = tid & 63, h = lane >> 5, c32 = lane & 31, tl = c32 >> 2, r = c32 & 3;
        const int bg = u >> 8, tsw = ((u & 7) << 5) | ((u & 255) >> 3), tile = (bg & 1) ? 255 - tsw : tsw, b = bg >> 1, g = bg & 1;
        const int t0 = tile * 64, tokl = wave * 8 + tl, t = t0 + tokl;
        const size_t tok = (size_t)b * SEQ + t;
        const float slope = exp2f(-(float)(g * 4 + r + 1)), sl2 = slope * LOG2E, C1 = 0.125f * LOG2E;
        const unsigned qx_one = cvt_pk_bf16(8.0f * slope, 0.f), qx_cmp = cvt_pk_bf16(128.0f * slope, 0.f);
        bf16x8 qf[4];
#pragma unroll
        for (int ks = 0; ks < 4; ++ks) qf[ks] = *(const bf16x8*)(proj + tok * PROJ_LD + PC_Q + (g * 4 + r) * 64 + ks * 16 + h * 8);
        f32x16 out0, out1;
#pragma unroll
        for (int e = 0; e < 16; ++e) { out0[e] = 0.f; out1[e] = 0.f; }
        SmState st;
        u32x4 kr, vr, kr2, vr2;
#define NSA_STATE_INIT() do { st.m = -1e30f; st.l = 0.f; _Pragma("unroll") for (int e = 0; e < 16; ++e) { st.o0[e] = 0.f; st.o1[e] = 0.f; } } while (0)
#define NSA_STATE_FOLD(gi) do { const float lt = xor32_sum(st.l); const float gt_ = sigmoidf_(bf2f(proj[((size_t)b * SEQ + t) * PROJ_LD + PC_G + (g * 4 + r) * 3 + (gi)])); const float sc_ = gt_ / fmaxf(lt, 1e-30f); _Pragma("unroll") for (int e = 0; e < 16; ++e) { out0[e] += st.o0[e] * sc_; out1[e] += st.o1[e] * sc_; } } while (0)
#define NSA_KB(i) (lds + NL_K + ((((i) >> 1) & 1) * 128 + ((i) & 1) * 64) * NK_KS)
#define NSA_VB(i) (lds + NL_V + ((((i) >> 1) & 1) * 128 + ((i) & 1) * 64) * NK_VS)
#define NSA_PIPE(N, SRC, ...) do { const int n_ = (N); \
        tile_load(SRC(0), tid, kr, vr); tile_store(NSA_KB(0), NSA_VB(0), tid, kr, vr); \
        if (1 < n_) { tile_load(SRC(1), tid, kr, vr); tile_store(NSA_KB(1), NSA_VB(1), tid, kr, vr); } \
        __syncthreads(); \
        if (2 < n_) tile_load(SRC(2), tid, kr, vr); \
        if (3 < n_) tile_load(SRC(3), tid, kr2, vr2); \
        for (int ip_ = 0; 2 * ip_ < n_; ++ip_) { \
            { const int i = 2 * ip_; __VA_ARGS__ } \
            if (2 * ip_ + 1 < n_) { const int i = 2 * ip_ + 1; __VA_ARGS__ } \
            if (2 * ip_ + 2 < n_) tile_store(NSA_KB(2 * ip_ + 2), NSA_VB(2 * ip_ + 2), tid, kr, vr); \
            if (2 * ip_ + 3 < n_) tile_store(NSA_KB(2 * ip_ + 3), NSA_VB(2 * ip_ + 3), tid, kr2, vr2); \
            __syncthreads(); \
            if (2 * ip_ + 4 < n_) tile_load(SRC(2 * ip_ + 4), tid, kr, vr); \
            if (2 * ip_ + 5 < n_) tile_load(SRC(2 * ip_ + 5), tid, kr2, vr2); \
        } } while (0)
        const int ntc = (4 * tile + 3 + 63) >> 6;
        auto cmp_src = [&](int i) { const int n0 = 64 * (ntc - 1 - i); TileSrc s; s.k = KC + ((size_t)(b * NCMP + n0) * 2 + g) * 64; s.v = VC + ((size_t)(b * NCMP + n0) * 2 + g) * 64; s.stride = 128; s.nvalid = NCMP - n0; return s; };
        float m_cmp, invl_cmp;
        NSA_REP(0) {
            NSA_STATE_INIT();
            __syncthreads();
            NSA_PIPE(ntc, cmp_src, { const int n0 = 64 * (ntc - 1 - i); const int hi = (t - 31 - 16 * n0) >> 4; const bool allv = __all(hi >= 63);
                tile64(NSA_KB(i), NSA_VB(i), lane, qf, qx_cmp, 0, hi, allv, C1, sl2 * (float)(16 * n0 + 31 - t), st); });
            const float lt = xor32_sum(st.l);
            m_cmp = st.m; invl_cmp = 1.0f / fmaxf(lt, 1e-30f);
        }
        NSA_STATE_FOLD(0);
        if (tile >= 16) {
            NSA_REP(1) {
            auto cmpk_src = [&](int i) { TileSrc s = cmp_src(i); s.v = nullptr; return s; };
            NSA_PIPE(ntc, cmpk_src, { const int n0 = 64 * (ntc - 1 - i); const int hi = (t - 31 - 16 * n0) >> 4;
                  f32x16 a0, a1; qk64(NSA_KB(i), lane, qf, qx_cmp, 0, hi, false, a0, a1);
                  const float off2 = sl2 * (float)(16 * n0 + 31 - t) - m_cmp;
                  float mv[8], hv[8];
                  _Pragma("unroll") for (int hf = 0; hf < 2; ++hf)
                    _Pragma("unroll") for (int gq = 0; gq < 4; ++gq) {
                        const f32x16& s = hf ? a1 : a0;
                        const float p0 = __builtin_amdgcn_exp2f(fmaf(s[4 * gq], C1, off2)) * invl_cmp, p1 = __builtin_amdgcn_exp2f(fmaf(s[4 * gq + 1], C1, off2)) * invl_cmp,
                                    p2 = __builtin_amdgcn_exp2f(fmaf(s[4 * gq + 2], C1, off2)) * invl_cmp, p3 = __builtin_amdgcn_exp2f(fmaf(s[4 * gq + 3], C1, off2)) * invl_cmp;
                        float mainv = ((p0 + p1) + p2) + 0.5f * p3, halfv = 0.5f * p3;
                        mainv += dpp_mov<0xB1>(mainv); mainv += dpp_mov<0x4E>(mainv); halfv += dpp_mov<0xB1>(halfv); halfv += dpp_mov<0x4E>(halfv);
                        mv[4 * hf + gq] = mainv; hv[4 * hf + gq] = halfv; }
                  _Pragma("unroll") for (int q = 0; q < 8; ++q) {
                        auto rr = __builtin_amdgcn_permlane32_swap(__float_as_uint(q ? hv[q - 1] : 0.f), __float_as_uint(hv[q]), false, false);
                        const float tot = mv[q] + __uint_as_float(h ? rr[0] : rr[1]);
                        const int j = (n0 >> 2) + 2 * q + h;
                        if (r == 0 && j < NSLC) IMP[imp_idx(tokl, j)] = tot; }
                  if (i > 0 && h == 1 && r == 0) { const int jn = (n0 >> 2) + 16; if (jn < NSLC) IMP[imp_idx(tokl, jn)] += hv[7]; } });
            }
            NSA_REP(2) {
                const int ttl = lane >> 3, sl = lane & 7, tk = wave * 8 + ttl;
                float cand[32];
#pragma unroll
                for (int i = 0; i < 32; ++i) { const int j = 32 * sl + i; const float v = IMP[tk * 264 + sl * 33 + i]; const bool forced = (j == 0) || (j == tile) || (j == tile - 1); cand[i] = (j <= tile && !forced) ? v : -1.0f; }
                float top[13];
#pragma unroll
                for (int q = 0; q < 13; ++q) top[q] = -1.0f;
#pragma unroll
                for (int i = 0; i < 32; ++i) { const float x = cand[i];
#pragma unroll
                    for (int q = 12; q >= 1; --q) top[q] = __builtin_amdgcn_fmed3f(top[q - 1], top[q], x);
                    top[0] = fmaxf(top[0], x); }
#define NSA_MERGE(CTRL) do { float oth[13]; _Pragma("unroll") for (int q = 0; q < 13; ++q) oth[q] = dpp_mov<CTRL>(top[q]); \
                    _Pragma("unroll") for (int i = 0; i < 13; ++i) { const float x = oth[i]; _Pragma("unroll") for (int q = 12; q >= 1; --q) top[q] = __builtin_amdgcn_fmed3f(top[q - 1], top[q], x); top[0] = fmaxf(top[0], x); } } while (0)
                NSA_MERGE(0xB1); NSA_MERGE(0x4E); NSA_MERGE(0x141);
#undef NSA_MERGE
                const float T = top[12];
                unsigned bgt = 0u, beq = 0u, bforced = 0u;
#pragma unroll
                for (int i = 0; i < 32; ++i) { const int j = 32 * sl + i; if (cand[i] > T) bgt |= 1u << i; if (cand[i] == T) beq |= 1u << i; if ((j == 0) || (j == tile) || (j == tile - 1)) bforced |= 1u << i; }
                int cgt = __popc(bgt); cgt += dpp_movi<0xB1>(cgt); cgt += dpp_movi<0x4E>(cgt); cgt += dpp_movi<0x141>(cgt);
                const int need_eq = 13 - cgt;
                int ce_inc = __popc(beq);
#pragma unroll
                for (int d = 1; d < 8; d <<= 1) { const int y = __shfl_up(ce_inc, d); if (sl >= d) ce_inc += y; }
                const int before = ce_inc - __popc(beq);
                int ntake = need_eq - before; ntake = ntake < 0 ? 0 : ntake;
                unsigned keep = 0u, mm = beq;
                for (int q = 0; q < ntake && mm; ++q) { const unsigned low = mm & (0u - mm); keep |= low; mm ^= low; }
                const unsigned mask = bgt | keep | bforced;
                SELM[tk * 8 + sl] = mask;
                unsigned um = mask; um |= __shfl_xor(um, 8); um |= __shfl_xor(um, 16); um |= __shfl_xor(um, 32);
                if (lane < 8) UN[wave * 8 + lane] = um;
            }
        } else {
            if (tid < 64 * 8) { const unsigned mask = ((tid & 7) == 0) ? ((1u << (tile + 1)) - 1u) : 0u; SELM[tid] = mask; if (tid < 64) UN[tid] = ((tid & 7) == 0) ? mask : 0u; }
        }
        __syncthreads();
        if (tid < 256) {
            unsigned um[8]; int above = 0, total = 0;
#pragma unroll
            for (int d = 0; d < 8; ++d) { unsigned x = 0u;
#pragma unroll
                for (int w = 0; w < 8; ++w) x |= UN[w * 8 + d];
                um[d] = x; total += __popc(x); }
            const int dj = tid >> 5, bj = tid & 31; unsigned mine = 0u;
#pragma unroll
            for (int d = 0; d < 8; ++d) { if (d > dj) above += __popc(um[d]); if (d == dj) mine = um[d]; }
            above += __popc(bj == 31 ? 0u : (mine >> (bj + 1)));
            if ((mine >> bj) & 1u) ULIST[1 + above] = tid;
            if (tid == 0) ULIST[0] = total;
        }
        __syncthreads();
        {
            const int nu = __builtin_amdgcn_readfirstlane(ULIST[0]);
            auto slc_src = [&](int i) { const int j = ULIST[1 + i]; TileSrc s; s.k = proj + ((size_t)b * SEQ + 64 * j) * PROJ_LD + PC_KS + g * 64; s.v = proj + ((size_t)b * SEQ + 64 * j) * PROJ_LD + PC_VS + g * 64; s.stride = PROJ_LD; s.nvalid = 64; return s; };
            NSA_REP(3) {
            NSA_STATE_INIT();
            NSA_PIPE(nu, slc_src, { const int j = __builtin_amdgcn_readfirstlane(ULIST[1 + i]);
                const bool sel = (SELM[tokl * 8 + (j >> 5)] >> (j & 31)) & 1u;
                if (__any(sel)) { const int hi = sel ? (t - 64 * j) : -1; const bool allv = __all(hi >= 63);
                    tile64(NSA_KB(i), NSA_VB(i), lane, qf, qx_one, 0, hi, allv, C1, sl2 * (float)(64 * j - t), st); } });
            }
            NSA_STATE_FOLD(1);
        }
        {
            const int nwt = tile + 1 < 9 ? tile + 1 : 9;
            auto win_src = [&](int i) { const int j = tile - i; TileSrc s; s.k = proj + ((size_t)b * SEQ + 64 * j) * PROJ_LD + PC_KW + g * 64; s.v = proj + ((size_t)b * SEQ + 64 * j) * PROJ_LD + PC_VW + g * 64; s.stride = PROJ_LD; s.nvalid = 64; return s; };
            NSA_REP(4) {
            NSA_STATE_INIT();
            NSA_PIPE(nwt, win_src, { const int j = tile - i; const int hi = t - 64 * j, lo = t - 511 - 64 * j; const bool allv = __all(hi >= 63 && lo <= 0);
                tile64(NSA_KB(i), NSA_VB(i), lane, qf, qx_one, lo, hi, allv, C1, sl2 * (float)(64 * j - t), st); });
            }
            NSA_STATE_FOLD(2);
        }
#pragma unroll
        for (int dt = 0; dt < 2; ++dt)
#pragma unroll
            for (int gq = 0; gq < 4; ++gq) {
                const f32x16& o = dt ? out1 : out0;
                u32x2 w; w.x = cvt_pk_bf16(o[4 * gq], o[4 * gq + 1]); w.y = cvt_pk_bf16(o[4 * gq + 2], o[4 * gq + 3]);
                *(u32x2*)(att + tok * D + (g * 4 + r) * 64 + 32 * dt + 8 * gq + 4 * h) = w;
            }
#undef NSA_STATE_INIT
#undef NSA_STATE_FOLD
#undef NSA_KB
#undef NSA_VB
#undef NSA_PIPE
    }
    NSA_REP(5) {
        const float* cw = a.in[I_CONV_W]; const float* cbias = a.in[I_CONV_B];
        const int gt = blockIdx.x * 512 + tid0, gs = gridDim.x * 512;
        const int c0 = (gt & 63) * 8, tl = gt >> 6;
        constexpr int run = M / (256 * 8);
        if (gs == 256 * 512) {
        const f32x4 w0a = *(const f32x4*)(cw + c0), w0b = *(const f32x4*)(cw + c0 + 4), w1a = *(const f32x4*)(cw + 512 + c0), w1b = *(const f32x4*)(cw + 512 + c0 + 4),
                    w2a = *(const f32x4*)(cw + 1024 + c0), w2b = *(const f32x4*)(cw + 1024 + c0 + 4), bsa = *(const f32x4*)(cbias + c0), bsb = *(const f32x4*)(cbias + c0 + 4);
        const int t_beg = tl * run;
        const f32x4 zero4 = (f32x4){0.f, 0.f, 0.f, 0.f};
        f32x4 z0a = zero4, z0b = zero4, z1a = zero4, z1b = zero4;
#define CONV_U(S_, A, B) do { const u32x4 s_ = (S_); A = (f32x4){bflo(s_.x), bfhi(s_.x), bflo(s_.y), bfhi(s_.y)}; B = (f32x4){bflo(s_.z), bfhi(s_.z), bflo(s_.w), bfhi(s_.w)}; } while (0)
#define CONV_Z(A, B, tokn_) do { const bf16* p_ = proj + (size_t)(tokn_) * PROJ_LD; const u32x4 cc = *(const u32x4*)(p_ + PC_CC + c0), cu = *(const u32x4*)(p_ + PC_CU + c0); \
            f32x4 ca_, cb_, ua_, ub_; CONV_U(cc, ca_, cb_); CONV_U(cu, ua_, ub_); A = ca_ * ua_; B = cb_ * ub_; } while (0)
        if (t_beg < M) { const int tt = t_beg & (SEQ - 1); if (tt >= 2) CONV_Z(z0a, z0b, t_beg - 2); if (tt >= 1) CONV_Z(z1a, z1b, t_beg - 1); }
        for (int k = 0; k < run; ++k) {
            const int tokn = t_beg + k; if (tokn >= M) continue;
            if ((tokn & (SEQ - 1)) == 0) { z0a = zero4; z0b = zero4; z1a = zero4; z1b = zero4; }
            f32x4 z2a, z2b; CONV_Z(z2a, z2b, tokn);
            const u32x4 cbv = *(const u32x4*)(proj + (size_t)tokn * PROJ_LD + PC_CB + c0);
            f32x4 ga_, gb_; CONV_U(cbv, ga_, gb_);
            const f32x4 oa = ga_ * (bsa + w2a * z2a + w1a * z1a + w0a * z0a), ob = gb_ * (bsb + w2b * z2b + w1b * z1b + w0b * z0b);
            z0a = z1a; z0b = z1b; z1a = z2a; z1b = z2b;
            u32x4 w; w.x = cvt_pk_bf16(oa.x, oa.y); w.y = cvt_pk_bf16(oa.z, oa.w); w.z = cvt_pk_bf16(ob.x, ob.y); w.w = cvt_pk_bf16(ob.z, ob.w);
            *(u32x4*)(att + (size_t)tokn * D + 512 + c0) = w;
        }
#undef CONV_Z
#undef CONV_U
        } else {
        for (int idx = gt; idx < M * 64; idx += gs) {
            const int c0 = (idx & 63) * 8; const int tokn = idx >> 6, tt = tokn & (SEQ - 1);
            const bf16* p = proj + (size_t)tokn * PROJ_LD;
            float z[3][8];
#pragma unroll
            for (int k = 0; k < 3; ++k) {
                if (tt >= 2 - k) { const u32x4 cc = *(const u32x4*)(p + PC_CC + c0 - (2 - k) * PROJ_LD), cu = *(const u32x4*)(p + PC_CU + c0 - (2 - k) * PROJ_LD);
                    z[k][0] = bflo(cc.x) * bflo(cu.x); z[k][1] = bfhi(cc.x) * bfhi(cu.x); z[k][2] = bflo(cc.y) * bflo(cu.y); z[k][3] = bfhi(cc.y) * bfhi(cu.y);
                    z[k][4] = bflo(cc.z) * bflo(cu.z); z[k][5] = bfhi(cc.z) * bfhi(cu.z); z[k][6] = bflo(cc.w) * bflo(cu.w); z[k][7] = bfhi(cc.w) * bfhi(cu.w); }
                else {
#pragma unroll
                    for (int j = 0; j < 8; ++j) z[k][j] = 0.f; }
            }
            const u32x4 cbv = *(const u32x4*)(p + PC_CB + c0);
            const float cbf[8] = {bflo(cbv.x), bfhi(cbv.x), bflo(cbv.y), bfhi(cbv.y), bflo(cbv.z), bfhi(cbv.z), bflo(cbv.w), bfhi(cbv.w)};
            float o[8];
#pragma unroll
            for (int j = 0; j < 8; ++j) { float y = cbias[c0 + j] + cw[2 * 512 + c0 + j] * z[2][j]; y += cw[512 + c0 + j] * z[1][j]; y += cw[c0 + j] * z[0][j]; o[j] = cbf[j] * y; }
            u32x4 w; w.x = cvt_pk_bf16(o[0], o[1]); w.y = cvt_pk_bf16(o[2], o[3]); w.z = cvt_pk_bf16(o[4], o[5]); w.w = cvt_pk_bf16(o[6], o[7]);
            *(u32x4*)(att + (size_t)tokn * D + 512 + c0) = w;
        }
        }
    }
}

constexpr int SC_NCH = 64, SC_L = SEQ / SC_NCH, SC_NT = NB * 16 * SC_NCH;
constexpr int SM_L = 16;
constexpr int SM_RS = 144, SM_TS = 48;
constexpr int SM_AK = 0, SM_BH = 2304, SM_KH = 4608, SM_RH = 6912, SM_VV = 9216, SM_GAB = 11520, SM_GAK = 12672, SM_HRB = 13440, SM_HRK = 14208, SM_TT = 14976,
              SM_CL = 15744, SM_SS = 16000, SM_RK = 16064, SM_WAVE = 16128, SM_T1 = 0, SM_T2 = 16 * 65 * 4;
static_assert(2 * 16 * 65 * 4 <= SM_GAB, "MFMA scan LDS overlay");
static_assert(8 * SM_WAVE <= LDS_CTL_OFF, "MFMA scan LDS");
__device__ __forceinline__ bf16x8 sm_acc_hi(const f32x16& x, int ks) {
    union { u32x4 u; bf16x8 b; } c; c.u = (u32x4){cvt_pk_bf16(x[8 * ks], x[8 * ks + 1]), cvt_pk_bf16(x[8 * ks + 2], x[8 * ks + 3]), cvt_pk_bf16(x[8 * ks + 4], x[8 * ks + 5]), cvt_pk_bf16(x[8 * ks + 6], x[8 * ks + 7])}; return c.b; }
__device__ __forceinline__ bf16x8 sm_a_perm(const LAS unsigned char* tile, int rs, int row, int k0, int h) {
    const u32x2 lo = *(const LAS u32x2*)(tile + row * rs + (k0 + 4 * h) * 2), hi = *(const LAS u32x2*)(tile + row * rs + (k0 + 8 + 4 * h) * 2);
    union { u32x4 u; bf16x8 b; } c; c.u = (u32x4){lo.x, lo.y, hi.x, hi.y}; return c.b; }
__device__ __forceinline__ bf16x8 sm_nat(const LAS unsigned char* tile, int rs, int row, int k0, int h) { return *(const LAS bf16x8*)(tile + row * rs + (k0 + 8 * h) * 2); }
__device__ __forceinline__ bf16x8 sm_tr(const LAS unsigned char* tile, int col0, int lane) {
    const int i16 = lane & 15, g4 = lane >> 4;
    const LAS unsigned char* p = tile + (4 * (g4 >> 1) + (i16 >> 2)) * SM_RS + (col0 + 16 * (g4 & 1) + 4 * (i16 & 3)) * 2;
    const s16x4 v0 = __builtin_amdgcn_ds_read_tr16_b64_v4i16((LAS s16x4*)p), v1 = __builtin_amdgcn_ds_read_tr16_b64_v4i16((LAS s16x4*)(p + 8 * SM_RS));
    return (bf16x8){v0.x, v0.y, v0.z, v0.w, v1.x, v1.y, v1.z, v1.w};
}
#define SM_MFMA(a, b, c) __builtin_amdgcn_mfma_f32_32x32x16_bf16(a, b, c, 0, 0, 0)

__device__ __forceinline__ void scan_a_mfma_task(const Args& a, int task, int lane_in, LAS unsigned char* L) {
    int lane = lane_in; asm volatile("" : "+v"(lane));
    bf16* rkv = (bf16*)(a.ws + WS_BIG); const bf16* eag = (const bf16*)(a.ws + WS_EAG);
    float* pq = (float*)(a.ws + WS_PQ); float* rks = (float*)(a.ws + WS_RKS);
    const int c = task % SC_NCH, bh = task / SC_NCH, b = bh >> 4, hd = bh & 15, hb = hd * 64;
    LAS float* GAB = (LAS float*)(L + SM_GAB); LAS float* CL = (LAS float*)(L + SM_CL); LAS float* T1 = (LAS float*)(L + SM_T1); LAS float* T2 = (LAS float*)(L + SM_T2);
    LAS float* SS = (LAS float*)(L + SM_SS); LAS float* RK = (LAS float*)(L + SM_RK);
    f32x16 ZT[2][4];
#pragma unroll
    for (int jt = 0; jt < 2; ++jt)
#pragma unroll
        for (int zt = 0; zt < 4; ++zt)
#pragma unroll
            for (int e = 0; e < 16; ++e) { const int j = 32 * jt + (e & 3) + 8 * (e >> 2) + 4 * (lane >> 5), z = 32 * zt + (lane & 31); ZT[jt][zt][e] = (zt < 2 && j == z) ? 1.f : 0.f; }
    const size_t tokb = (size_t)b * SEQ + (size_t)c * SC_L;
#pragma unroll 1
    for (int mc = 0; mc < SC_L / SM_L; ++mc) {
        asm volatile("" : "+v"(lane));
        const int h = lane >> 5, c32 = lane & 31, t16 = c32 & 15, ch = hb + lane;
        const size_t tok0 = tokb + (size_t)mc * SM_L;
        {
            int ch_o = ch; asm volatile("" : "+v"(ch_o));
            const float kk_c = a.in[I_K_K][ch_o], ka_c = a.in[I_K_A][ch_o], rk_c = a.in[I_R_K][ch_o];
            unsigned rk_[SM_L], ea_[SM_L];
            {
                const int lr = lane >> 3, lc = lane & 7;
                const u32x4* pr = (const u32x4*)(rkv + (tok0 + lr) * RKV_LD + hb) + lc; const u32x4* pe = (const u32x4*)(eag + (tok0 + lr) * EAG_LD + hb) + lc;
                u32x4 gr[2], gk[2], gv[2], ge[2], ga[2];
#pragma unroll
                for (int i = 0; i < 2; ++i) { gr[i] = pr[i * RKV_LD]; gk[i] = pr[i * RKV_LD + 128]; gv[i] = pr[i * RKV_LD + 256]; ge[i] = pe[i * EAG_LD]; ga[i] = pe[i * EAG_LD + 128]; }
#pragma unroll
                for (int i = 0; i < 2; ++i) { LAS unsigned char* w = L + (lr + 8 * i) * SM_RS + lc * 16;
                    *(LAS u32x4*)(w + SM_AK) = gr[i]; *(LAS u32x4*)(w + SM_BH) = gk[i]; *(LAS u32x4*)(w + SM_VV) = gv[i]; *(LAS u32x4*)(w + SM_KH) = ge[i]; *(LAS u32x4*)(w + SM_RH) = ga[i]; }
#pragma unroll
                for (int s = 0; s < SM_L; ++s) { const LAS unsigned char* q = L + s * SM_RS + lane * 2;
                    const unsigned r = *(const LAS unsigned short*)(q + SM_AK), k = *(const LAS unsigned short*)(q + SM_BH), e = *(const LAS unsigned short*)(q + SM_KH), al = *(const LAS unsigned short*)(q + SM_RH);
                    rk_[s] = r | (k << 16); ea_[s] = al | (e << 16); }
            }
#pragma unroll
            for (int s = 0; s < SM_L; ++s) { const float k = bfhi(rk_[s]), kkr = k * kk_c, al = bflo(ea_[s]); T1[s * 65 + lane] = kkr * kkr; T2[s * 65 + lane] = bflo(rk_[s]) * (k * (1.0f + (al - 1.0f) * ka_c)) * rk_c; }
            { const int st = lane >> 2, pt = lane & 3; float s1 = 0.f, s2 = 0.f;
#pragma unroll
              for (int q = 0; q < 16; ++q) { s1 += T1[st * 65 + pt * 16 + q]; s2 += T2[st * 65 + pt * 16 + q]; }
              s1 += dpp_mov<0xB1>(s1); s1 += dpp_mov<0x4E>(s1); s2 += dpp_mov<0xB1>(s2); s2 += dpp_mov<0x4E>(s2);
              if (pt == 0) { SS[st] = s1; RK[st] = s2; } }
            if (lane < SM_L) rks[(tok0 + lane) * 16 + hd] = RK[lane];
            float cum = 0.f, cprev = 1.f;
#pragma unroll
            for (int s = 0; s < SM_L; ++s) {
                const float k = bfhi(rk_[s]), al = bflo(ea_[s]), r = bflo(rk_[s]);
                const float kk = k * kk_c * rsqrtf(fmaxf(SS[s], 1e-12f)), kp = k * (1.0f + (al - 1.0f) * ka_c);
                cum += bfhi(ea_[s]); const float ct = __expf(-cum), ict = __expf(cum);
                const float akv = kk * cprev, bhv = kk * al * ict, khv = kp * ict, rhv = r * ct;
                *(LAS bf16*)(L + SM_AK + s * SM_RS + lane * 2) = f2bf(akv); *(LAS bf16*)(L + SM_BH + s * SM_RS + lane * 2) = f2bf(bhv);
                *(LAS bf16*)(L + SM_KH + s * SM_RS + lane * 2) = f2bf(khv); *(LAS bf16*)(L + SM_RH + s * SM_RS + lane * 2) = f2bf(rhv);
                cprev = ct;
            }
            CL[lane] = cprev;
        }
        __builtin_amdgcn_sched_barrier(0);
        {
            f32x16 gab, gak, hrb, hrk;
#pragma unroll
            for (int e = 0; e < 16; ++e) { gab[e] = 0.f; gak[e] = 0.f; hrb[e] = 0.f; hrk[e] = 0.f; }
#pragma unroll
            for (int ks = 0; ks < 4; ++ks) {
                const bf16x8 fa = sm_nat(L + SM_AK, SM_RS, t16, 16 * ks, h), fr = sm_nat(L + SM_RH, SM_RS, t16, 16 * ks, h), fb = sm_nat(L + SM_BH, SM_RS, t16, 16 * ks, h), fk = sm_nat(L + SM_KH, SM_RS, t16, 16 * ks, h);
                gab = SM_MFMA(fa, fb, gab); gak = SM_MFMA(fa, fk, gak); hrb = SM_MFMA(fr, fb, hrb); hrk = SM_MFMA(fr, fk, hrk);
            }
            if (c32 < 16) {
#pragma unroll
                for (int e = 0; e < 8; ++e) { const int t = (e & 3) + 8 * (e >> 2) + 4 * h, s = c32;
                    GAB[t * 17 + s] = (s < t) ? gab[e] : 0.f;
                    *(LAS bf16*)(L + SM_GAK + t * SM_TS + s * 2) = f2bf((s < t) ? gak[e] : 0.f);
                    *(LAS bf16*)(L + SM_HRB + t * SM_TS + s * 2) = f2bf((s <= t) ? hrb[e] : 0.f);
                    *(LAS bf16*)(L + SM_HRK + t * SM_TS + s * 2) = f2bf((s <= t) ? hrk[e] : 0.f); }
            }
        }
        __builtin_amdgcn_sched_barrier(0);
        if (lane < 16) {
            float tc[16];
#pragma unroll
            for (int t = 0; t < 16; ++t) { float v = (t == lane) ? 1.f : 0.f;
#pragma unroll
                for (int s = 0; s < t; ++s) v -= GAB[t * 17 + s] * tc[s];
                tc[t] = v; *(LAS bf16*)(L + SM_TT + t * SM_TS + lane * 2) = f2bf(v); }
        }
        __builtin_amdgcn_sched_barrier(0);
#pragma unroll
        for (int zt = 0; zt < 4; ++zt) {
            f32x16 x, o;
#pragma unroll
            for (int e = 0; e < 16; ++e) { x[e] = 0.f; o[e] = 0.f; }
#pragma unroll
            for (int jt = 0; jt < 2; ++jt)
#pragma unroll
                for (int ks = 0; ks < 2; ++ks) {
                    const bf16x8 fa = sm_a_perm(L + SM_AK, SM_RS, t16, 32 * jt + 16 * ks, h), fr = sm_a_perm(L + SM_RH, SM_RS, t16, 32 * jt + 16 * ks, h);
                    const bf16x8 zh = sm_acc_hi(ZT[jt][zt], ks);
                    x = SM_MFMA(fa, zh, x); o = SM_MFMA(fr, zh, o);
                }
            if (zt >= 2) { const bf16x8 fv = sm_tr(L + SM_VV, 32 * (zt - 2), lane);
                x = SM_MFMA(sm_a_perm(L + SM_GAK, SM_TS, t16, 0, h), fv, x); o = SM_MFMA(sm_a_perm(L + SM_HRK, SM_TS, t16, 0, h), fv, o); }
            f32x16 sa;
#pragma unroll
            for (int e = 0; e < 16; ++e) sa[e] = 0.f;
            { const bf16x8 xh = sm_acc_hi(x, 0); const bf16x8 ft = sm_a_perm(L + SM_TT, SM_TS, t16, 0, h); sa = SM_MFMA(ft, xh, sa); }
#pragma unroll
            for (int e = 0; e < 16; ++e) sa[e] = -sa[e];
            const bf16x8 sh = sm_acc_hi(sa, 0);
            { const bf16x8 fh = sm_a_perm(L + SM_HRB, SM_TS, t16, 0, h); o = SM_MFMA(fh, sh, o); }
#pragma unroll
            for (int e = 0; e < 8; ++e) { const int t = (e & 3) + 8 * (e >> 2) + 4 * h;
                rkv[(tok0 + t) * RKV_LD + (zt < 2 ? hb + 32 * zt : 1024 + hb + 32 * (zt - 2)) + c32] = f2bf(o[e]); }
#pragma unroll
            for (int jt = 0; jt < 2; ++jt) {
                const bf16x8 fb = sm_tr(L + SM_BH, 32 * jt, lane);
                ZT[jt][zt] = SM_MFMA(fb, sh, ZT[jt][zt]);
                if (zt >= 2) ZT[jt][zt] = SM_MFMA(sm_tr(L + SM_KH, 32 * jt, lane), sm_tr(L + SM_VV, 32 * (zt - 2), lane), ZT[jt][zt]);
#pragma unroll
                for (int g = 0; g < 4; ++g) { const f32x4 c4 = *(const LAS f32x4*)(CL + 32 * jt + 8 * g + 4 * h);
                    ZT[jt][zt][4 * g] *= c4.x; ZT[jt][zt][4 * g + 1] *= c4.y; ZT[jt][zt][4 * g + 2] *= c4.z; ZT[jt][zt][4 * g + 3] *= c4.w; }

            }
            __builtin_amdgcn_sched_barrier(0);
        }
    }
    if (c < SC_NCH - 1) {
        float* dst = pq + ((size_t)(bh * (SC_NCH - 1) + c) * 2) * 4096;
#pragma unroll
        for (int jt = 0; jt < 2; ++jt)
#pragma unroll
            for (int zt = 0; zt < 4; ++zt)
#pragma unroll
                for (int g = 0; g < 4; ++g) { const int z = 32 * zt + (lane & 31), j0 = 32 * jt + 8 * g + 4 * (lane >> 5);
                    *(f32x4*)(dst + (size_t)z * 64 + j0) = (f32x4){ZT[jt][zt][4 * g], ZT[jt][zt][4 * g + 1], ZT[jt][zt][4 * g + 2], ZT[jt][zt][4 * g + 3]}; }
    }
}
__device__ __forceinline__ void scan_pass_a_mfma(const Args& a, LAS unsigned char* lds) {
    const int tid = threadIdx.x, wave = __builtin_amdgcn_readfirstlane(tid >> 6), lane = tid & 63, G = gridDim.x;
    for (int task = wave * G + blockIdx.x; task < SC_NT; task += 8 * G)
    {   unsigned z = 0u; asm volatile("" : "+v"(z));
        scan_a_mfma_task(a, task, (int)__builtin_amdgcn_mbcnt_hi(~0u, __builtin_amdgcn_mbcnt_lo(~0u, z)), lds + wave * SM_WAVE); }
}
#define PB_WAIT(n) asm volatile("s_waitcnt vmcnt(" #n ")" ::: "memory")
__device__ __forceinline__ void scan_pass_b(const Args& a, LAS unsigned char* lds) {
    const int tid = threadIdx.x, wave = __builtin_amdgcn_readfirstlane(tid >> 6), lane = tid & 63;
    LAS float* Pl = (LAS float*)lds;
    LAS float* Ql = Pl + 4 * 4096;
    float* pq = (float*)(a.ws + WS_PQ);
    for (int u = blockIdx.x; u < NB * 16 * 8; u += gridDim.x) {
        const int xcd = u & 7, idx = u >> 3, bh = (xcd * 4 + (idx >> 3)) & (NB * 16 - 1), row = (idx & 7) * 8 + wave;
        float* pc = pq + ((size_t)(bh * (SC_NCH - 1)) * 2) * 4096;
        float cur = 0.f;
        __syncthreads();
#define PB_ISSUE(cc) do { const int c_ = (cc) < SC_NCH - 1 ? (cc) : SC_NCH - 2; const float* g_ = pc + (size_t)c_ * 2 * 4096; LAS float* d_ = Pl + ((cc) & 3) * 4096 + wave * 256; \
            __builtin_amdgcn_global_load_lds((const unsigned*)(g_ + tid * 4), (LAS unsigned*)d_, 16, 0, 0); __builtin_amdgcn_global_load_lds((const unsigned*)(g_ + 2048 + tid * 4), (LAS unsigned*)(d_ + 2048), 16, 0, 0); \
            __builtin_amdgcn_global_load_lds((const unsigned*)(g_ + 4096 + row * 64 + lane), (LAS unsigned*)(Ql + ((cc) & 3) * 512 + wave * 64), 4, 0, 0); } while (0)
        PB_ISSUE(0); PB_ISSUE(1); PB_ISSUE(2);
        for (int c = 0; c < SC_NCH - 1; ++c) {
            if (c >= 3) PB_WAIT(9); else PB_WAIT(6);
            __builtin_amdgcn_s_barrier(); asm volatile("" ::: "memory");
            PB_ISSUE(c + 3);
            const LAS float* P = Pl + (c & 3) * 4096 + lane;
            float a0 = Ql[(c & 3) * 512 + wave * 64 + lane], a1 = 0.f, a2 = 0.f, a3 = 0.f;
#pragma unroll
            for (int k = 0; k < 64; k += 4) {
#define PB_BC(kk) __int_as_float(__builtin_amdgcn_readlane(__float_as_int(cur), (kk)))
                a0 = fmaf(PB_BC(k), P[k * 64], a0); a1 = fmaf(PB_BC(k + 1), P[(k + 1) * 64], a1); a2 = fmaf(PB_BC(k + 2), P[(k + 2) * 64], a2); a3 = fmaf(PB_BC(k + 3), P[(k + 3) * 64], a3);
            }
            cur = (a0 + a1) + (a2 + a3);
            pc[(size_t)c * 2 * 4096 + 4096 + row * 64 + lane] = cur;
        }
        PB_WAIT(0);
    }
}
__device__ __forceinline__ void pc_seg_load(const bf16* half_base, u32x2 (&out)[2][4]) {
#pragma unroll
    for (int gq = 0; gq < 4; ++gq) { const u32x4 L = ((const u32x4*)half_base)[gq];
        auto s0 = __builtin_amdgcn_permlane32_swap(L.x, L.z, false, false); auto s1 = __builtin_amdgcn_permlane32_swap(L.y, L.w, false, false);
        out[0][gq] = (u32x2){s0[0], s1[0]}; out[1][gq] = (u32x2){s0[1], s1[1]}; }
}
__device__ __forceinline__ void pc_seg_store(bf16* half_base, const u32x2 (&in)[2][4]) {
#pragma unroll
    for (int gq = 0; gq < 4; ++gq) {
        auto s0 = __builtin_amdgcn_permlane32_swap(in[0][gq].x, in[1][gq].x, false, false); auto s1 = __builtin_amdgcn_permlane32_swap(in[0][gq].y, in[1][gq].y, false, false);
        ((u32x4*)half_base)[gq] = (u32x4){s0[0], s1[0], s0[1], s1[1]}; }
}
constexpr int SCC_SS = 144;
__device__ __forceinline__ void scan_pass_c(const Args& a, LAS unsigned char* lds) {
    const int tid = threadIdx.x, wave = __builtin_amdgcn_readfirstlane(tid >> 6), lane = tid & 63, h32 = lane >> 5, c32 = lane & 31;
    bf16* rkv = (bf16*)(a.ws + WS_BIG); const bf16* eag = (const bf16*)(a.ws + WS_EAG);
    const float* pq = (const float*)(a.ws + WS_PQ); const float* rks = (const float*)(a.ws + WS_RKS);
    LAS unsigned char* SH = lds; LAS unsigned char* SL = lds + 64 * SCC_SS;
    for (int u = blockIdx.x; u < SC_NT; u += gridDim.x) {
        const int c = u % SC_NCH, bh = u / SC_NCH, b = bh >> 4, h = bh & 15, hb = h * 64;
        __syncthreads();
        if (c > 0) { const float* sp = pq + ((size_t)(bh * (SC_NCH - 1) + c - 1) * 2 + 1) * 4096 + tid * 8;
            const f32x4 x0 = *(const f32x4*)sp, x1 = *(const f32x4*)(sp + 4);
            const float xs[8] = {x0.x, x0.y, x0.z, x0.w, x1.x, x1.y, x1.z, x1.w};
            unsigned hi[4], lo[4];
#pragma unroll
            for (int q = 0; q < 4; ++q) { hi[q] = cvt_pk_bf16(xs[2 * q], xs[2 * q + 1]); lo[q] = cvt_pk_bf16(xs[2 * q] - bflo(hi[q]), xs[2 * q + 1] - bfhi(hi[q])); }
            *(LAS u32x4*)(SH + (tid >> 3) * SCC_SS + (tid & 7) * 16) = (u32x4){hi[0], hi[1], hi[2], hi[3]};
            *(LAS u32x4*)(SL + (tid >> 3) * SCC_SS + (tid & 7) * 16) = (u32x4){lo[0], lo[1], lo[2], lo[3]}; }
        __syncthreads();
        const size_t tok = (size_t)b * SEQ + (size_t)c * SC_L + wave * 32 + c32;
        f32x16 acc0, acc1;
#pragma unroll
        for (int e = 0; e < 16; ++e) { acc0[e] = 0.f; acc1[e] = 0.f; }
        if (c > 0) {
#pragma unroll
            for (int ks = 0; ks < 4; ++ks) {
                const bf16x8 pf = *(const bf16x8*)(rkv + tok * RKV_LD + hb + ks * 16 + h32 * 8);
                const bf16x8 a0h = *(const LAS bf16x8*)(SH + c32 * SCC_SS + h32 * 16 + ks * 32), a0l = *(const LAS bf16x8*)(SL + c32 * SCC_SS + h32 * 16 + ks * 32);
                const bf16x8 a1h = *(const LAS bf16x8*)(SH + (32 + c32) * SCC_SS + h32 * 16 + ks * 32), a1l = *(const LAS bf16x8*)(SL + (32 + c32) * SCC_SS + h32 * 16 + ks * 32);
                acc0 = __builtin_amdgcn_mfma_f32_32x32x16_bf16(a0h, pf, acc0, 0, 0, 0); acc0 = __builtin_amdgcn_mfma_f32_32x32x16_bf16(a0l, pf, acc0, 0, 0, 0);
                acc1 = __builtin_amdgcn_mfma_f32_32x32x16_bf16(a1h, pf, acc1, 0, 0, 0); acc1 = __builtin_amdgcn_mfma_f32_32x32x16_bf16(a1l, pf, acc1, 0, 0, 0);
            }
        }
        u32x2 yqw[2][4], vw[2][4], gw2[2][4];
        pc_seg_load(rkv + tok * RKV_LD + 1024 + hb + 32 * h32, yqw); pc_seg_load(rkv + tok * RKV_LD + 2048 + hb + 32 * h32, vw); pc_seg_load(eag + tok * EAG_LD + 2048 + hb + 32 * h32, gw2);
        float y[32]; float sum = 0.f;
#pragma unroll
        for (int it = 0; it < 2; ++it)
#pragma unroll
            for (int gq = 0; gq < 4; ++gq) {
                const u32x2 w = yqw[it][gq];
                const float q4[4] = {bflo(w.x), bfhi(w.x), bflo(w.y), bfhi(w.y)};
#pragma unroll
                for (int j = 0; j < 4; ++j) { const float v = (it ? acc1[4 * gq + j] : acc0[4 * gq + j]) + q4[j]; y[it * 16 + gq * 4 + j] = v; sum += v; }
            }
        const float mean = xor32_sum(sum) * (1.0f / 64.0f); float qs = 0.f;
#pragma unroll
        for (int e = 0; e < 32; ++e) { const float d = y[e] - mean; qs += d * d; }
        const float rstd = rsqrtf(xor32_sum(qs) * (1.0f / 64.0f) + 64e-5f);
        const float rkc = rks[tok * 16 + h];
        u32x2 ow[2][4];
#pragma unroll
        for (int it = 0; it < 2; ++it)
#pragma unroll
            for (int gq = 0; gq < 4; ++gq) {
                const int i0 = 32 * it + 8 * gq + 4 * h32;
                const f32x4 lg = *(const f32x4*)(a.in[I_LNX_G] + hb + i0), lb = *(const f32x4*)(a.in[I_LNX_B] + hb + i0);
                const float v4[4] = {bflo(vw[it][gq].x), bfhi(vw[it][gq].x), bflo(vw[it][gq].y), bfhi(vw[it][gq].y)}, g4[4] = {bflo(gw2[it][gq].x), bfhi(gw2[it][gq].x), bflo(gw2[it][gq].y), bfhi(gw2[it][gq].y)};
                const float l4[4] = {lg.x, lg.y, lg.z, lg.w}, b4[4] = {lb.x, lb.y, lb.z, lb.w};
                float o[4];
#pragma unroll
                for (int j = 0; j < 4; ++j) o[j] = ((y[it * 16 + gq * 4 + j] - mean) * rstd * l4[j] + b4[j] + rkc * v4[j]) * g4[j];
                ow[it][gq] = (u32x2){cvt_pk_bf16(o[0], o[1]), cvt_pk_bf16(o[2], o[3])};
            }
        pc_seg_store(rkv + tok * RKV_LD + hb + 32 * h32, ow);
    }
}

constexpr int N_PHASES = 27;
__global__ void __launch_bounds__(512, 2) mk_fwd(Args args) {
    extern __shared__ __attribute__((aligned(16))) unsigned char lds_raw[];
    LAS unsigned char* lds = (LAS unsigned char*)lds_raw;
    const int tid = threadIdx.x;
    const int G = gridDim.x, nw = G * 8, gsize = G * 512;
#define TIDO() ({ int t_ = threadIdx.x; asm volatile("" : "+v"(t_)); t_; })
#define lane (TIDO() & 63)
#define gw ((int)blockIdx.x * 8 + (TIDO() >> 6))
#define gtid ((int)blockIdx.x * 512 + TIDO())
    unsigned char* ws = args.ws;
    volatile LAS unsigned* lctl = (volatile LAS unsigned*)(lds + LDS_CTL_OFF);
    if (tid < 16) lctl[tid] = 0u;
    __syncthreads();
    const int lo = args.ph_lo, hi = args.ph_hi;
    XcdBarrier bar; bar.bar = (unsigned*)(ws + WS_CTL) + CW_BAR; bar.x = 0; bar.st = nullptr;
    if (hi - lo > 1) bar = xcd_barrier_post((unsigned*)(ws + WS_CTL) + CW_BAR, lctl + 8);
#define IN(k) (lo <= (k) && (k) < hi)
#ifndef PROBE_DUP
#define PROBE_DUP 0u
#endif
#define RUN(k, ...) do { if (IN(k)) { __VA_ARGS__; if ((PROBE_DUP >> (k)) & 1u) { xcd_barrier(bar); __VA_ARGS__; } } if (IN(k) && IN((k) + 1)) xcd_barrier(bar); } while (0)
    float* X = args.out;
    bf16* XNp = (bf16*)(ws + WS_XN);
    const pg8::bf16_t* XNa = (const pg8::bf16_t*)(ws + WS_XN) + D;
    bf16* DD = (bf16*)(ws + WS_DD);
    pg8::bf16_t* BIG = (pg8::bf16_t*)(ws + WS_BIG);
    pg8::bf16_t* YY = (pg8::bf16_t*)(ws + WS_Y);
    const unsigned char* Wb = ws + WS_W;
    const int bx = (int)blockIdx.x;

#define GEMM_CALL(MODE, Aptr, Woff, N_, K_, lda_, gap_, ts_, Optr, ldc_, b0_, b1_) do { pg8::Gemm g{Aptr, (const pg8::bf16_t*)(Wb + (Woff)), M, N_, K_, lda_, gap_, ts_}; pg8::StaticOrder S; S.init(M, N_, G, bx); \
        pg8::Epi<MODE> E{Optr, ldc_, b0_, b1_}; pg8::gemm_phase(lds, g, S, E); } while (0)
#define FFN_G1(k) RUN(k, GEMM_CALL(1, XNa, W_GU, 2 * FF, D, D, 1, D / 64, BIG, FF, nullptr, nullptr))
#define FFN_G2(k, outp) RUN(k, do { pg8::Gemm g{BIG, (const pg8::bf16_t*)(Wb + W_DN), M, D, FF, FF, 0, FF / 64}; pg8::StaticOrder S; S.init(M, D, G, bx); S.rev = 1; \
        pg8::Epi<0> E{(pg8::bf16_t*)(outp), D, nullptr, nullptr}; pg8::gemm_phase(lds, g, S, E); } while (0))
    bf16* DY = (bf16*)(ws + WS_Y);
    const pg8::bf16_t* ATT = (const pg8::bf16_t*)(ws + WS_ATT);

    RUN(0, row_pass<false, false, false, true>(args.in[I_X], nullptr, nullptr, nullptr, 0.f, nullptr, nullptr, 0.f, args.in[I_L0F1 + 0], XNp, gw, nw, lane); convert_ffn(args, I_L0F1, gtid, gsize, lds));
    FFN_G1(1); FFN_G2(2, DY);
    RUN(3, row_pass<true, false, false, true>(args.in[I_X], nullptr, DY, args.in[I_L0F1 + 1], 0.5f, nullptr, nullptr, 0.f, args.in[I_L0_MIX_PRE], XNp, gw, nw, lane); convert_mix0(args, gtid, gsize, lds));
    RUN(4, GEMM_CALL(0, XNa, W_IN, PROJ_LD, D, D, 1, D / 64, BIG, PROJ_LD, nullptr, nullptr));
    RUN(5, do {
        pg8::Gemm g{BIG + PC_KC, (const pg8::bf16_t*)(Wb + W_CMP), 8192, 256, 2048 / CMP_SPLIT, PROJ_LD, 0, 32, 2048}; pg8::SplitTiles S{G, bx, CMP_SPLIT * 32};
        pg8::Epi<6> E{(pg8::bf16_t*)(ws + WS_XN), 128, nullptr, nullptr}; pg8::gemm_phase<pg8::Epi<6>, pg8::SplitTiles, true>(lds, g, S, E); } while (0));
    RUN(6, compress_stage2(args, gw, nw, lane));
    RUN(7, nsa_mfma_phase(args, lds));
    RUN(8, GEMM_CALL(0, ATT, W_OUT, D, D, D, 0, D / 64, (pg8::bf16_t*)DD, D, nullptr, nullptr));
    RUN(9, row_pass<true, true, true, true>(args.in[I_X], X, DY, args.in[I_L0F1 + 1], 0.5f, DD, args.in[I_L0_MIX_POST], 1.0f, args.in[I_L0F2 + 0], XNp, gw, nw, lane); convert_ffn(args, I_L0F2, gtid, gsize, lds));
    FFN_G1(10); FFN_G2(11, DD);
    RUN(12, row_pass<true, false, false, true>(X, nullptr, DD, args.in[I_L0F2 + 1], 0.5f, nullptr, nullptr, 0.f, args.in[I_L1F1 + 0], XNp, gw, nw, lane); convert_ffn(args, I_L1F1, gtid, gsize, lds));
    FFN_G1(13); FFN_G2(14, DY);
    RUN(15, row_pass<true, true, true, true>(X, X, DD, args.in[I_L0F2 + 1], 0.5f, DY, args.in[I_L1F1 + 1], 0.5f, args.in[I_L1_MIX_PRE], XNp, gw, nw, lane); convert_mix1(args, gtid, gsize, lds));
    RUN(16, rwkv_mix_phase(args, gtid, gsize));
    RUN(17, GEMM_CALL(0, (const pg8::bf16_t*)(ws + WS_XR), W_R, D, D, D, 0, D / 64, BIG, RKV_LD, nullptr, nullptr);
            GEMM_CALL(0, (const pg8::bf16_t*)(ws + WS_XK), W_K, D, D, D, 0, D / 64, BIG + 1024, RKV_LD, nullptr, nullptr);
            GEMM_CALL(0, (const pg8::bf16_t*)(ws + WS_XV), W_V, D, D, D, 0, D / 64, BIG + 2048, RKV_LD, nullptr, nullptr);
            GEMM_CALL(5, XNa, W_LORA, 256, 2 * D, D, 1, D / 64, BIG + 3072, RKV_LD, nullptr, nullptr);
            convert_mix1_l2(args, gtid, gsize, lds));
    RUN(18, do { pg8::Gemm g{BIG + 3072, (const pg8::bf16_t*)(Wb + W_L2), M, 2048, 128, RKV_LD, 0, 2, 256}; pg8::StaticOrder S; S.init(M, 2048, G, bx);
                 pg8::Epi<3> E{(pg8::bf16_t*)(ws + WS_EAG), EAG_LD, args.in[I_W0], args.in[I_A0]}; pg8::gemm_phase(lds, g, S, E); } while (0);
            do { pg8::Gemm g{BIG + 3072 + 128, (const pg8::bf16_t*)(Wb + W_L2) + (size_t)2048 * 256 + 128, M, 1024, 128, RKV_LD, 0, 2, 256}; pg8::StaticOrder S; S.init(M, 1024, G, bx);
                 pg8::Epi<0> E{(pg8::bf16_t*)(ws + WS_EAG) + 2048, EAG_LD, nullptr, nullptr}; pg8::gemm_phase(lds, g, S, E); } while (0));
    RUN(19, scan_pass_a_mfma(args, lds));
    RUN(20, scan_pass_b(args, lds));
    RUN(21, scan_pass_c(args, lds));
    RUN(22, GEMM_CALL(0, BIG, W_O, D, D, RKV_LD, 0, D / 64, (pg8::bf16_t*)DD, D, nullptr, nullptr));
    RUN(23, row_pass<true, false, false, true>(X, nullptr, DD, args.in[I_L1_MIX_POST], 1.0f, nullptr, nullptr, 0.f, args.in[I_L1F2 + 0], XNp, gw, nw, lane); convert_ffn(args, I_L1F2, gtid, gsize, lds));
    FFN_G1(24); FFN_G2(25, DY);
    RUN(26, row_pass<true, true, true, false>(X, X, DD, args.in[I_L1_MIX_POST], 1.0f, DY, args.in[I_L1F2 + 1], 0.5f, nullptr, nullptr, gw, nw, lane));
#undef IN
#undef RUN
#undef lane
#undef gw
#undef gtid
#undef TIDO
}

extern "C" void kernel_launch(void* const* d_in, const int* in_sizes, int n_in, void* d_out, int out_size, void* d_ws, size_t ws_size, hipStream_t stream) {
    static int grid = 0;
    if (grid == 0) {
        if (n_in != 53 || out_size != M * D || ws_size < WS_END) { fprintf(stderr, "kernel_launch: unexpected shapes (n_in %d, out %d, ws %zu)\n", n_in, out_size, ws_size); grid = -1; return; }
        int dev = 0, cus = 0;
        if (hipGetDevice(&dev) != hipSuccess || hipDeviceGetAttribute(&cus, hipDeviceAttributeMultiprocessorCount, dev) != hipSuccess) { grid = -1; return; }
        if (hipFuncSetAttribute((const void*)mk_fwd, hipFuncAttributeMaxDynamicSharedMemorySize, LDS_BYTES) != hipSuccess) { fprintf(stderr, "kernel_launch: hipFuncSetAttribute failed\n"); grid = -1; return; }
        int per_cu = 0;
        if (hipOccupancyMaxActiveBlocksPerMultiprocessor(&per_cu, (const void*)mk_fwd, 512, LDS_BYTES) != hipSuccess || per_cu < 1) { fprintf(stderr, "kernel_launch: occupancy query says %d\n", per_cu); }
        (void)hipGetLastError();
        grid = cus;
    }
    if (grid < 0) return;
    (void)hipMemsetAsync((char*)d_ws + WS_CTL, 0, CTL_ZERO_BYTES, stream);
    Args a{};
    for (int i = 0; i < 53; ++i) a.in[i] = (const float*)d_in[i];
    a.out = (float*)d_out; a.ws = (unsigned char*)d_ws;
#if MK_ONE_LAUNCH
    a.ph_lo = 0; a.ph_hi = N_PHASES;
    hipLaunchKernelGGL(mk_fwd, dim3(grid), dim3(512), LDS_BYTES, stream, a);
#else
    for (int p = 0; p < N_PHASES; ++p) { a.ph_lo = p; a.ph_hi = p + 1; hipLaunchKernelGGL(mk_fwd, dim3(grid), dim3(512), LDS_BYTES, stream, a); }
#endif
}
```

```cpp
#include <hip/hip_runtime.h>
#include <cstdio>
#include <cstdint>

#ifndef MK_ONE_LAUNCH
#define MK_ONE_LAUNCH 1
#endif

#define LAS __attribute__((address_space(3)))
typedef unsigned short bf16;
typedef short bf16x8 __attribute__((ext_vector_type(8)));
typedef float f32x4 __attribute__((ext_vector_type(4)));
typedef float f32x2 __attribute__((ext_vector_type(2)));
typedef unsigned u32x4 __attribute__((ext_vector_type(4)));
typedef unsigned u32x2 __attribute__((ext_vector_type(2)));

constexpr int NB = 2, SEQ = 16384, M = NB * SEQ, D = 1024, FF = 2816;
constexpr int NCMP = 1023, NSLC = 256;
constexpr int PROJ_LD = 3072;
constexpr int PC_Q = 0, PC_KC = 512, PC_VC = 640, PC_KS = 768, PC_VS = 896, PC_KW = 1024, PC_VW = 1152, PC_CB = 1280, PC_CC = 1792, PC_CU = 2304, PC_G = 2816;
constexpr int RKV_LD = 3328;
constexpr int EAG_LD = 3072;
constexpr float EPS = 1e-6f;

constexpr size_t MiB = 1u << 20;
constexpr size_t WS_CTL = 0, CTL_ZERO_BYTES = 1 * MiB;
constexpr size_t WS_KC = 1 * MiB, WS_VC = 2 * MiB;
constexpr size_t WS_W = 8 * MiB;
constexpr size_t WS_BIG = 28 * MiB;
constexpr size_t WS_EAG = 236 * MiB;
constexpr size_t WS_XN = 236 * MiB;
constexpr size_t WS_DD = 302 * MiB;
constexpr size_t WS_ATT = 236 * MiB;
constexpr size_t WS_Y = 428 * MiB;
constexpr size_t WS_PQ = 428 * MiB;
constexpr size_t WS_XR = 302 * MiB, WS_XK = 366 * MiB, WS_XV = 430 * MiB;
constexpr size_t WS_RKS = 494 * MiB;
constexpr size_t WS_END = 496 * MiB;
constexpr size_t W_GU = 0, W_DN = 11 * MiB;
constexpr size_t W_IN = 0, W_OUT = 6 * MiB, W_CMP = 8 * MiB;
constexpr size_t WS_PEB = 1 * MiB + 768 * 1024;
constexpr size_t W_R = 0, W_K = 2 * MiB, W_V = 4 * MiB, W_LORA = 6 * MiB, W_L2 = 13 * MiB, W_O = 15 * MiB;

constexpr int CW_BAR = 4096;

constexpr int LDS_CTL_OFF = 147456;
constexpr int LDS_BYTES = 147456 + 256;

__device__ __forceinline__ float bf2f(bf16 b) { return __uint_as_float(((unsigned)b) << 16); }
__device__ __forceinline__ float bflo(unsigned u) { return __uint_as_float(u << 16); }
__device__ __forceinline__ float bfhi(unsigned u) { return __uint_as_float(u & 0xffff0000u); }
typedef __bf16 nbf16x2 __attribute__((ext_vector_type(2)));
typedef float nf32x2 __attribute__((ext_vector_type(2)));
__device__ __forceinline__ unsigned cvt_pk_bf16(float lo, float hi) { const nf32x2 v = {lo, hi}; return __builtin_bit_cast(unsigned, __builtin_convertvector(v, nbf16x2)); }
__device__ __forceinline__ bf16 f2bf(float f) { return (bf16)(cvt_pk_bf16(f, 0.f) & 0xffffu); }
__device__ __forceinline__ float wave_sum(float v) {
#pragma unroll
    for (int o = 1; o < 64; o <<= 1) v += __shfl_xor(v, o);
    return v;
}
template <int CTRL, int ROWMASK> __device__ __forceinline__ float dpp_add(float x) { const int t = __builtin_amdgcn_update_dpp(0, __float_as_int(x), CTRL, ROWMASK, 0xF, false); return x + __int_as_float(t); }
__device__ __forceinline__ float wave_sum_dpp(float v) {
    v = dpp_add<0xB1, 0xF>(v); v = dpp_add<0x4E, 0xF>(v); v = dpp_add<0x124, 0xF>(v); v = dpp_add<0x128, 0xF>(v);
    v = dpp_add<0x142, 0xA>(v); v = dpp_add<0x143, 0xC>(v);
    return __int_as_float(__builtin_amdgcn_readlane(__float_as_int(v), 63));
}
template <int CTRL> __device__ __forceinline__ float dpp_mov(float x) { return __int_as_float(__builtin_amdgcn_mov_dpp(__float_as_int(x), CTRL, 0xf, 0xf, true)); }
template <int CTRL> __device__ __forceinline__ int dpp_movi(int x) { return __builtin_amdgcn_mov_dpp(x, CTRL, 0xf, 0xf, true); }
__device__ __forceinline__ float xor32_max(float x) { auto rr = __builtin_amdgcn_permlane32_swap(__float_as_uint(x), __float_as_uint(x), false, false); return fmaxf(__uint_as_float(rr[0]), __uint_as_float(rr[1])); }
__device__ __forceinline__ float xor32_sum(float x) { auto rr = __builtin_amdgcn_permlane32_swap(__float_as_uint(x), __float_as_uint(x), false, false); return __uint_as_float(rr[0]) + __uint_as_float(rr[1]); }
__device__ __forceinline__ float red8(float v) { v += dpp_mov<0xB1>(v); v += dpp_mov<0x4E>(v); v += dpp_mov<0x141>(v); return v; }
__device__ __forceinline__ float wave_max(float v) {
#pragma unroll
    for (int o = 1; o < 64; o <<= 1) v = fmaxf(v, __shfl_xor(v, o));
    return v;
}
__device__ __forceinline__ float sigmoidf_(float x) { return __builtin_amdgcn_rcpf(1.0f + __expf(-x)); }

namespace pg8 {
#define PG8_LAS __attribute__((address_space(3)))
typedef unsigned short bf16_t;
constexpr int BM = 256, BK = 64, HALF = 128, HTB = HALF * BK * 2, STAGE_BYTES = 8 * HTB, NXCD = 8, WGM = 8;

__host__ __device__ __forceinline__ int lds_byte(int r, int c) { const int st = (r >> 4) * 2 + (c >> 5), rr = r & 15, cc = c & 31, ob = rr * 64 + cc * 2; return st * 1024 + (ob ^ (((ob >> 9) & 1) << 5)); }
__host__ __device__ __forceinline__ void stage_rc(int b, int& R, int& C) { const int st = b / 1024, sb = b % 1024, swz = sb ^ (((sb >> 9) & 1) << 5); R = (st >> 1) * 16 + swz / 64; C = (st & 1) * 32 + (swz % 64) / 2; }
__host__ __device__ __forceinline__ int perm32(int rho) { const int n = rho >> 4, i = rho & 15; return 8 * (i >> 2) + 4 * n + (i & 3); }

struct Unit { int pm, pn; };
struct Gemm { const bf16_t* A; const bf16_t* Bt; int M, N, K, lda, gap, ts, ldb = 0; };

struct StaticOrder {
    int nM, nN, nwg, G, c, rev = 0;
    __host__ __device__ void init(int M_, int N_, int G_, int c_) { nM = M_ / BM; nN = N_ / BM; nwg = nM * nN; G = G_; c = c_; }
    __host__ __device__ bool next(int i, Unit& u) const {
        const int rounds = nwg / G; const bool flip = rev && rounds * G == nwg;
        if (flip && i >= rounds) return false;
        const long L = (long)(flip ? rounds - 1 - i : i) * G + c; if (L >= nwg) return false;
        int wgid = (int)L; { const int q = nwg / NXCD, r = nwg % NXCD, xcd = wgid % NXCD, off = wgid / NXCD; wgid = (xcd < r ? xcd * (q + 1) : r * (q + 1) + (xcd - r) * q) + off; }
        const int nig = WGM * nN, gid = wgid / nig, fm = gid * WGM, gsz = (nM - fm) < WGM ? (nM - fm) : WGM;
        u.pm = fm + ((wgid % nig) % gsz); u.pn = (wgid % nig) / gsz; return true;
    }
    __device__ __forceinline__ void a_ready(const Unit&) const {}
    __device__ __forceinline__ void done(const Unit&) const {}
};

struct SplitTiles {
    int G, c, n;
    __host__ __device__ bool next(int i, Unit& u) const { const int L = i * G + c; if (L >= n) return false; u.pm = L & 31; u.pn = L >> 5; return true; }
    __device__ __forceinline__ void a_ready(const Unit&) const {}
    __device__ __forceinline__ void done(const Unit&) const {}
};

template <int MODE> struct Epi {
    static constexpr bool PERM = true, AFTER_DRAIN = false;
    bf16_t* O; int ldc; const float* b0; const float* b1;
    __device__ __forceinline__ void operator()(const f32x4 (&acc)[2][2][4][2], const Unit& u, int wr, int wc, int, int) const {
        int ln_ = threadIdx.x; asm volatile("" : "+v"(ln_));
        const int fr = ln_ & 15, fq = (ln_ >> 4) & 3;
        if constexpr (MODE == 4 || MODE == 6) {
            const int row0 = u.pm * BM + wr * 64 + fr;
            const int kv = u.pm >> 4, col0 = wc * 32 + 8 * fq; float* H = (float*)O + (MODE == 6 ? (size_t)u.pn * 8192 * 128 : (size_t)0);
#pragma unroll
            for (int ai = 0; ai < 2; ++ai)
#pragma unroll
                for (int m = 0; m < 4; ++m) {
                    float o[8];
#pragma unroll
                    for (int n = 0; n < 2; ++n)
#pragma unroll
                        for (int j = 0; j < 4; ++j) {
                            if constexpr (MODE == 6) o[n * 4 + j] = kv ? acc[ai][1][m][n][j] : acc[ai][0][m][n][j];
                            else { const float hh = (kv ? acc[ai][1][m][n][j] : acc[ai][0][m][n][j]) + b0[kv * 128 + col0 + n * 4 + j];
                                const float uu = 0.7978845608028654f * (hh + 0.044715f * hh * hh * hh); const float e2 = __expf(2.0f * uu); o[n * 4 + j] = 0.5f * hh * (2.0f - 2.0f * __builtin_amdgcn_rcpf(e2 + 1.0f)); } }
                    float* hp = H + (size_t)(row0 + ai * HALF + m * 16) * 128 + col0;
                    *(f32x4*)hp = (f32x4){o[0], o[1], o[2], o[3]}; *(f32x4*)(hp + 4) = (f32x4){o[4], o[5], o[6], o[7]};
                }
        } else if constexpr (MODE == 1) {
            const int row0 = u.pm * BM + wr * 64 + fr;
            const int col0 = u.pn * HALF + wc * 32 + 8 * fq;
#pragma unroll
            for (int ai = 0; ai < 2; ++ai)
#pragma unroll
                for (int m = 0; m < 4; ++m) {
                    float o[8];
#pragma unroll
                    for (int n = 0; n < 2; ++n)
#pragma unroll
                        for (int j = 0; j < 4; ++j) { const float g = acc[ai][0][m][n][j], up = acc[ai][1][m][n][j]; o[n * 4 + j] = g * __builtin_amdgcn_rcpf(1.0f + __expf(-g)) * up; }
                    u32x4 w; w.x = cvt_pk_bf16(o[0], o[1]); w.y = cvt_pk_bf16(o[2], o[3]); w.z = cvt_pk_bf16(o[4], o[5]); w.w = cvt_pk_bf16(o[6], o[7]);
                    *(u32x4*)(O + (size_t)(row0 + ai * HALF + m * 16) * ldc + col0) = w;
                }
        } else {
            const int row0 = u.pm * BM + wr * 64 + fr;
            const int col0 = u.pn * BM + wc * 32 + 8 * fq;
#pragma unroll
            for (int ai = 0; ai < 2; ++ai)
#pragma unroll
                for (int m = 0; m < 4; ++m) {
                    bf16_t* rowp = O + (size_t)(row0 + ai * HALF + m * 16) * ldc + col0;
#pragma unroll
                    for (int bj = 0; bj < 2; ++bj) {
                        float o[8];
#pragma unroll
                        for (int n = 0; n < 2; ++n)
#pragma unroll
                            for (int j = 0; j < 4; ++j) o[n * 4 + j] = acc[ai][bj][m][n][j];
                        if constexpr (MODE == 2 || MODE == 5) {
                            if (u.pn == (MODE == 2 ? 12 : 0)) {
                                if (bj == 1) {
#pragma unroll
                                    for (int j = 0; j < 8; ++j) o[j] = sigmoidf_(o[j]);
                                } else if (wc < 2) {
#pragma unroll
                                    for (int j = 0; j < 8; ++j) { const float e2 = __expf(2.0f * o[j]); o[j] = 1.0f - 2.0f * __builtin_amdgcn_rcpf(e2 + 1.0f); }
                                }
                            }
                        }
                        if constexpr (MODE == 3) {
                            const int cc = (u.pn & 3) * BM + bj * HALF + wc * 32 + 8 * fq;
                            if (u.pn < 4) {
#pragma unroll
                                for (int j = 0; j < 8; ++j) o[j] = 0.60653065971f * sigmoidf_(o[j] + b0[cc + j]);
                            } else if (u.pn < 8) {
#pragma unroll
                                for (int j = 0; j < 8; ++j) o[j] = sigmoidf_(o[j] + b1[cc + j]);
                            }
                        }
                        u32x4 w; w.x = cvt_pk_bf16(o[0], o[1]); w.y = cvt_pk_bf16(o[2], o[3]); w.z = cvt_pk_bf16(o[4], o[5]); w.w = cvt_pk_bf16(o[6], o[7]);
                        *(u32x4*)(rowp + bj * HALF) = w;
                    }
                }
        }
    }
};

template <class EpiT, class Sched, bool CMPA = false, bool ALIGN_EPI = true, bool SP2 = true>
__device__ __forceinline__ void gemm_phase(PG8_LAS unsigned char* lds, const Gemm g, const Sched& S, const EpiT& E) {
    const int tid = threadIdx.x, wid = __builtin_amdgcn_readfirstlane(tid >> 6), lane = tid & 63, wr = wid >> 2, wc = wid & 3, fr = lane & 15, fq = lane >> 4;
    const int K = g.K, nt = K / BK, lda = g.lda, ts = g.ts, ldb = g.ldb ? g.ldb : g.K;
    unsigned voffA[2], voffB[2];
#pragma unroll
    for (int i = 0; i < 2; ++i) { int R, C; stage_rc(tid * 16 + i * 8192, R, C); const int Rb = EpiT::PERM ? ((R & ~31) + perm32(R & 31)) : R;
        voffA[i] = CMPA ? (unsigned)((R >> 1) * 16 * lda + (R & 1) * 64 + C) * 2u : (unsigned)(R * lda + C) * 2u; voffB[i] = (unsigned)(Rb * ldb + C) * 2u; }
    const size_t kstep = (size_t)(BK * 2), kstepA = CMPA ? (size_t)lda * 2 : kstep;
    const size_t hstepA = CMPA ? (size_t)64 * 16 * lda * 2 : (size_t)HALF * lda * 2, hstepB = (size_t)HALF * ldb * 2;
    const size_t tstepB = 2 * hstepB, rowA = (size_t)lda * 2;
    const unsigned ldsw = (unsigned)wid * 1024u;
    const int aoff = lds_byte(wr * 64 + fr, fq * 8), boff = lds_byte(wc * 32 + fr, fq * 8);
#define PG8_BBASE(pn) (CMPA ? (const char*)g.Bt + (size_t)(pn) * ((size_t)nt * kstep) : (const char*)g.Bt + (size_t)(pn) * tstepB)
#define PG8_ASLICE(pn) (CMPA ? (size_t)(pn) * ((size_t)nt * kstepA) : (size_t)0)
#define PG8_ABASE(pm) (CMPA ? (const char*)g.A + ((size_t)((pm) & 15) * 128 * 16 * lda + (size_t)((pm) >> 4) * 128) * 2 : (const char*)g.A + ((size_t)(pm) * BM + ((g.gap && (pm) >= 64) ? 1 : 0)) * rowA)
#define PG8_KOFF(t) (CMPA ? (ptrdiff_t)(t) * (ptrdiff_t)kstepA : (((t) < ts) ? (ptrdiff_t)(t) * (ptrdiff_t)kstep : (ptrdiff_t)((t) - ts) * (ptrdiff_t)kstep - (ptrdiff_t)rowA))
#define PG8_SA(b, h) (((b) * 2 + (h)) * HTB)
#define PG8_SB(b, h) ((4 + (b) * 2 + (h)) * HTB)
#define PG8_STAGE(bufoff, gbase, voff) do { _Pragma("unroll") for (int _i = 0; _i < 2; ++_i) \
        __builtin_amdgcn_global_load_lds((const unsigned*)((const char*)(gbase) + (voff)[_i]), (PG8_LAS unsigned*)(lds + (bufoff) + ldsw + _i * 8192), 16, 0, 0); } while (0)
#define PG8_LDA(dst, b, h) do { _Pragma("unroll") for (int m = 0; m < 4; ++m) _Pragma("unroll") for (int k = 0; k < 2; ++k) dst[m][k] = *(const PG8_LAS bf16x8*)(lds + PG8_SA(b, h) + aoff + m * 2048 + k * 1024); } while (0)
#define PG8_LDB(dst, b, h) do { _Pragma("unroll") for (int n = 0; n < 2; ++n) _Pragma("unroll") for (int k = 0; k < 2; ++k) dst[n][k] = *(const PG8_LAS bf16x8*)(lds + PG8_SB(b, h) + boff + n * 2048 + k * 1024); } while (0)
#define PG8_MMA(ai, bj, At, Bt) do { __builtin_amdgcn_s_setprio(1); _Pragma("unroll") for (int m = 0; m < 4; ++m) _Pragma("unroll") for (int n = 0; n < 2; ++n) _Pragma("unroll") for (int k = 0; k < 2; ++k) \
        acc[ai][bj][m][n] = __builtin_amdgcn_mfma_f32_16x16x32_bf16(Bt[n][k], At[m][k], acc[ai][bj][m][n], 0, 0, 0); __builtin_amdgcn_s_setprio(0); } while (0)
#define PG8_WAIT_V(n) asm volatile("s_waitcnt vmcnt(" #n ")" ::: "memory")
#define PG8_WAIT_L(n) asm volatile("s_waitcnt lgkmcnt(" #n ")" ::: "memory")
#define PG8_BAR __builtin_amdgcn_s_barrier()
#define PG8_SCHED __builtin_amdgcn_sched_barrier(0)
    Unit cur, nxt; int ui = 0;
    if (!S.next(0, cur)) return;
    f32x4 acc[2][2][4][2];
#pragma unroll
    for (int a = 0; a < 2; ++a)
#pragma unroll
        for (int b = 0; b < 2; ++b)
#pragma unroll
            for (int m = 0; m < 4; ++m)
#pragma unroll
                for (int n = 0; n < 2; ++n) acc[a][b][m][n] = (f32x4){0.f, 0.f, 0.f, 0.f};
    bf16x8 At[4][2], B0[2][2], B1[2][2];
    const char* cA = PG8_ABASE(cur.pm) + PG8_ASLICE(cur.pn); const char* cB = PG8_BBASE(cur.pn);
    S.a_ready(cur);
    static_assert(SP2, "only the SP2 loop is kept");
    PG8_STAGE(PG8_SB(0, 0), cB, voffB); PG8_STAGE(PG8_SB(0, 1), cB + hstepB, voffB); PG8_STAGE(PG8_SA(0, 0), cA, voffA); PG8_STAGE(PG8_SA(0, 1), cA + hstepA, voffA);
    if (wr == 1) PG8_BAR;
    PG8_WAIT_V(2); PG8_BAR;
    PG8_STAGE(PG8_SB(1, 0), cB + kstep, voffB); PG8_STAGE(PG8_SA(1, 0), cA + kstepA, voffA); PG8_STAGE(PG8_SB(1, 1), cB + hstepB + kstep, voffB);
    PG8_WAIT_V(6); PG8_BAR;
    for (;;) {
        const bool has_next = S.next(ui + 1, nxt);
        const char* nA = has_next ? PG8_ABASE(nxt.pm) + PG8_ASLICE(nxt.pn) : cA; const char* nB = has_next ? PG8_BBASE(nxt.pn) : cB;
        for (int t = 0; t < nt; t += 2) {
            const bool last = (t == nt - 2);
            const char* a1 = cA + PG8_KOFF(t + 1);
            const char* a2 = last ? nA : cA + PG8_KOFF(t + 2); const char* b2 = last ? nB : cB + (size_t)(t + 2) * kstep;
            const char* a3 = a2 + kstepA; const char* b3 = b2 + kstep;
            if (last && has_next) S.a_ready(nxt);
            PG8_LDB(B0, 0, 0); PG8_LDB(B1, 0, 1); PG8_SCHED; PG8_LDA(At, 0, 0); PG8_STAGE(PG8_SA(1, 1), a1 + hstepA, voffA);
            PG8_WAIT_V(8); PG8_WAIT_L(0); PG8_BAR; PG8_MMA(0, 0, At, B0); PG8_MMA(0, 1, At, B1); PG8_BAR; PG8_SCHED;
            PG8_LDA(At, 0, 1); PG8_STAGE(PG8_SB(0, 0), b2, voffB); PG8_STAGE(PG8_SB(0, 1), b2 + hstepB, voffB); PG8_STAGE(PG8_SA(0, 0), a2, voffA);
            PG8_WAIT_V(8); PG8_WAIT_L(0); PG8_BAR; PG8_MMA(1, 0, At, B0); PG8_MMA(1, 1, At, B1); PG8_BAR; PG8_SCHED;
            PG8_LDB(B0, 1, 0); PG8_LDB(B1, 1, 1); PG8_SCHED; PG8_LDA(At, 1, 0); PG8_STAGE(PG8_SA(0, 1), a2 + hstepA, voffA);
            PG8_WAIT_V(8); PG8_WAIT_L(0); PG8_BAR; PG8_MMA(0, 0, At, B0); PG8_MMA(0, 1, At, B1); PG8_BAR; PG8_SCHED;
            PG8_LDA(At, 1, 1); PG8_STAGE(PG8_SB(1, 0), b3, voffB); PG8_STAGE(PG8_SB(1, 1), b3 + hstepB, voffB); PG8_STAGE(PG8_SA(1, 0), a3, voffA);
            PG8_WAIT_V(8); PG8_WAIT_L(0); PG8_BAR; PG8_MMA(1, 0, At, B0); PG8_MMA(1, 1, At, B1); PG8_BAR; PG8_SCHED;
        }
        if constexpr (ALIGN_EPI) { if (wr == 0) PG8_BAR; }
        E(acc, cur, wr, wc, fr, fq); S.done(cur);
        if (!has_next) break;
#pragma unroll
        for (int a = 0; a < 2; ++a)
#pragma unroll
            for (int b = 0; b < 2; ++b)
#pragma unroll
                for (int m = 0; m < 4; ++m)
#pragma unroll
                    for (int n = 0; n < 2; ++n) acc[a][b][m][n] = (f32x4){0.f, 0.f, 0.f, 0.f};
        cur = nxt; cA = nA; cB = nB; ++ui;
        if constexpr (ALIGN_EPI) { if (wr == 1) PG8_BAR; }
    }
    PG8_WAIT_V(0);
    if constexpr (!ALIGN_EPI) { if (wr == 0) PG8_BAR; }
    PG8_BAR;
#undef PG8_BBASE
#undef PG8_ASLICE
#undef PG8_ABASE
#undef PG8_KOFF
#undef PG8_SA
#undef PG8_SB
#undef PG8_STAGE
#undef PG8_LDA
#undef PG8_LDB
#undef PG8_MMA
#undef PG8_WAIT_V
#undef PG8_WAIT_L
#undef PG8_BAR
#undef PG8_SCHED
}
}

#define XB_TMO      128
#define XB_XCNT(j)  (256  + 64 * (j))
#define XB_XSUB(j)  (1280 + 64 * (j))
#define XB_XGEN(j)  (2304 + 64 * (j))
#define XB_TOP      3328
#define XB_TOPGEN   3392
#define XCD_BAR_WORDS 3456
#define XB_SPIN_CAP (1u << 24)

__device__ __forceinline__ unsigned xb_ld(unsigned* p)              { return __hip_atomic_load(p, __ATOMIC_RELAXED, __HIP_MEMORY_SCOPE_AGENT); }
__device__ __forceinline__ unsigned xb_add(unsigned* p, unsigned v) { return __hip_atomic_fetch_add(p, v, __ATOMIC_RELAXED, __HIP_MEMORY_SCOPE_AGENT); }
__device__ __forceinline__ unsigned xb_xcc_id() { return (unsigned)__builtin_amdgcn_s_getreg((3 << 11) | 20) & 0xFu; }
#define XB_SPIN(cond, bar) do { unsigned _sp = 0; while (cond) { __builtin_amdgcn_s_sleep(1); \
    if ((++_sp & 255u) == 0u) { if (xb_ld(&(bar)[XB_TMO])) break; if (_sp > XB_SPIN_CAP) { atomicAdd(&(bar)[XB_TMO], 1u); break; } } } } while (0)

struct XcdBarrier { unsigned* bar; unsigned x; volatile LAS unsigned* st; };

__device__ __forceinline__ XcdBarrier xcd_barrier_post(unsigned* bar, volatile LAS unsigned* st) {
    XcdBarrier b; b.bar = bar; b.x = xb_xcc_id(); b.st = st;
    if (threadIdx.x == 0) (void)xb_add(&bar[XB_XCNT(b.x)], 1u);
    return b;
}
__device__ __forceinline__ void xcd_barrier_complete(unsigned* bar, unsigned x, unsigned& nloc, unsigned& nx) {
    const unsigned G = gridDim.x * gridDim.y * gridDim.z;
    unsigned sum, cnt, mine, sp = 0u;
    for (;;) {
        sum = 0u; cnt = 0u; mine = 0u;
#pragma unroll
        for (unsigned j = 0; j < 16; ++j) { const unsigned c = xb_ld(&bar[XB_XCNT(j)]); sum += c; cnt += (c > 0u) ? 1u : 0u; mine = (j == x) ? c : mine; }
        if (sum == G) break;
        __builtin_amdgcn_s_sleep(1);
        if ((++sp & 255u) == 0u) { if (xb_ld(&bar[XB_TMO])) break; if (sp > XB_SPIN_CAP) { atomicAdd(&bar[XB_TMO], 1u); break; } }
    }
    nloc = mine > 0u ? mine : 1u; nx = cnt > 0u ? cnt : 1u;
}
__device__ __forceinline__ void xcd_barrier(const XcdBarrier& b) {
    asm volatile("s_waitcnt vmcnt(0)" ::: "memory");
    __syncthreads();
    if (threadIdx.x == 0) {
        unsigned* bar = b.bar;
        __builtin_amdgcn_s_waitcnt(0);
        unsigned nloc = b.st[0], nx = b.st[1];
        if (nloc == 0u) { xcd_barrier_complete(bar, b.x, nloc, nx); b.st[0] = nloc; b.st[1] = nx; }
        const unsigned old = xb_add(&bar[XB_XSUB(b.x)], 1u);
        const unsigned gen = old / nloc;
        if (old + 1u == (gen + 1u) * nloc) {
            __builtin_amdgcn_fence(__ATOMIC_RELEASE, "agent");
            asm volatile("s_waitcnt vmcnt(0)" ::: "memory");
            const unsigned og = xb_add(&bar[XB_TOP], 1u);
            const unsigned tg = og / nx;
            if (og + 1u == (tg + 1u) * nx) xb_add(&bar[XB_TOPGEN], 1u);
            else XB_SPIN(xb_ld(&bar[XB_TOPGEN]) == tg, bar);
            __builtin_amdgcn_fence(__ATOMIC_ACQUIRE, "agent");
            xb_add(&bar[XB_XGEN(b.x)], 1u);
            asm volatile("s_waitcnt vmcnt(0)" ::: "memory");
        } else {
            XB_SPIN(xb_ld(&bar[XB_XGEN(b.x)]) == gen, bar);
            __builtin_amdgcn_fence(__ATOMIC_ACQUIRE, "agent");
            asm volatile("s_waitcnt vmcnt(0)" ::: "memory");
        }
    }
    __syncthreads();
}

struct Args { const float* in[53]; float* out; unsigned char* ws; int ph_lo, ph_hi; };

enum { I_X = 0, I_L0F1 = 1, I_L0_MIX_PRE = 6, I_L0_MIX_POST = 7, I_W_IN = 8, I_PE_K = 9, I_W1_K = 10, I_W2_K = 11, I_PE_V = 12, I_W1_V = 13, I_W2_V = 14,
       I_CONV_W = 15, I_CONV_B = 16, I_W_OUT = 17, I_L0F2 = 18, I_L1F1 = 23, I_L1_MIX_PRE = 28, I_L1_MIX_POST = 29, I_MU = 30, I_W_R = 31, I_W_K = 32, I_W_V = 33, I_W_O = 34,
       I_W0 = 35, I_DEC1 = 36, I_DEC2 = 37, I_A0 = 38, I_A1 = 39, I_A2 = 40, I_G1 = 41, I_G2 = 42, I_K_K = 43, I_K_A = 44, I_R_K = 45, I_LNX_G = 46, I_LNX_B = 47, I_L1F2 = 48 };

template <class RM, class SC> __device__ __forceinline__ void convert_t(bf16* dst, int dstK, int koff, const float* src, int Ksrc, int ncol, RM rowmap, SC scale, int gtid, int gsize, LAS unsigned char* lds, int rot = 0) {
    const int lane = gtid & 63, nwv = gsize >> 6, gwv = ((gtid >> 6) + nwv - rot % nwv) % nwv;
    LAS float* scr = (LAS float*)(lds + ((gtid >> 6) & 7) * 8704);
    const int nblk = (ncol + 31) >> 5, nitems = (Ksrc >> 6) * nblk;
    for (int it = gwv; it < nitems; it += nwv) {
        const int kb = it / nblk, nb = it - kb * nblk, k0 = kb * 64, n0 = nb * 32;
        const int nn = n0 + (lane & 31); const bool nok = nn < ncol;
        float v[32];
        const float* sp = src + (size_t)(k0 + (lane >> 5)) * ncol + (nok ? nn : 0);
#pragma unroll
        for (int i = 0; i < 32; ++i) v[i] = sp[(size_t)(2 * i) * ncol];
#pragma unroll
        for (int i = 0; i < 32; ++i) { const int kk = 2 * i + (lane >> 5); scr[kk * 33 + (lane & 31)] = nok ? v[i] * scale(k0 + kk) : 0.f; }
        const int cch = lane & 7;
#pragma unroll
        for (int j = 0; j < 4; ++j) { const int n = (lane >> 3) + 8 * j; const LAS float* s = scr + (8 * cch) * 33 + n;
            u32x4 o; o.x = cvt_pk_bf16(s[0 * 33], s[1 * 33]); o.y = cvt_pk_bf16(s[2 * 33], s[3 * 33]); o.z = cvt_pk_bf16(s[4 * 33], s[5 * 33]); o.w = cvt_pk_bf16(s[6 * 33], s[7 * 33]);
            if (n0 + n < ncol) *(u32x4*)(dst + (size_t)rowmap(n0 + n) * dstK + koff + k0 + 8 * cch) = o; }
    }
}
__device__ __forceinline__ void zero_rows(bf16* dst, size_t nelem, int gtid, int gsize) {
    for (size_t i = (size_t)gtid * 8; i < nelem; i += (size_t)gsize * 8) *(u32x4*)(dst + i) = (u32x4){0u, 0u, 0u, 0u};
}
__device__ __forceinline__ void convert_ffn(const Args& a, int base, int gtid, int gsize, LAS unsigned char* lds) {
    const float* wg = a.in[base + 2]; const float* wu = a.in[base + 3]; const float* wd = a.in[base + 4];
    unsigned char* W = a.ws + WS_W;
    auto one = [](int) { return 1.0f; };
    convert_t((bf16*)(W + W_GU), D, 0, wg, D, FF, [](int n) { return (n >> 7) * 256 + (n & 127); }, one, gtid, gsize, lds, 0);
    convert_t((bf16*)(W + W_GU), D, 0, wu, D, FF, [](int n) { return (n >> 7) * 256 + 128 + (n & 127); }, one, gtid, gsize, lds, 1408);
    convert_t((bf16*)(W + W_DN), FF, 0, wd, FF, D, [](int n) { return n; }, one, gtid, gsize, lds, 2816);
}
__device__ __forceinline__ void convert_mix0(const Args& a, int gtid, int gsize, LAS unsigned char* lds) {
    const float* win = a.in[I_W_IN]; const float* wout = a.in[I_W_OUT];
    unsigned char* W = a.ws + WS_W;
    auto one = [](int) { return 1.0f; };
    convert_t((bf16*)(W + W_IN), D, 0, win, D, 2840, [](int n) { return n < 512 ? n : (n < 536 ? n - 512 + 2816 : n - 24); }, one, gtid, gsize, lds);
    zero_rows((bf16*)(W + W_IN) + (size_t)2840 * D, (size_t)(PROJ_LD - 2840) * D, gtid, gsize);
    convert_t((bf16*)(W + W_OUT), D, 0, wout, D, D, [](int n) { return n; }, one, gtid, gsize, lds);
    convert_t((bf16*)(W + W_CMP), 2048, 0, a.in[I_W1_K], 2048, 128, [](int n) { return n; }, one, gtid, gsize, lds);
    convert_t((bf16*)(W + W_CMP), 2048, 0, a.in[I_W1_V], 2048, 128, [](int n) { return n + 128; }, one, gtid, gsize, lds);
    { const int gw_ = gtid >> 6, ln = gtid & 63; if (gw_ < 256) { const int kv = gw_ >> 7, n = gw_ & 127; const float* pe = a.in[kv ? I_PE_V : I_PE_K]; const float* w1 = a.in[kv ? I_W1_V : I_W1_K];
        float s = 0.f; for (int kk = ln; kk < 2048; kk += 64) s += pe[kk] * w1[(size_t)kk * 128 + n]; s = wave_sum(s); if (ln == 0) ((float*)(a.ws + WS_PEB))[gw_] = s; } }
}
__device__ __forceinline__ void convert_mix1(const Args& a, int gtid, int gsize, LAS unsigned char* lds) {
    const float* mu = a.in[I_MU];
    unsigned char* W = a.ws + WS_W;
    bf16* Wlo = (bf16*)(W + W_LORA); bf16* Wl2 = (bf16*)(W + W_L2);
    auto one = [](int) { return 1.0f; };
    convert_t((bf16*)(W + W_R), D, 0, a.in[I_W_R], D, D, [](int n) { return n; }, one, gtid, gsize, lds, 0);
    convert_t((bf16*)(W + W_K), D, 0, a.in[I_W_K], D, D, [](int n) { return n; }, one, gtid, gsize, lds, 512);
    convert_t((bf16*)(W + W_V), D, 0, a.in[I_W_V], D, D, [](int n) { return n; }, one, gtid, gsize, lds, 1024);
#define CONV_LORA(srcp, ncol, rowoff, mi) \
    convert_t(Wlo, 2 * D, 0, srcp, D, ncol, [](int n) { return n + (rowoff); }, [=](int k) { return 1.0f - mu[(mi) * 1024 + k]; }, gtid, gsize, lds, 1536); \
    convert_t(Wlo, 2 * D, D, srcp, D, ncol, [](int n) { return n + (rowoff); }, [=](int k) { return mu[(mi) * 1024 + k]; }, gtid, gsize, lds, 1700);
    CONV_LORA(a.in[I_DEC1], 64, 0, 1)
    CONV_LORA(a.in[I_A1], 64, 64, 4)
    CONV_LORA(a.in[I_G1], 128, 128, 5)
#undef CONV_LORA
    zero_rows(Wl2, (size_t)EAG_LD * 256, gtid, gsize);
    convert_t((bf16*)(W + W_O), D, 0, a.in[I_W_O], D, D, [](int n) { return n; }, one, gtid, gsize, lds);
}
__device__ __forceinline__ void convert_mix1_l2(const Args& a, int gtid, int gsize, LAS unsigned char* lds) {
    unsigned char* W = a.ws + WS_W; bf16* Wl2 = (bf16*)(W + W_L2);
    auto one = [](int) { return 1.0f; };
    convert_t(Wl2, 256, 0, a.in[I_DEC2], 64, 1024, [](int n) { return n; }, one, gtid, gsize, lds);
    convert_t(Wl2, 256, 64, a.in[I_A2], 64, 1024, [](int n) { return n + 1024; }, one, gtid, gsize, lds);
    convert_t(Wl2, 256, 128, a.in[I_G2], 128, 1024, [](int n) { return n + 2048; }, one, gtid, gsize, lds);
}

template <bool HAS_A, bool TWO, bool WRITE_X, bool HAS_XN>
__device__ __forceinline__ void row_pass(const float* xin, float* xout, const bf16* da, const float* ga, float ca, const bf16* db, const float* gb, float cb, const float* gpre, bf16* xn, int gw, int nw, int lane) {
    f32x4 gA[4], gB[4], gP[4];
#pragma unroll
    for (int j = 0; j < 4; ++j) { if constexpr (HAS_A) gA[j] = *(const f32x4*)(ga + lane * 4 + 256 * j); if constexpr (TWO) gB[j] = *(const f32x4*)(gb + lane * 4 + 256 * j);
        if constexpr (HAS_XN) gP[j] = *(const f32x4*)(gpre + lane * 4 + 256 * j); }
    for (int row = gw; row < M; row += nw) {
        f32x4 x[4];
#pragma unroll
        for (int j = 0; j < 4; ++j) x[j] = __builtin_nontemporal_load((const f32x4*)(xin + (size_t)row * D + lane * 4 + 256 * j));
        if constexpr (HAS_A) {
            f32x4 d[4]; float ss = 0.f;
#pragma unroll
            for (int j = 0; j < 4; ++j) { const u32x2 w = *(const u32x2*)(da + (size_t)row * D + lane * 4 + 256 * j); d[j] = (f32x4){bflo(w.x), bfhi(w.x), bflo(w.y), bfhi(w.y)};
                ss += (d[j].x * d[j].x + d[j].y * d[j].y) + (d[j].z * d[j].z + d[j].w * d[j].w); }
            const float rstd = ca * rsqrtf(wave_sum(ss) * (1.0f / D) + EPS);
#pragma unroll
            for (int j = 0; j < 4; ++j) x[j] = x[j] + d[j] * gA[j] * rstd;
        }
        if constexpr (TWO) {
            f32x4 d[4]; float ss = 0.f;
#pragma unroll
            for (int j = 0; j < 4; ++j) { const u32x2 w = *(const u32x2*)(db + (size_t)row * D + lane * 4 + 256 * j); d[j] = (f32x4){bflo(w.x), bfhi(w.x), bflo(w.y), bfhi(w.y)};
                ss += (d[j].x * d[j].x + d[j].y * d[j].y) + (d[j].z * d[j].z + d[j].w * d[j].w); }
            const float rstd = cb * rsqrtf(wave_sum(ss) * (1.0f / D) + EPS);
#pragma unroll
            for (int j = 0; j < 4; ++j) x[j] = x[j] + d[j] * gB[j] * rstd;
        }
        if constexpr (WRITE_X) {
#pragma unroll
            for (int j = 0; j < 4; ++j) __builtin_nontemporal_store(x[j], (f32x4*)(xout + (size_t)row * D + lane * 4 + 256 * j));
        }
        if constexpr (HAS_XN) {
            float ss = 0.f;
#pragma unroll
            for (int j = 0; j < 4; ++j) ss += (x[j].x * x[j].x + x[j].y * x[j].y) + (x[j].z * x[j].z + x[j].w * x[j].w);
            const float rstd = rsqrtf(wave_sum(ss) * (1.0f / D) + EPS);
            const size_t prow = (size_t)row + (row >= SEQ ? 2 : 1);
#pragma unroll
            for (int j = 0; j < 4; ++j) { const f32x4 y = x[j] * gP[j] * rstd;
                u32x2 w; w.x = cvt_pk_bf16(y.x, y.y); w.y = cvt_pk_bf16(y.z, y.w); *(u32x2*)(xn + prow * D + lane * 4 + 256 * j) = w; }
        }
    }
    if constexpr (HAS_XN) { if (blockIdx.x == 0) { const int t = threadIdx.x; if (t < 256) { u32x4 z = (u32x4){0u, 0u, 0u, 0u}; const size_t prow = (t < 128) ? 0 : (size_t)SEQ + 1; *(u32x4*)(xn + prow * D + (t & 127) * 8) = z; } } }
}

__device__ __forceinline__ void rwkv_mix_phase(const Args& a, int gtid, int gsize) {
    const bf16* xn = (const bf16*)(a.ws + WS_XN); const float* mu = a.in[I_MU];
    bf16* xr = (bf16*)(a.ws + WS_XR); bf16* xk = (bf16*)(a.ws + WS_XK); bf16* xv = (bf16*)(a.ws + WS_XV);
    const int c8 = gtid & 127, tl = gtid >> 7, nl = gsize >> 7, run = (M + nl - 1) / nl;
    float mr[8], mk[8], mv[8];
    { const float* m = mu + c8 * 8;
#pragma unroll
      for (int j = 0; j < 8; ++j) { mr[j] = m[j]; mk[j] = m[2 * 1024 + j]; mv[j] = m[3 * 1024 + j]; } }
    const int t_beg = tl * run, t_end = (t_beg + run < M) ? t_beg + run : M;
    u32x4 pw = (u32x4){0u, 0u, 0u, 0u};
    if (t_beg < t_end) { const size_t prow0 = (size_t)t_beg + (t_beg >= SEQ ? 2 : 1); pw = *(const u32x4*)(xn + (prow0 - 1) * D + c8 * 8); }
    for (int tok = t_beg; tok < t_end; ++tok) {
        const size_t prow = (size_t)tok + (tok >= SEQ ? 2 : 1);
        if ((tok & (SEQ - 1)) == 0) pw = (u32x4){0u, 0u, 0u, 0u};
        const u32x4 hw = *(const u32x4*)(xn + prow * D + c8 * 8);
        const float h[8] = {bflo(hw.x), bfhi(hw.x), bflo(hw.y), bfhi(hw.y), bflo(hw.z), bfhi(hw.z), bflo(hw.w), bfhi(hw.w)};
        const float p[8] = {bflo(pw.x), bfhi(pw.x), bflo(pw.y), bfhi(pw.y), bflo(pw.z), bfhi(pw.z), bflo(pw.w), bfhi(pw.w)};
#define MIX_ONE(mm, dstp) do { float o[8]; \
            _Pragma("unroll") for (int j = 0; j < 8; ++j) o[j] = h[j] + (p[j] - h[j]) * mm[j]; \
            u32x4 w; w.x = cvt_pk_bf16(o[0], o[1]); w.y = cvt_pk_bf16(o[2], o[3]); w.z = cvt_pk_bf16(o[4], o[5]); w.w = cvt_pk_bf16(o[6], o[7]); \
            *(u32x4*)((dstp) + (size_t)tok * D + c8 * 8) = w; } while (0)
        MIX_ONE(mr, xr); MIX_ONE(mk, xk); MIX_ONE(mv, xv);
#undef MIX_ONE
        pw = hw;
    }
}

constexpr int CMP_SPLIT = 8;
__device__ __forceinline__ void compress_stage2(const Args& a, int gw, int nw, int lane) {
    const float* part = (const float*)(a.ws + WS_XN); const float* peb = (const float*)(a.ws + WS_PEB);
    for (int m = gw; m < 8192; m += nw) {
        const int kv = m >> 12, mm = m & 4095, g = mm & 1, i = (mm >> 1) & 1023, b = mm >> 11;
        if (i >= NCMP) continue;
        float h0 = peb[kv * 128 + lane], h1 = peb[kv * 128 + 64 + lane];
#pragma unroll
        for (int s = 0; s < CMP_SPLIT; ++s) { const float* p = part + ((size_t)s * 8192 + m) * 128; h0 += p[lane]; h1 += p[64 + lane]; }
        { const float u0 = 0.7978845608028654f * (h0 + 0.044715f * h0 * h0 * h0), u1 = 0.7978845608028654f * (h1 + 0.044715f * h1 * h1 * h1);
          h0 = 0.5f * h0 * (2.0f - 2.0f * __builtin_amdgcn_rcpf(__expf(2.0f * u0) + 1.0f)); h1 = 0.5f * h1 * (2.0f - 2.0f * __builtin_amdgcn_rcpf(__expf(2.0f * u1) + 1.0f)); }
        const float* w2 = a.in[kv ? I_W2_V : I_W2_K];
        float o0 = 0.f, o1 = 0.f;
#pragma unroll
        for (int n = 0; n < 64; ++n) { o0 = fmaf(__int_as_float(__builtin_amdgcn_readlane(__float_as_int(h0), n)), w2[n * 64 + lane], o0); o1 = fmaf(__int_as_float(__builtin_amdgcn_readlane(__float_as_int(h1), n)), w2[(64 + n) * 64 + lane], o1); }
        bf16* dst = (bf16*)(a.ws + (kv ? WS_VC : WS_KC)); dst[((size_t)(b * NCMP + i) * 2 + g) * 64 + lane] = f2bf(o0 + o1);
    }
}

typedef float f32x16 __attribute__((ext_vector_type(16)));
typedef short s16x4 __attribute__((ext_vector_type(4)));
constexpr int NK_KS = 144, NK_VS = 144;
constexpr int NL_K = 0, NL_V = 2 * 128 * NK_KS, NL_IMP = NL_V + 2 * 128 * NK_VS, NL_SELM = NL_IMP + 64 * 264 * 4, NL_UN = NL_SELM + 64 * 8 * 4, NL_ULIST = NL_UN + 72 * 4, NL_END = NL_ULIST + 260 * 4;
static_assert(NL_END <= LDS_CTL_OFF, "NSA LDS map");
constexpr float LOG2E = 1.4426950408889634f;

struct SmState { float m, l; f32x16 o0, o1; };
struct TileSrc { const bf16* k; const bf16* v; int stride; int nvalid; };

__device__ __forceinline__ void tile_load(const TileSrc& s, int tid, u32x4& kr, u32x4& vr) {
    const int row = tid >> 3, chk = tid & 7;
    if (row < s.nvalid) { kr = *(const u32x4*)(s.k + (size_t)row * s.stride + chk * 8); if (s.v) vr = *(const u32x4*)(s.v + (size_t)row * s.stride + chk * 8); }
    else { kr = (u32x4){0u, 0u, 0u, 0u}; vr = (u32x4){0u, 0u, 0u, 0u}; }
}
__device__ __forceinline__ void tile_store(LAS unsigned char* kb, LAS unsigned char* vb, int tid, const u32x4& kr, const u32x4& vr) {
    const int row = tid >> 3, chk = tid & 7;
    *(LAS u32x4*)(kb + row * NK_KS + chk * 16) = kr; *(LAS u32x4*)(vb + row * NK_VS + chk * 16) = vr;
    if (chk == 0) *(LAS u32x4*)(kb + row * NK_KS + 128) = (u32x4){cvt_pk_bf16((float)row, 0.f), 0u, 0u, 0u};
}
__device__ __forceinline__ void qk64(const LAS unsigned char* kb, int lane, const bf16x8 (&qf)[4], unsigned qx0, int lo, int hi, bool allvalid, f32x16& a0, f32x16& a1) {
#pragma unroll
    for (int e = 0; e < 16; ++e) { a0[e] = 0.f; a1[e] = 0.f; }
    const int c32 = lane & 31, h = lane >> 5;
    const LAS unsigned char* kp = kb + c32 * NK_KS + h * 16;
#pragma unroll
    for (int ks = 0; ks < 4; ++ks) { const bf16x8 k0 = *(const LAS bf16x8*)(kp + ks * 32), k1 = *(const LAS bf16x8*)(kp + 32 * NK_KS + ks * 32);
        a0 = __builtin_amdgcn_mfma_f32_32x32x16_bf16(k0, qf[ks], a0, 0, 0, 0); a1 = __builtin_amdgcn_mfma_f32_32x32x16_bf16(k1, qf[ks], a1, 0, 0, 0); }
    { const bf16x8 k0 = *(const LAS bf16x8*)(kb + c32 * NK_KS + 128), k1 = *(const LAS bf16x8*)(kb + (32 + c32) * NK_KS + 128);
      union { u32x4 u; bf16x8 b; } qx; qx.u = (u32x4){(lane < 32) ? qx0 : 0u, 0u, 0u, 0u};
      a0 = __builtin_amdgcn_mfma_f32_32x32x16_bf16(k0, qx.b, a0, 0, 0, 0); a1 = __builtin_amdgcn_mfma_f32_32x32x16_bf16(k1, qx.b, a1, 0, 0, 0); }
    if (!allvalid) {
        if (hi < lo) { lo = 1000; hi = 1000; }
        const unsigned span = (unsigned)(hi - lo); const int l0 = lo - 4 * h, l1 = lo - 4 * h - 32;
#pragma unroll
        for (int e = 0; e < 16; ++e) { const int ce = (e & 3) + 8 * (e >> 2);
            a0[e] = ((unsigned)(ce - l0) <= span) ? a0[e] : -INFINITY; a1[e] = ((unsigned)(ce - l1) <= span) ? a1[e] : -INFINITY; }
    }
}
__device__ __forceinline__ void tile64(const LAS unsigned char* kb, const LAS unsigned char* vb, int lane, const bf16x8 (&qf)[4], unsigned qx0, int lo, int hi, bool allvalid, float C1, float tc2, SmState& st) {
    f32x16 a0, a1;
    qk64(kb, lane, qf, qx0, lo, hi, allvalid, a0, a1);
    float tmax = fmaxf(a0[0], a1[0]);
#pragma unroll
    for (int e = 1; e < 16; ++e) tmax = fmaxf(tmax, fmaxf(a0[e], a1[e]));
    tmax = xor32_max(fmaf(tmax, C1, tc2));
    const float mn = fmaxf(st.m, tmax);
    if (!__all(mn == st.m)) { const float al = __builtin_amdgcn_exp2f(st.m - mn); st.l *= al; st.m = mn;
#pragma unroll
        for (int e = 0; e < 16; ++e) { st.o0[e] *= al; st.o1[e] *= al; } }
    float ps = 0.f; const float off = tc2 - st.m;
#pragma unroll
    for (int e = 0; e < 16; ++e) { a0[e] = __builtin_amdgcn_exp2f(fmaf(a0[e], C1, off)); a1[e] = __builtin_amdgcn_exp2f(fmaf(a1[e], C1, off)); ps += a0[e] + a1[e]; }
    st.l += ps;
    const int i16 = lane & 15, g4 = lane >> 4;
    const LAS unsigned char* vp = vb + (4 * (g4 >> 1) + (i16 >> 2)) * NK_VS + (16 * (g4 & 1) + 4 * (i16 & 3)) * 2;
#pragma unroll
    for (int hf = 0; hf < 2; ++hf)
#pragma unroll
        for (int sk = 0; sk < 2; ++sk) {
            const f32x16& pp = hf ? a1 : a0;
            bf16x8 pf; { union { u32x4 u; bf16x8 b; } cv; cv.u.x = cvt_pk_bf16(pp[8 * sk + 0], pp[8 * sk + 1]); cv.u.y = cvt_pk_bf16(pp[8 * sk + 2], pp[8 * sk + 3]); cv.u.z = cvt_pk_bf16(pp[8 * sk + 4], pp[8 * sk + 5]); cv.u.w = cvt_pk_bf16(pp[8 * sk + 6], pp[8 * sk + 7]); pf = cv.b; }
#pragma unroll
            for (int dt = 0; dt < 2; ++dt) {
                const s16x4 v0 = __builtin_amdgcn_ds_read_tr16_b64_v4i16((LAS s16x4*)(vp + (32 * hf + 16 * sk) * NK_VS + dt * 64));
                const s16x4 v1 = __builtin_amdgcn_ds_read_tr16_b64_v4i16((LAS s16x4*)(vp + (32 * hf + 16 * sk + 8) * NK_VS + dt * 64));
                const bf16x8 vf = (bf16x8){v0.x, v0.y, v0.z, v0.w, v1.x, v1.y, v1.z, v1.w};
                if (dt == 0) st.o0 = __builtin_amdgcn_mfma_f32_32x32x16_bf16(vf, pf, st.o0, 0, 0, 0);
                else st.o1 = __builtin_amdgcn_mfma_f32_32x32x16_bf16(vf, pf, st.o1, 0, 0, 0);
            }
        }
}
__device__ __forceinline__ int imp_idx(int token, int j) { return token * 264 + (j >> 5) * 33 + (j & 31); }

#ifndef NSA_DUP
#define NSA_DUP 0
#endif
#define NSA_REP(bit) for (int rep_ = 0; rep_ < ((NSA_DUP >> (bit)) & 1) + 1; ++rep_)
__device__ __forceinline__ void nsa_mfma_phase(const Args& a, LAS unsigned char* lds) {
    const int tid0 = threadIdx.x, wave = __builtin_amdgcn_readfirstlane(tid0 >> 6);
    const bf16* proj = (const bf16*)(a.ws + WS_BIG);
    const bf16* KC = (const bf16*)(a.ws + WS_KC); const bf16* VC = (const bf16*)(a.ws + WS_VC);
    bf16* att = (bf16*)(a.ws + WS_ATT);
    LAS float* IMP = (LAS float*)(lds + NL_IMP); LAS unsigned* SELM = (LAS unsigned*)(lds + NL_SELM); LAS unsigned* UN = (LAS unsigned*)(lds + NL_UN); LAS int* ULIST = (LAS int*)(lds + NL_ULIST);
    const int G = gridDim.x;
    for (int ui = 0; ; ++ui) {
        const int u = ui * G + blockIdx.x; if (u >= NB * 2 * (SEQ / 64)) break;
        int tid = tid0; asm volatile("" : "+v"(tid));
        const int lane = tid & 63, h = lane >> 5, c32 = lane & 31, tl = c32 >> 2, r = c32 & 3;
        const int bg = u >> 8, tsw = ((u & 7) << 5) | ((u & 255) >> 3), tile = (bg & 1) ? 255 - tsw : tsw, b = bg >> 1, g = bg & 1;
        const int t0 = tile * 64, tokl = wave * 8 + tl, t = t0 + tokl;
        const size_t tok = (size_t)b * SEQ + t;
        const float slope = exp2f(-(float)(g * 4 + r + 1)), sl2 = slope * LOG2E, C1 = 0.125f * LOG2E;
        const unsigned qx_one = cvt_pk_bf16(8.0f * slope, 0.f), qx_cmp = cvt_pk_bf16(128.0f * slope, 0.f);
        bf16x8 qf[4];
#pragma unroll
        for (int ks = 0; ks < 4; ++ks) qf[ks] = *(const bf16x8*)(proj + tok * PROJ_LD + PC_Q + (g * 4 + r) * 64 + ks * 16 + h * 8);
        f32x16 out0, out1;
#pragma unroll
        for (int e = 0; e < 16; ++e) { out0[e] = 0.f; out1[e] = 0.f; }
        SmState st;
        u32x4 kr, vr, kr2, vr2;
#define NSA_STATE_INIT() do { st.m = -1e30f; st.l = 0.f; _Pragma("unroll") for (int e = 0; e < 16; ++e) { st.o0[e] = 0.f; st.o1[e] = 0.f; } } while (0)
#define NSA_STATE_FOLD(gi) do { const float lt = xor32_sum(st.l); const float gt_ = sigmoidf_(bf2f(proj[((size_t)b * SEQ + t) * PROJ_LD + PC_G + (g * 4 + r) * 3 + (gi)])); const float sc_ = gt_ / fmaxf(lt, 1e-30f); _Pragma("unroll") for (int e = 0; e < 16; ++e) { out0[e] += st.o0[e] * sc_; out1[e] += st.o1[e] * sc_; } } while (0)
#define NSA_KB(i) (lds + NL_K + ((((i) >> 1) & 1) * 128 + ((i) & 1) * 64) * NK_KS)
#define NSA_VB(i) (lds + NL_V + ((((i) >> 1) & 1) * 128 + ((i) & 1) * 64) * NK_VS)
#define NSA_PIPE(N, SRC, ...) do { const int n_ = (N); \
        tile_load(SRC(0), tid, kr, vr); tile_store(NSA_KB(0), NSA_VB(0), tid, kr, vr); \
        if (1 < n_) { tile_load(SRC(1), tid, kr, vr); tile_store(NSA_KB(1), NSA_VB(1), tid, kr, vr); } \
        __syncthreads(); \
        if (2 < n_) tile_load(SRC(2), tid, kr, vr); \
        if (3 < n_) tile_load(SRC(3), tid, kr2, vr2); \
        for (int ip_ = 0; 2 * ip_ < n_; ++ip_) { \
            { const int i = 2 * ip_; __VA_ARGS__ } \
            if (2 * ip_ + 1 < n_) { const int i = 2 * ip_ + 1; __VA_ARGS__ } \
            if (2 * ip_ + 2 < n_) tile_store(NSA_KB(2 * ip_ + 2), NSA_VB(2 * ip_ + 2), tid, kr, vr); \
            if (2 * ip_ + 3 < n_) tile_store(NSA_KB(2 * ip_ + 3), NSA_VB(2 * ip_ + 3), tid, kr2, vr2); \
            __syncthreads(); \
            if (2 * ip_ + 4 < n_) tile_load(SRC(2 * ip_ + 4), tid, kr, vr); \
            if (2 * ip_ + 5 < n_) tile_load(SRC(2 * ip_ + 5), tid, kr2, vr2); \
        } } while (0)
        const int ntc = (4 * tile + 3 + 63) >> 6;
        auto cmp_src = [&](int i) { const int n0 = 64 * (ntc - 1 - i); TileSrc s; s.k = KC + ((size_t)(b * NCMP + n0) * 2 + g) * 64; s.v = VC + ((size_t)(b * NCMP + n0) * 2 + g) * 64; s.stride = 128; s.nvalid = NCMP - n0; return s; };
        float m_cmp, invl_cmp;
        NSA_REP(0) {
            NSA_STATE_INIT();
            __syncthreads();
            NSA_PIPE(ntc, cmp_src, { const int n0 = 64 * (ntc - 1 - i); const int hi = (t - 31 - 16 * n0) >> 4; const bool allv = __all(hi >= 63);
                tile64(NSA_KB(i), NSA_VB(i), lane, qf, qx_cmp, 0, hi, allv, C1, sl2 * (float)(16 * n0 + 31 - t), st); });
            const float lt = xor32_sum(st.l);
            m_cmp = st.m; invl_cmp = 1.0f / fmaxf(lt, 1e-30f);
        }
        NSA_STATE_FOLD(0);
        if (tile >= 16) {
            NSA_REP(1) {
            auto cmpk_src = [&](int i) { TileSrc s = cmp_src(i); s.v = nullptr; return s; };
            NSA_PIPE(ntc, cmpk_src, { const int n0 = 64 * (ntc - 1 - i); const int hi = (t - 31 - 16 * n0) >> 4;
                  f32x16 a0, a1; qk64(NSA_KB(i), lane, qf, qx_cmp, 0, hi, false, a0, a1);
                  const float off2 = sl2 * (float)(16 * n0 + 31 - t) - m_cmp;
                  float mv[8], hv[8];
                  _Pragma("unroll") for (int hf = 0; hf < 2; ++hf)
                    _Pragma("unroll") for (int gq = 0; gq < 4; ++gq) {
                        const f32x16& s = hf ? a1 : a0;
                        const float p0 = __builtin_amdgcn_exp2f(fmaf(s[4 * gq], C1, off2)) * invl_cmp, p1 = __builtin_amdgcn_exp2f(fmaf(s[4 * gq + 1], C1, off2)) * invl_cmp,
                                    p2 = __builtin_amdgcn_exp2f(fmaf(s[4 * gq + 2], C1, off2)) * invl_cmp, p3 = __builtin_amdgcn_exp2f(fmaf(s[4 * gq + 3], C1, off2)) * invl_cmp;
                        float mainv = ((p0 + p1) + p2) + 0.5f * p3, halfv = 0.5f * p3;
                        mainv += dpp_mov<0xB1>(mainv); mainv += dpp_mov<0x4E>(mainv); halfv += dpp_mov<0xB1>(halfv); halfv += dpp_mov<0x4E>(halfv);
                        mv[4 * hf + gq] = mainv; hv[4 * hf + gq] = halfv; }
                  _Pragma("unroll") for (int q = 0; q < 8; ++q) {
                        auto rr = __builtin_amdgcn_permlane32_swap(__float_as_uint(q ? hv[q - 1] : 0.f), __float_as_uint(hv[q]), false, false);
                        const float tot = mv[q] + __uint_as_float(h ? rr[0] : rr[1]);
                        const int j = (n0 >> 2) + 2 * q + h;
                        if (r == 0 && j < NSLC) IMP[imp_idx(tokl, j)] = tot; }
                  if (i > 0 && h == 1 && r == 0) { const int jn = (n0 >> 2) + 16; if (jn < NSLC) IMP[imp_idx(tokl, jn)] += hv[7]; } });
            }
            NSA_REP(2) {
                const int ttl = lane >> 3, sl = lane & 7, tk = wave * 8 + ttl;
                float cand[32];
#pragma unroll
                for (int i = 0; i < 32; ++i) { const int j = 32 * sl + i; const float v = IMP[tk * 264 + sl * 33 + i]; const bool forced = (j == 0) || (j == tile) || (j == tile - 1); cand[i] = (j <= tile && !forced) ? v : -1.0f; }
                float top[13];
#pragma unroll
                for (int q = 0; q < 13; ++q) top[q] = -1.0f;
#pragma unroll
                for (int i = 0; i < 32; ++i) { const float x = cand[i];
#pragma unroll
                    for (int q = 12; q >= 1; --q) top[q] = __builtin_amdgcn_fmed3f(top[q - 1], top[q], x);
                    top[0] = fmaxf(top[0], x); }
#define NSA_MERGE(CTRL) do { float oth[13]; _Pragma("unroll") for (int q = 0; q < 13; ++q) oth[q] = dpp_mov<CTRL>(top[q]); \
                    _Pragma("unroll") for (int i = 0; i < 13; ++i) { const float x = oth[i]; _Pragma("unroll") for (int q = 12; q >= 1; --q) top[q] = __builtin_amdgcn_fmed3f(top[q - 1], top[q], x); top[0] = fmaxf(top[0], x); } } while (0)
                NSA_MERGE(0xB1); NSA_MERGE(0x4E); NSA_MERGE(0x141);
#undef NSA_MERGE
                const float T = top[12];
                unsigned bgt = 0u, beq = 0u, bforced = 0u;
#pragma unroll
                for (int i = 0; i < 32; ++i) { const int j = 32 * sl + i; if (cand[i] > T) bgt |= 1u << i; if (cand[i] == T) beq |= 1u << i; if ((j == 0) || (j == tile) || (j == tile - 1)) bforced |= 1u << i; }
                int cgt = __popc(bgt); cgt += dpp_movi<0xB1>(cgt); cgt += dpp_movi<0x4E>(cgt); cgt += dpp_movi<0x141>(cgt);
                const int need_eq = 13 - cgt;
                int ce_inc = __popc(beq);
#pragma unroll
                for (int d = 1; d < 8; d <<= 1) { const int y = __shfl_up(ce_inc, d); if (sl >= d) ce_inc += y; }
                const int before = ce_inc - __popc(beq);
                int ntake = need_eq - before; ntake = ntake < 0 ? 0 : ntake;
                unsigned keep = 0u, mm = beq;
                for (int q = 0; q < ntake && mm; ++q) { const unsigned low = mm & (0u - mm); keep |= low; mm ^= low; }
                const unsigned mask = bgt | keep | bforced;
                SELM[tk * 8 + sl] = mask;
                unsigned um = mask; um |= __shfl_xor(um, 8); um |= __shfl_xor(um, 16); um |= __shfl_xor(um, 32);
                if (lane < 8) UN[wave * 8 + lane] = um;
            }
        } else {
            if (tid < 64 * 8) { const unsigned mask = ((tid & 7) == 0) ? ((1u << (tile + 1)) - 1u) : 0u; SELM[tid] = mask; if (tid < 64) UN[tid] = ((tid & 7) == 0) ? mask : 0u; }
        }
        __syncthreads();
        if (tid < 256) {
            unsigned um[8]; int above = 0, total = 0;
#pragma unroll
            for (int d = 0; d < 8; ++d) { unsigned x = 0u;
#pragma unroll
                for (int w = 0; w < 8; ++w) x |= UN[w * 8 + d];
                um[d] = x; total += __popc(x); }
            const int dj = tid >> 5, bj = tid & 31; unsigned mine = 0u;
#pragma unroll
            for (int d = 0; d < 8; ++d) { if (d > dj) above += __popc(um[d]); if (d == dj) mine = um[d]; }
            above += __popc(bj == 31 ? 0u : (mine >> (bj + 1)));
            if ((mine >> bj) & 1u) ULIST[1 + above] = tid;
            if (tid == 0) ULIST[0] = total;
        }
        __syncthreads();
        {
            const int nu = __builtin_amdgcn_readfirstlane(ULIST[0]);
            auto slc_src = [&](int i) { const int j = ULIST[1 + i]; TileSrc s; s.k = proj + ((size_t)b * SEQ + 64 * j) * PROJ_LD + PC_KS + g * 64; s.v = proj + ((size_t)b * SEQ + 64 * j) * PROJ_LD + PC_VS + g * 64; s.stride = PROJ_LD; s.nvalid = 64; return s; };
            NSA_REP(3) {
            NSA_STATE_INIT();
            NSA_PIPE(nu, slc_src, { const int j = __builtin_amdgcn_readfirstlane(ULIST[1 + i]);
                const bool sel = (SELM[tokl * 8 + (j >> 5)] >> (j & 31)) & 1u;
                if (__any(sel)) { const int hi = sel ? (t - 64 * j) : -1; const bool allv = __all(hi >= 63);
                    tile64(NSA_KB(i), NSA_VB(i), lane, qf, qx_one, 0, hi, allv, C1, sl2 * (float)(64 * j - t), st); } });
            }
            NSA_STATE_FOLD(1);
        }
        {
            const int nwt = tile + 1 < 9 ? tile + 1 : 9;
            auto win_src = [&](int i) { const int j = tile - i; TileSrc s; s.k = proj + ((size_t)b * SEQ + 64 * j) * PROJ_LD + PC_KW + g * 64; s.v = proj + ((size_t)b * SEQ + 64 * j) * PROJ_LD + PC_VW + g * 64; s.stride = PROJ_LD; s.nvalid = 64; return s; };
            NSA_REP(4) {
            NSA_STATE_INIT();
            NSA_PIPE(nwt, win_src, { const int j = tile - i; const int hi = t - 64 * j, lo = t - 511 - 64 * j; const bool allv = __all(hi >= 63 && lo <= 0);
                tile64(NSA_KB(i), NSA_VB(i), lane, qf, qx_one, lo, hi, allv, C1, sl2 * (float)(64 * j - t), st); });
            }
            NSA_STATE_FOLD(2);
        }
#pragma unroll
        for (int dt = 0; dt < 2; ++dt)
#pragma unroll
            for (int gq = 0; gq < 4; ++gq) {
                const f32x16& o = dt ? out1 : out0;
                u32x2 w; w.x = cvt_pk_bf16(o[4 * gq], o[4 * gq + 1]); w.y = cvt_pk_bf16(o[4 * gq + 2], o[4 * gq + 3]);
                *(u32x2*)(att + tok * D + (g * 4 + r) * 64 + 32 * dt + 8 * gq + 4 * h) = w;
            }
#undef NSA_STATE_INIT
#undef NSA_STATE_FOLD
#undef NSA_KB
#undef NSA_VB
#undef NSA_PIPE
    }
    NSA_REP(5) {
        const float* cw = a.in[I_CONV_W]; const float* cbias = a.in[I_CONV_B];
        const int gt = blockIdx.x * 512 + tid0, gs = gridDim.x * 512;
        const int c0 = (gt & 63) * 8, tl = gt >> 6;
        constexpr int run = M / (256 * 8);
        if (gs == 256 * 512) {
        const f32x4 w0a = *(const f32x4*)(cw + c0), w0b = *(const f32x4*)(cw + c0 + 4), w1a = *(const f32x4*)(cw + 512 + c0), w1b = *(const f32x4*)(cw + 512 + c0 + 4),
                    w2a = *(const f32x4*)(cw + 1024 + c0), w2b = *(const f32x4*)(cw + 1024 + c0 + 4), bsa = *(const f32x4*)(cbias + c0), bsb = *(const f32x4*)(cbias + c0 + 4);
        const int t_beg = tl * run;
        const f32x4 zero4 = (f32x4){0.f, 0.f, 0.f, 0.f};
        f32x4 z0a = zero4, z0b = zero4, z1a = zero4, z1b = zero4;
#define CONV_U(S_, A, B) do { const u32x4 s_ = (S_); A = (f32x4){bflo(s_.x), bfhi(s_.x), bflo(s_.y), bfhi(s_.y)}; B = (f32x4){bflo(s_.z), bfhi(s_.z), bflo(s_.w), bfhi(s_.w)}; } while (0)
#define CONV_Z(A, B, tokn_) do { const bf16* p_ = proj + (size_t)(tokn_) * PROJ_LD; const u32x4 cc = *(const u32x4*)(p_ + PC_CC + c0), cu = *(const u32x4*)(p_ + PC_CU + c0); \
            f32x4 ca_, cb_, ua_, ub_; CONV_U(cc, ca_, cb_); CONV_U(cu, ua_, ub_); A = ca_ * ua_; B = cb_ * ub_; } while (0)
        if (t_beg < M) { const int tt = t_beg & (SEQ - 1); if (tt >= 2) CONV_Z(z0a, z0b, t_beg - 2); if (tt >= 1) CONV_Z(z1a, z1b, t_beg - 1); }
        for (int k = 0; k < run; ++k) {
            const int tokn = t_beg + k; if (tokn >= M) continue;
            if ((tokn & (SEQ - 1)) == 0) { z0a = zero4; z0b = zero4; z1a = zero4; z1b = zero4; }
            f32x4 z2a, z2b; CONV_Z(z2a, z2b, tokn);
            const u32x4 cbv = *(const u32x4*)(proj + (size_t)tokn * PROJ_LD + PC_CB + c0);
            f32x4 ga_, gb_; CONV_U(cbv, ga_, gb_);
            const f32x4 oa = ga_ * (bsa + w2a * z2a + w1a * z1a + w0a * z0a), ob = gb_ * (bsb + w2b * z2b + w1b * z1b + w0b * z0b);
            z0a = z1a; z0b = z1b; z1a = z2a; z1b = z2b;
            u32x4 w; w.x = cvt_pk_bf16(oa.x, oa.y); w.y = cvt_pk_bf16(oa.z, oa.w); w.z = cvt_pk_bf16(ob.x, ob.y); w.w = cvt_pk_bf16(ob.z, ob.w);
            *(u32x4*)(att + (size_t)tokn * D + 512 + c0) = w;
        }
#undef CONV_Z
#undef CONV_U
        } else {
        for (int idx = gt; idx < M * 64; idx += gs) {
            const int c0 = (idx & 63) * 8; const int tokn = idx >> 6, tt = tokn & (SEQ - 1);
            const bf16* p = proj + (size_t)tokn * PROJ_LD;
            float z[3][8];
#pragma unroll
            for (int k = 0; k < 3; ++k) {
                if (tt >= 2 - k) { const u32x4 cc = *(const u32x4*)(p + PC_CC + c0 - (2 - k) * PROJ_LD), cu = *(const u32x4*)(p + PC_CU + c0 - (2 - k) * PROJ_LD);
                    z[k][0] = bflo(cc.x) * bflo(cu.x); z[k][1] = bfhi(cc.x) * bfhi(cu.x); z[k][2] = bflo(cc.y) * bflo(cu.y); z[k][3] = bfhi(cc.y) * bfhi(cu.y);
                    z[k][4] = bflo(cc.z) * bflo(cu.z); z[k][5] = bfhi(cc.z) * bfhi(cu.z); z[k][6] = bflo(cc.w) * bflo(cu.w); z[k][7] = bfhi(cc.w) * bfhi(cu.w); }
                else {
#pragma unroll
                    for (int j = 0; j < 8; ++j) z[k][j] = 0.f; }
            }
            const u32x4 cbv = *(const u32x4*)(p + PC_CB + c0);
            const float cbf[8] = {bflo(cbv.x), bfhi(cbv.x), bflo(cbv.y), bfhi(cbv.y), bflo(cbv.z), bfhi(cbv.z), bflo(cbv.w), bfhi(cbv.w)};
            float o[8];
#pragma unroll
            for (int j = 0; j < 8; ++j) { float y = cbias[c0 + j] + cw[2 * 512 + c0 + j] * z[2][j]; y += cw[512 + c0 + j] * z[1][j]; y += cw[c0 + j] * z[0][j]; o[j] = cbf[j] * y; }
            u32x4 w; w.x = cvt_pk_bf16(o[0], o[1]); w.y = cvt_pk_bf16(o[2], o[3]); w.z = cvt_pk_bf16(o[4], o[5]); w.w = cvt_pk_bf16(o[6], o[7]);
            *(u32x4*)(att + (size_t)tokn * D + 512 + c0) = w;
        }
        }
    }
}

constexpr int SC_NCH = 64, SC_L = SEQ / SC_NCH, SC_NT = NB * 16 * SC_NCH;
constexpr int SM_L = 16;
constexpr int SM_RS = 144, SM_TS = 48;
constexpr int SM_AK = 0, SM_BH = 2304, SM_KH = 4608, SM_RH = 6912, SM_VV = 9216, SM_GAB = 11520, SM_GAK = 12672, SM_HRB = 13440, SM_HRK = 14208, SM_TT = 14976,
              SM_CL = 15744, SM_SS = 16000, SM_RK = 16064, SM_WAVE = 16128, SM_T1 = 0, SM_T2 = 16 * 65 * 4;
static_assert(2 * 16 * 65 * 4 <= SM_GAB, "MFMA scan LDS overlay");
static_assert(8 * SM_WAVE <= LDS_CTL_OFF, "MFMA scan LDS");
__device__ __forceinline__ bf16x8 sm_acc_hi(const f32x16& x, int ks) {
    union { u32x4 u; bf16x8 b; } c; c.u = (u32x4){cvt_pk_bf16(x[8 * ks], x[8 * ks + 1]), cvt_pk_bf16(x[8 * ks + 2], x[8 * ks + 3]), cvt_pk_bf16(x[8 * ks + 4], x[8 * ks + 5]), cvt_pk_bf16(x[8 * ks + 6], x[8 * ks + 7])}; return c.b; }
__device__ __forceinline__ bf16x8 sm_a_perm(const LAS unsigned char* tile, int rs, int row, int k0, int h) {
    const u32x2 lo = *(const LAS u32x2*)(tile + row * rs + (k0 + 4 * h) * 2), hi = *(const LAS u32x2*)(tile + row * rs + (k0 + 8 + 4 * h) * 2);
    union { u32x4 u; bf16x8 b; } c; c.u = (u32x4){lo.x, lo.y, hi.x, hi.y}; return c.b; }
__device__ __forceinline__ bf16x8 sm_nat(const LAS unsigned char* tile, int rs, int row, int k0, int h) { return *(const LAS bf16x8*)(tile + row * rs + (k0 + 8 * h) * 2); }
__device__ __forceinline__ bf16x8 sm_tr(const LAS unsigned char* tile, int col0, int lane) {
    const int i16 = lane & 15, g4 = lane >> 4;
    const LAS unsigned char* p = tile + (4 * (g4 >> 1) + (i16 >> 2)) * SM_RS + (col0 + 16 * (g4 & 1) + 4 * (i16 & 3)) * 2;
    const s16x4 v0 = __builtin_amdgcn_ds_read_tr16_b64_v4i16((LAS s16x4*)p), v1 = __builtin_amdgcn_ds_read_tr16_b64_v4i16((LAS s16x4*)(p + 8 * SM_RS));
    return (bf16x8){v0.x, v0.y, v0.z, v0.w, v1.x, v1.y, v1.z, v1.w};
}
#define SM_MFMA(a, b, c) __builtin_amdgcn_mfma_f32_32x32x16_bf16(a, b, c, 0, 0, 0)

__device__ __forceinline__ void scan_a_mfma_task(const Args& a, int task, int lane_in, LAS unsigned char* L) {
    int lane = lane_in; asm volatile("" : "+v"(lane));
    bf16* rkv = (bf16*)(a.ws + WS_BIG); const bf16* eag = (const bf16*)(a.ws + WS_EAG);
    float* pq = (float*)(a.ws + WS_PQ); float* rks = (float*)(a.ws + WS_RKS);
    const int c = task % SC_NCH, bh = task / SC_NCH, b = bh >> 4, hd = bh & 15, hb = hd * 64;
    LAS float* GAB = (LAS float*)(L + SM_GAB); LAS float* CL = (LAS float*)(L + SM_CL); LAS float* T1 = (LAS float*)(L + SM_T1); LAS float* T2 = (LAS float*)(L + SM_T2);
    LAS float* SS = (LAS float*)(L + SM_SS); LAS float* RK = (LAS float*)(L + SM_RK);
    f32x16 ZT[2][4];
#pragma unroll
    for (int jt = 0; jt < 2; ++jt)
#pragma unroll
        for (int zt = 0; zt < 4; ++zt)
#pragma unroll
            for (int e = 0; e < 16; ++e) { const int j = 32 * jt + (e & 3) + 8 * (e >> 2) + 4 * (lane >> 5), z = 32 * zt + (lane & 31); ZT[jt][zt][e] = (zt < 2 && j == z) ? 1.f : 0.f; }
    const size_t tokb = (size_t)b * SEQ + (size_t)c * SC_L;
#pragma unroll 1
    for (int mc = 0; mc < SC_L / SM_L; ++mc) {
        asm volatile("" : "+v"(lane));
        const int h = lane >> 5, c32 = lane & 31, t16 = c32 & 15, ch = hb + lane;
        const size_t tok0 = tokb + (size_t)mc * SM_L;
        {
            int ch_o = ch; asm volatile("" : "+v"(ch_o));
            const float kk_c = a.in[I_K_K][ch_o], ka_c = a.in[I_K_A][ch_o], rk_c = a.in[I_R_K][ch_o];
            unsigned rk_[SM_L], ea_[SM_L];
            {
                const int lr = lane >> 3, lc = lane & 7;
                const u32x4* pr = (const u32x4*)(rkv + (tok0 + lr) * RKV_LD + hb) + lc; const u32x4* pe = (const u32x4*)(eag + (tok0 + lr) * EAG_LD + hb) + lc;
                u32x4 gr[2], gk[2], gv[2], ge[2], ga[2];
#pragma unroll
                for (int i = 0; i < 2; ++i) { gr[i] = pr[i * RKV_LD]; gk[i] = pr[i * RKV_LD + 128]; gv[i] = pr[i * RKV_LD + 256]; ge[i] = pe[i * EAG_LD]; ga[i] = pe[i * EAG_LD + 128]; }
#pragma unroll
                for (int i = 0; i < 2; ++i) { LAS unsigned char* w = L + (lr + 8 * i) * SM_RS + lc * 16;
                    *(LAS u32x4*)(w + SM_AK) = gr[i]; *(LAS u32x4*)(w + SM_BH) = gk[i]; *(LAS u32x4*)(w + SM_VV) = gv[i]; *(LAS u32x4*)(w + SM_KH) = ge[i]; *(LAS u32x4*)(w + SM_RH) = ga[i]; }
#pragma unroll
                for (int s = 0; s < SM_L; ++s) { const LAS unsigned char* q = L + s * SM_RS + lane * 2;
                    const unsigned r = *(const LAS unsigned short*)(q + SM_AK), k = *(const LAS unsigned short*)(q + SM_BH), e = *(const LAS unsigned short*)(q + SM_KH), al = *(const LAS unsigned short*)(q + SM_RH);
                    rk_[s] = r | (k << 16); ea_[s] = al | (e << 16); }
            }
#pragma unroll
            for (int s = 0; s < SM_L; ++s) { const float k = bfhi(rk_[s]), kkr = k * kk_c, al = bflo(ea_[s]); T1[s * 65 + lane] = kkr * kkr; T2[s * 65 + lane] = bflo(rk_[s]) * (k * (1.0f + (al - 1.0f) * ka_c)) * rk_c; }
            { const int st = lane >> 2, pt = lane & 3; float s1 = 0.f, s2 = 0.f;
#pragma unroll
              for (int q = 0; q < 16; ++q) { s1 += T1[st * 65 + pt * 16 + q]; s2 += T2[st * 65 + pt * 16 + q]; }
              s1 += dpp_mov<0xB1>(s1); s1 += dpp_mov<0x4E>(s1); s2 += dpp_mov<0xB1>(s2); s2 += dpp_mov<0x4E>(s2);
              if (pt == 0) { SS[st] = s1; RK[st] = s2; } }
            if (lane < SM_L) rks[(tok0 + lane) * 16 + hd] = RK[lane];
            float cum = 0.f, cprev = 1.f;
#pragma unroll
            for (int s = 0; s < SM_L; ++s) {
                const float k = bfhi(rk_[s]), al = bflo(ea_[s]), r = bflo(rk_[s]);
                const float kk = k * kk_c * rsqrtf(fmaxf(SS[s], 1e-12f)), kp = k * (1.0f + (al - 1.0f) * ka_c);
                cum += bfhi(ea_[s]); const float ct = __expf(-cum), ict = __expf(cum);
                const float akv = kk * cprev, bhv = kk * al * ict, khv = kp * ict, rhv = r * ct;
                *(LAS bf16*)(L + SM_AK + s * SM_RS + lane * 2) = f2bf(akv); *(LAS bf16*)(L + SM_BH + s * SM_RS + lane * 2) = f2bf(bhv);
                *(LAS bf16*)(L + SM_KH + s * SM_RS + lane * 2) = f2bf(khv); *(LAS bf16*)(L + SM_RH + s * SM_RS + lane * 2) = f2bf(rhv);
                cprev = ct;
            }
            CL[lane] = cprev;
        }
        __builtin_amdgcn_sched_barrier(0);
        {
            f32x16 gab, gak, hrb, hrk;
#pragma unroll
            for (int e = 0; e < 16; ++e) { gab[e] = 0.f; gak[e] = 0.f; hrb[e] = 0.f; hrk[e] = 0.f; }
#pragma unroll
            for (int ks = 0; ks < 4; ++ks) {
                const bf16x8 fa = sm_nat(L + SM_AK, SM_RS, t16, 16 * ks, h), fr = sm_nat(L + SM_RH, SM_RS, t16, 16 * ks, h), fb = sm_nat(L + SM_BH, SM_RS, t16, 16 * ks, h), fk = sm_nat(L + SM_KH, SM_RS, t16, 16 * ks, h);
                gab = SM_MFMA(fa, fb, gab); gak = SM_MFMA(fa, fk, gak); hrb = SM_MFMA(fr, fb, hrb); hrk = SM_MFMA(fr, fk, hrk);
            }
            if (c32 < 16) {
#pragma unroll
                for (int e = 0; e < 8; ++e) { const int t = (e & 3) + 8 * (e >> 2) + 4 * h, s = c32;
                    GAB[t * 17 + s] = (s < t) ? gab[e] : 0.f;
                    *(LAS bf16*)(L + SM_GAK + t * SM_TS + s * 2) = f2bf((s < t) ? gak[e] : 0.f);
                    *(LAS bf16*)(L + SM_HRB + t * SM_TS + s * 2) = f2bf((s <= t) ? hrb[e] : 0.f);
                    *(LAS bf16*)(L + SM_HRK + t * SM_TS + s * 2) = f2bf((s <= t) ? hrk[e] : 0.f); }
            }
        }
        __builtin_amdgcn_sched_barrier(0);
        if (lane < 16) {
            float tc[16];
#pragma unroll
            for (int t = 0; t < 16; ++t) { float v = (t == lane) ? 1.f : 0.f;
#pragma unroll
                for (int s = 0; s < t; ++s) v -= GAB[t * 17 + s] * tc[s];
                tc[t] = v; *(LAS bf16*)(L + SM_TT + t * SM_TS + lane * 2) = f2bf(v); }
        }
        __builtin_amdgcn_sched_barrier(0);
#pragma unroll
        for (int zt = 0; zt < 4; ++zt) {
            f32x16 x, o;
#pragma unroll
            for (int e = 0; e < 16; ++e) { x[e] = 0.f; o[e] = 0.f; }
#pragma unroll
            for (int jt = 0; jt < 2; ++jt)
#pragma unroll
                for (int ks = 0; ks < 2; ++ks) {
                    const bf16x8 fa = sm_a_perm(L + SM_AK, SM_RS, t16, 32 * jt + 16 * ks, h), fr = sm_a_perm(L + SM_RH, SM_RS, t16, 32 * jt + 16 * ks, h);
                    const bf16x8 zh = sm_acc_hi(ZT[jt][zt], ks);
                    x = SM_MFMA(fa, zh, x); o = SM_MFMA(fr, zh, o);
                }
            if (zt >= 2) { const bf16x8 fv = sm_tr(L + SM_VV, 32 * (zt - 2), lane);
                x = SM_MFMA(sm_a_perm(L + SM_GAK, SM_TS, t16, 0, h), fv, x); o = SM_MFMA(sm_a_perm(L + SM_HRK, SM_TS, t16, 0, h), fv, o); }
            f32x16 sa;
#pragma unroll
            for (int e = 0; e < 16; ++e) sa[e] = 0.f;
            { const bf16x8 xh = sm_acc_hi(x, 0); const bf16x8 ft = sm_a_perm(L + SM_TT, SM_TS, t16, 0, h); sa = SM_MFMA(ft, xh, sa); }
#pragma unroll
            for (int e = 0; e < 16; ++e) sa[e] = -sa[e];
            const bf16x8 sh = sm_acc_hi(sa, 0);
            { const bf16x8 fh = sm_a_perm(L + SM_HRB, SM_TS, t16, 0, h); o = SM_MFMA(fh, sh, o); }
#pragma unroll
            for (int e = 0; e < 8; ++e) { const int t = (e & 3) + 8 * (e >> 2) + 4 * h;
                rkv[(tok0 + t) * RKV_LD + (zt < 2 ? hb + 32 * zt : 1024 + hb + 32 * (zt - 2)) + c32] = f2bf(o[e]); }
#pragma unroll
            for (int jt = 0; jt < 2; ++jt) {
                const bf16x8 fb = sm_tr(L + SM_BH, 32 * jt, lane);
                ZT[jt][zt] = SM_MFMA(fb, sh, ZT[jt][zt]);
                if (zt >= 2) ZT[jt][zt] = SM_MFMA(sm_tr(L + SM_KH, 32 * jt, lane), sm_tr(L + SM_VV, 32 * (zt - 2), lane), ZT[jt][zt]);
#pragma unroll
                for (int g = 0; g < 4; ++g) { const f32x4 c4 = *(const LAS f32x4*)(CL + 32 * jt + 8 * g + 4 * h);
                    ZT[jt][zt][4 * g] *= c4.x; ZT[jt][zt][4 * g + 1] *= c4.y; ZT[jt][zt][4 * g + 2] *= c4.z; ZT[jt][zt][4 * g + 3] *= c4.w; }

            }
            __builtin_amdgcn_sched_barrier(0);
        }
    }
    if (c < SC_NCH - 1) {
        float* dst = pq + ((size_t)(bh * (SC_NCH - 1) + c) * 2) * 4096;
#pragma unroll
        for (int jt = 0; jt < 2; ++jt)
#pragma unroll
            for (int zt = 0; zt < 4; ++zt)
#pragma unroll
                for (int g = 0; g < 4; ++g) { const int z = 32 * zt + (lane & 31), j0 = 32 * jt + 8 * g + 4 * (lane >> 5);
                    *(f32x4*)(dst + (size_t)z * 64 + j0) = (f32x4){ZT[jt][zt][4 * g], ZT[jt][zt][4 * g + 1], ZT[jt][zt][4 * g + 2], ZT[jt][zt][4 * g + 3]}; }
    }
}
__device__ __forceinline__ void scan_pass_a_mfma(const Args& a, LAS unsigned char* lds) {
    const int tid = threadIdx.x, wave = __builtin_amdgcn_readfirstlane(tid >> 6), lane = tid & 63, G = gridDim.x;
    for (int task = wave * G + blockIdx.x; task < SC_NT; task += 8 * G)
    {   unsigned z = 0u; asm volatile("" : "+v"(z));
        scan_a_mfma_task(a, task, (int)__builtin_amdgcn_mbcnt_hi(~0u, __builtin_amdgcn_mbcnt_lo(~0u, z)), lds + wave * SM_WAVE); }
}
#define PB_WAIT(n) asm volatile("s_waitcnt vmcnt(" #n ")" ::: "memory")
__device__ __forceinline__ void scan_pass_b(const Args& a, LAS unsigned char* lds) {
    const int tid = threadIdx.x, wave = __builtin_amdgcn_readfirstlane(tid >> 6), lane = tid & 63;
    LAS float* Pl = (LAS float*)lds;
    LAS float* Ql = Pl + 4 * 4096;
    float* pq = (float*)(a.ws + WS_PQ);
    for (int u = blockIdx.x; u < NB * 16 * 8; u += gridDim.x) {
        const int xcd = u & 7, idx = u >> 3, bh = (xcd * 4 + (idx >> 3)) & (NB * 16 - 1), row = (idx & 7) * 8 + wave;
        float* pc = pq + ((size_t)(bh * (SC_NCH - 1)) * 2) * 4096;
        float cur = 0.f;
        __syncthreads();
#define PB_ISSUE(cc) do { const int c_ = (cc) < SC_NCH - 1 ? (cc) : SC_NCH - 2; const float* g_ = pc + (size_t)c_ * 2 * 4096; LAS float* d_ = Pl + ((cc) & 3) * 4096 + wave * 256; \
            __builtin_amdgcn_global_load_lds((const unsigned*)(g_ + tid * 4), (LAS unsigned*)d_, 16, 0, 0); __builtin_amdgcn_global_load_lds((const unsigned*)(g_ + 2048 + tid * 4), (LAS unsigned*)(d_ + 2048), 16, 0, 0); \
            __builtin_amdgcn_global_load_lds((const unsigned*)(g_ + 4096 + row * 64 + lane), (LAS unsigned*)(Ql + ((cc) & 3) * 512 + wave * 64), 4, 0, 0); } while (0)
        PB_ISSUE(0); PB_ISSUE(1); PB_ISSUE(2);
        for (int c = 0; c < SC_NCH - 1; ++c) {
            if (c >= 3) PB_WAIT(9); else PB_WAIT(6);
            __builtin_amdgcn_s_barrier(); asm volatile("" ::: "memory");
            PB_ISSUE(c + 3);
            const LAS float* P = Pl + (c & 3) * 4096 + lane;
            float a0 = Ql[(c & 3) * 512 + wave * 64 + lane], a1 = 0.f, a2 = 0.f, a3 = 0.f;
#pragma unroll
            for (int k = 0; k < 64; k += 4) {
#define PB_BC(kk) __int_as_float(__builtin_amdgcn_readlane(__float_as_int(cur), (kk)))
                a0 = fmaf(PB_BC(k), P[k * 64], a0); a1 = fmaf(PB_BC(k + 1), P[(k + 1) * 64], a1); a2 = fmaf(PB_BC(k + 2), P[(k + 2) * 64], a2); a3 = fmaf(PB_BC(k + 3), P[(k + 3) * 64], a3);
            }
            cur = (a0 + a1) + (a2 + a3);
            pc[(size_t)c * 2 * 4096 + 4096 + row * 64 + lane] = cur;
        }
        PB_WAIT(0);
    }
}
__device__ __forceinline__ void pc_seg_load(const bf16* half_base, u32x2 (&out)[2][4]) {
#pragma unroll
    for (int gq = 0; gq < 4; ++gq) { const u32x4 L = ((const u32x4*)half_base)[gq];
        auto s0 = __builtin_amdgcn_permlane32_swap(L.x, L.z, false, false); auto s1 = __builtin_amdgcn_permlane32_swap(L.y, L.w, false, false);
        out[0][gq] = (u32x2){s0[0], s1[0]}; out[1][gq] = (u32x2){s0[1], s1[1]}; }
}
__device__ __forceinline__ void pc_seg_store(bf16* half_base, const u32x2 (&in)[2][4]) {
#pragma unroll
    for (int gq = 0; gq < 4; ++gq) {
        auto s0 = __builtin_amdgcn_permlane32_swap(in[0][gq].x, in[1][gq].x, false, false); auto s1 = __builtin_amdgcn_permlane32_swap(in[0][gq].y, in[1][gq].y, false, false);
        ((u32x4*)half_base)[gq] = (u32x4){s0[0], s1[0], s0[1], s1[1]}; }
}
constexpr int SCC_SS = 144;
__device__ __forceinline__ void scan_pass_c(const Args& a, LAS unsigned char* lds) {
    const int tid = threadIdx.x, wave = __builtin_amdgcn_readfirstlane(tid >> 6), lane = tid & 63, h32 = lane >> 5, c32 = lane & 31;
    bf16* rkv = (bf16*)(a.ws + WS_BIG); const bf16* eag = (const bf16*)(a.ws + WS_EAG);
    const float* pq = (const float*)(a.ws + WS_PQ); const float* rks = (const float*)(a.ws + WS_RKS);
    LAS unsigned char* SH = lds; LAS unsigned char* SL = lds + 64 * SCC_SS;
    for (int u = blockIdx.x; u < SC_NT; u += gridDim.x) {
        const int c = u % SC_NCH, bh = u / SC_NCH, b = bh >> 4, h = bh & 15, hb = h * 64;
        __syncthreads();
        if (c > 0) { const float* sp = pq + ((size_t)(bh * (SC_NCH - 1) + c - 1) * 2 + 1) * 4096 + tid * 8;
            const f32x4 x0 = *(const f32x4*)sp, x1 = *(const f32x4*)(sp + 4);
            const float xs[8] = {x0.x, x0.y, x0.z, x0.w, x1.x, x1.y, x1.z, x1.w};
            unsigned hi[4], lo[4];
#pragma unroll
            for (int q = 0; q < 4; ++q) { hi[q] = cvt_pk_bf16(xs[2 * q], xs[2 * q + 1]); lo[q] = cvt_pk_bf16(xs[2 * q] - bflo(hi[q]), xs[2 * q + 1] - bfhi(hi[q])); }
            *(LAS u32x4*)(SH + (tid >> 3) * SCC_SS + (tid & 7) * 16) = (u32x4){hi[0], hi[1], hi[2], hi[3]};
            *(LAS u32x4*)(SL + (tid >> 3) * SCC_SS + (tid & 7) * 16) = (u32x4){lo[0], lo[1], lo[2], lo[3]}; }
        __syncthreads();
        const size_t tok = (size_t)b * SEQ + (size_t)c * SC_L + wave * 32 + c32;
        f32x16 acc0, acc1;
#pragma unroll
        for (int e = 0; e < 16; ++e) { acc0[e] = 0.f; acc1[e] = 0.f; }
        if (c > 0) {
#pragma unroll
            for (int ks = 0; ks < 4; ++ks) {
                const bf16x8 pf = *(const bf16x8*)(rkv + tok * RKV_LD + hb + ks * 16 + h32 * 8);
                const bf16x8 a0h = *(const LAS bf16x8*)(SH + c32 * SCC_SS + h32 * 16 + ks * 32), a0l = *(const LAS bf16x8*)(SL + c32 * SCC_SS + h32 * 16 + ks * 32);
                const bf16x8 a1h = *(const LAS bf16x8*)(SH + (32 + c32) * SCC_SS + h32 * 16 + ks * 32), a1l = *(const LAS bf16x8*)(SL + (32 + c32) * SCC_SS + h32 * 16 + ks * 32);
                acc0 = __builtin_amdgcn_mfma_f32_32x32x16_bf16(a0h, pf, acc0, 0, 0, 0); acc0 = __builtin_amdgcn_mfma_f32_32x32x16_bf16(a0l, pf, acc0, 0, 0, 0);
                acc1 = __builtin_amdgcn_mfma_f32_32x32x16_bf16(a1h, pf, acc1, 0, 0, 0); acc1 = __builtin_amdgcn_mfma_f32_32x32x16_bf16(a1l, pf, acc1, 0, 0, 0);
            }
        }
        u32x2 yqw[2][4], vw[2][4], gw2[2][4];
        pc_seg_load(rkv + tok * RKV_LD + 1024 + hb + 32 * h32, yqw); pc_seg_load(rkv + tok * RKV_LD + 2048 + hb + 32 * h32, vw); pc_seg_load(eag + tok * EAG_LD + 2048 + hb + 32 * h32, gw2);
        float y[32]; float sum = 0.f;
#pragma unroll
        for (int it = 0; it < 2; ++it)
#pragma unroll
            for (int gq = 0; gq < 4; ++gq) {
                const u32x2 w = yqw[it][gq];
                const float q4[4] = {bflo(w.x), bfhi(w.x), bflo(w.y), bfhi(w.y)};
#pragma unroll
                for (int j = 0; j < 4; ++j) { const float v = (it ? acc1[4 * gq + j] : acc0[4 * gq + j]) + q4[j]; y[it * 16 + gq * 4 + j] = v; sum += v; }
            }
        const float mean = xor32_sum(sum) * (1.0f / 64.0f); float qs = 0.f;
#pragma unroll
        for (int e = 0; e < 32; ++e) { const float d = y[e] - mean; qs += d * d; }
        const float rstd = rsqrtf(xor32_sum(qs) * (1.0f / 64.0f) + 64e-5f);
        const float rkc = rks[tok * 16 + h];
        u32x2 ow[2][4];
#pragma unroll
        for (int it = 0; it < 2; ++it)
#pragma unroll
            for (int gq = 0; gq < 4; ++gq) {
                const int i0 = 32 * it + 8 * gq + 4 * h32;
                const f32x4 lg = *(const f32x4*)(a.in[I_LNX_G] + hb + i0), lb = *(const f32x4*)(a.in[I_LNX_B] + hb + i0);
                const float v4[4] = {bflo(vw[it][gq].x), bfhi(vw[it][gq].x), bflo(vw[it][gq].y), bfhi(vw[it][gq].y)}, g4[4] = {bflo(gw2[it][gq].x), bfhi(gw2[it][gq].x), bflo(gw2[it][gq].y), bfhi(gw2[it][gq].y)};
                const float l4[4] = {lg.x, lg.y, lg.z, lg.w}, b4[4] = {lb.x, lb.y, lb.z, lb.w};
                float o[4];
#pragma unroll
                for (int j = 0; j < 4; ++j) o[j] = ((y[it * 16 + gq * 4 + j] - mean) * rstd * l4[j] + b4[j] + rkc * v4[j]) * g4[j];
                ow[it][gq] = (u32x2){cvt_pk_bf16(o[0], o[1]), cvt_pk_bf16(o[2], o[3])};
            }
        pc_seg_store(rkv + tok * RKV_LD + hb + 32 * h32, ow);
    }
}

constexpr int N_PHASES = 27;
__global__ void __launch_bounds__(512, 2) mk_fwd(Args args) {
    extern __shared__ __attribute__((aligned(16))) unsigned char lds_raw[];
    LAS unsigned char* lds = (LAS unsigned char*)lds_raw;
    const int tid = threadIdx.x;
    const int G = gridDim.x, nw = G * 8, gsize = G * 512;
#define TIDO() ({ int t_ = threadIdx.x; asm volatile("" : "+v"(t_)); t_; })
#define lane (TIDO() & 63)
#define gw ((int)blockIdx.x * 8 + (TIDO() >> 6))
#define gtid ((int)blockIdx.x * 512 + TIDO())
    unsigned char* ws = args.ws;
    volatile LAS unsigned* lctl = (volatile LAS unsigned*)(lds + LDS_CTL_OFF);
    if (tid < 16) lctl[tid] = 0u;
    __syncthreads();
    const int lo = args.ph_lo, hi = args.ph_hi;
    XcdBarrier bar; bar.bar = (unsigned*)(ws + WS_CTL) + CW_BAR; bar.x = 0; bar.st = nullptr;
    if (hi - lo > 1) bar = xcd_barrier_post((unsigned*)(ws + WS_CTL) + CW_BAR, lctl + 8);
#define IN(k) (lo <= (k) && (k) < hi)
#ifndef PROBE_DUP
#define PROBE_DUP 0u
#endif
#define RUN(k, ...) do { if (IN(k)) { __VA_ARGS__; if ((PROBE_DUP >> (k)) & 1u) { xcd_barrier(bar); __VA_ARGS__; } } if (IN(k) && IN((k) + 1)) xcd_barrier(bar); } while (0)
    float* X = args.out;
    bf16* XNp = (bf16*)(ws + WS_XN);
    const pg8::bf16_t* XNa = (const pg8::bf16_t*)(ws + WS_XN) + D;
    bf16* DD = (bf16*)(ws + WS_DD);
    pg8::bf16_t* BIG = (pg8::bf16_t*)(ws + WS_BIG);
    pg8::bf16_t* YY = (pg8::bf16_t*)(ws + WS_Y);
    const unsigned char* Wb = ws + WS_W;
    const int bx = (int)blockIdx.x;

#define GEMM_CALL(MODE, Aptr, Woff, N_, K_, lda_, gap_, ts_, Optr, ldc_, b0_, b1_) do { pg8::Gemm g{Aptr, (const pg8::bf16_t*)(Wb + (Woff)), M, N_, K_, lda_, gap_, ts_}; pg8::StaticOrder S; S.init(M, N_, G, bx); \
        pg8::Epi<MODE> E{Optr, ldc_, b0_, b1_}; pg8::gemm_phase(lds, g, S, E); } while (0)
#define FFN_G1(k) RUN(k, GEMM_CALL(1, XNa, W_GU, 2 * FF, D, D, 1, D / 64, BIG, FF, nullptr, nullptr))
#define FFN_G2(k, outp) RUN(k, do { pg8::Gemm g{BIG, (const pg8::bf16_t*)(Wb + W_DN), M, D, FF, FF, 0, FF / 64}; pg8::StaticOrder S; S.init(M, D, G, bx); S.rev = 1; \
        pg8::Epi<0> E{(pg8::bf16_t*)(outp), D, nullptr, nullptr}; pg8::gemm_phase(lds, g, S, E); } while (0))
    bf16* DY = (bf16*)(ws + WS_Y);
    const pg8::bf16_t* ATT = (const pg8::bf16_t*)(ws + WS_ATT);

    RUN(0, row_pass<false, false, false, true>(args.in[I_X], nullptr, nullptr, nullptr, 0.f, nullptr, nullptr, 0.f, args.in[I_L0F1 + 0], XNp, gw, nw, lane); convert_ffn(args, I_L0F1, gtid, gsize, lds));
    FFN_G1(1); FFN_G2(2, DY);
    RUN(3, row_pass<true, false, false, true>(args.in[I_X], nullptr, DY, args.in[I_L0F1 + 1], 0.5f, nullptr, nullptr, 0.f, args.in[I_L0_MIX_PRE], XNp, gw, nw, lane); convert_mix0(args, gtid, gsize, lds));
    RUN(4, GEMM_CALL(0, XNa, W_IN, PROJ_LD, D, D, 1, D / 64, BIG, PROJ_LD, nullptr, nullptr));
    RUN(5, do {
        pg8::Gemm g{BIG + PC_KC, (const pg8::bf16_t*)(Wb + W_CMP), 8192, 256, 2048 / CMP_SPLIT, PROJ_LD, 0, 32, 2048}; pg8::SplitTiles S{G, bx, CMP_SPLIT * 32};
        pg8::Epi<6> E{(pg8::bf16_t*)(ws + WS_XN), 128, nullptr, nullptr}; pg8::gemm_phase<pg8::Epi<6>, pg8::SplitTiles, true>(lds, g, S, E); } while (0));
    RUN(6, compress_stage2(args, gw, nw, lane));
    RUN(7, nsa_mfma_phase(args, lds));
    RUN(8, GEMM_CALL(0, ATT, W_OUT, D, D, D, 0, D / 64, (pg8::bf16_t*)DD, D, nullptr, nullptr));
    RUN(9, row_pass<true, true, true, true>(args.in[I_X], X, DY, args.in[I_L0F1 + 1], 0.5f, DD, args.in[I_L0_MIX_POST], 1.0f, args.in[I_L0F2 + 0], XNp, gw, nw, lane); convert_ffn(args, I_L0F2, gtid, gsize, lds));
    FFN_G1(10); FFN_G2(11, DD);
    RUN(12, row_pass<true, false, false, true>(X, nullptr, DD, args.in[I_L0F2 + 1], 0.5f, nullptr, nullptr, 0.f, args.in[I_L1F1 + 0], XNp, gw, nw, lane); convert_ffn(args, I_L1F1, gtid, gsize, lds));
    FFN_G1(13); FFN_G2(14, DY);
    RUN(15, row_pass<true, true, true, true>(X, X, DD, args.in[I_L0F2 + 1], 0.5f, DY, args.in[I_L1F1 + 1], 0.5f, args.in[I_L1_MIX_PRE], XNp, gw, nw, lane); convert_mix1(args, gtid, gsize, lds));
    RUN(16, rwkv_mix_phase(args, gtid, gsize));
    RUN(17, GEMM_CALL(0, (const pg8::bf16_t*)(ws + WS_XR), W_R, D, D, D, 0, D / 64, BIG, RKV_LD, nullptr, nullptr);
            GEMM_CALL(0, (const pg8::bf16_t*)(ws + WS_XK), W_K, D, D, D, 0, D / 64, BIG + 1024, RKV_LD, nullptr, nullptr);
            GEMM_CALL(0, (const pg8::bf16_t*)(ws + WS_XV), W_V, D, D, D, 0, D / 64, BIG + 2048, RKV_LD, nullptr, nullptr);
            GEMM_CALL(5, XNa, W_LORA, 256, 2 * D, D, 1, D / 64, BIG + 3072, RKV_LD, nullptr, nullptr);
            convert_mix1_l2(args, gtid, gsize, lds));
    RUN(18, do { pg8::Gemm g{BIG + 3072, (const pg8::bf16_t*)(Wb + W_L2), M, 2048, 128, RKV_LD, 0, 2, 256}; pg8::StaticOrder S; S.init(M, 2048, G, bx);
                 pg8::Epi<3> E{(pg8::bf16_t*)(ws + WS_EAG), EAG_LD, args.in[I_W0], args.in[I_A0]}; pg8::gemm_phase(lds, g, S, E); } while (0);
            do { pg8::Gemm g{BIG + 3072 + 128, (const pg8::bf16_t*)(Wb + W_L2) + (size_t)2048 * 256 + 128, M, 1024, 128, RKV_LD, 0, 2, 256}; pg8::StaticOrder S; S.init(M, 1024, G, bx);
                 pg8::Epi<0> E{(pg8::bf16_t*)(ws + WS_EAG) + 2048, EAG_LD, nullptr, nullptr}; pg8::gemm_phase(lds, g, S, E); } while (0));
    RUN(19, scan_pass_a_mfma(args, lds));
    RUN(20, scan_pass_b(args, lds));
    RUN(21, scan_pass_c(args, lds));
    RUN(22, GEMM_CALL(0, BIG, W_O, D, D, RKV_LD, 0, D / 64, (pg8::bf16_t*)DD, D, nullptr, nullptr));
    RUN(23, row_pass<true, false, false, true>(X, nullptr, DD, args.in[I_L1_MIX_POST], 1.0f, nullptr, nullptr, 0.f, args.in[I_L1F2 + 0], XNp, gw, nw, lane); convert_ffn(args, I_L1F2, gtid, gsize, lds));
    FFN_G1(24); FFN_G2(25, DY);
    RUN(26, row_pass<true, true, true, false>(X, X, DD, args.in[I_L1_MIX_POST], 1.0f, DY, args.in[I_L1F2 + 1], 0.5f, nullptr, nullptr, gw, nw, lane));
#undef IN
#undef RUN
#undef lane
#undef gw
#undef gtid
#undef TIDO
}

extern "C" void kernel_launch(void* const* d_in, const int* in_sizes, int n_in, void* d_out, int out_size, void* d_ws, size_t ws_size, hipStream_t stream) {
    static int grid = 0;
    if (grid == 0) {
        if (n_in != 53 || out_size != M * D || ws_size < WS_END) { fprintf(stderr, "kernel_launch: unexpected shapes (n_in %d, out %d, ws %zu)\n", n_in, out_size, ws_size); grid = -1; return; }
        int dev = 0, cus = 0;
        if (hipGetDevice(&dev) != hipSuccess || hipDeviceGetAttribute(&cus, hipDeviceAttributeMultiprocessorCount, dev) != hipSuccess) { grid = -1; return; }
        if (hipFuncSetAttribute((const void*)mk_fwd, hipFuncAttributeMaxDynamicSharedMemorySize, LDS_BYTES) != hipSuccess) { fprintf(stderr, "kernel_launch: hipFuncSetAttribute failed\n"); grid = -1; return; }
        int per_cu = 0;
        if (hipOccupancyMaxActiveBlocksPerMultiprocessor(&per_cu, (const void*)mk_fwd, 512, LDS_BYTES) != hipSuccess || per_cu < 1) { fprintf(stderr, "kernel_launch: occupancy query says %d\n", per_cu); }
        (void)hipGetLastError();
        grid = cus;
    }
    if (grid < 0) return;
    (void)hipMemsetAsync((char*)d_ws + WS_CTL, 0, CTL_ZERO_BYTES, stream);
    Args a{};
    for (int i = 0; i < 53; ++i) a.in[i] = (const float*)d_in[i];
    a.out = (float*)d_out; a.ws = (unsigned char*)d_ws;
#if MK_ONE_LAUNCH
    a.ph_lo = 0; a.ph_hi = N_PHASES;
    hipLaunchKernelGGL(mk_fwd, dim3(grid), dim3(512), LDS_BYTES, stream, a);
#else
    for (int p = 0; p < N_PHASES; ++p) { a.ph_lo = p; a.ph_hi = p + 1; hipLaunchKernelGGL(mk_fwd, dim3(grid), dim3(512), LDS_BYTES, stream, a); }
#endif
}
```
